# Optimizing an MI355X kernel written in HIP

```python
import math
import jax
import jax.numpy as jnp
from jax import lax
import numpy as np

D_MODEL = 1024
BATCH = 16
SEQ = 256
DEPTH = 2
DEC_BATCH = 2
DEC_SEQ = 2048
PAST_LEN = 512

GRID_W = 64
N_MIXERS = 4
GROUP_W = D_MODEL // N_MIXERS
N_DIR = 2
S5_P = 16
S5_G = GROUP_W // S5_P
S5_N = 64
HG_HEADS = 4
HG_DK = GROUP_W // HG_HEADS
HG_DV = GROUP_W // HG_HEADS
HG_CHUNK = 32
FN_HEADS = 4
FN_DH = GROUP_W // FN_HEADS
GM_HEADS = 4
GM_DH = GROUP_W // GM_HEADS
GM_CHUNK = 128
D_FF = ((8 * D_MODEL // 3 + 127) // 128) * 128
CONV_W = 3
N_MOD = 6
N_IN_SLICES = 9
D_IN = N_IN_SLICES * GROUP_W
EPS = 1e-6
LAM_RE_MAX = -1e-4

kernel_name = 'hybrid_flow_prefix_s5_hgrn2_fnet_gmlp'


def rmsnorm(x, g):
    xf = x.astype(jnp.float32)
    y = xf * lax.rsqrt(jnp.mean(xf * xf, axis=-1, keepdims=True) + EPS)
    return (y * g.astype(jnp.float32)).astype(x.dtype)


def group_rmsnorm(x, g, n_groups):
    shp = x.shape
    xg = x.reshape(shp[:-1] + (n_groups, shp[-1] // n_groups))
    return rmsnorm(xg, g.reshape(n_groups, -1)).reshape(shp)


def s5_direction(u, lam_re, lam_im, log_dt, b_re, b_im, c_re, c_im, h0_re, h0_im, reverse):
    lr = jnp.minimum(lam_re.astype(jnp.float32), LAM_RE_MAX)
    li = lam_im.astype(jnp.float32)
    dt = jnp.exp(log_dt.astype(jnp.float32))[:, None]
    mag = jnp.exp(lr * dt)
    ang = li * dt
    ab_re = mag * jnp.cos(ang)
    ab_im = mag * jnp.sin(ang)
    den = lr * lr + li * li
    xr = ab_re - 1.0
    z_re = (xr * lr + ab_im * li) / den
    z_im = (ab_im * lr - xr * li) / den
    b_re = b_re.astype(jnp.float32)
    b_im = b_im.astype(jnp.float32)
    bb_re = z_re[..., None] * b_re - z_im[..., None] * b_im
    bb_im = z_re[..., None] * b_im + z_im[..., None] * b_re
    bu_re = jnp.einsum('btgp,gnp->btgn', u, bb_re)
    bu_im = jnp.einsum('btgp,gnp->btgn', u, bb_im)
    a_re = jnp.broadcast_to(ab_re, bu_re.shape)
    a_im = jnp.broadcast_to(ab_im, bu_im.shape)

    def combine(e1, e2):
        a1r, a1i, b1r, b1i = e1
        a2r, a2i, b2r, b2i = e2
        return (a2r * a1r - a2i * a1i, a2r * a1i + a2i * a1r,
                a2r * b1r - a2i * b1i + b2r, a2r * b1i + a2i * b1r + b2i)

    ac_re, ac_im, hb_re, hb_im = lax.associative_scan(combine, (a_re, a_im, bu_re, bu_im), reverse=reverse, axis=1)
    h_re = ac_re * h0_re[:, None] - ac_im * h0_im[:, None] + hb_re
    h_im = ac_re * h0_im[:, None] + ac_im * h0_re[:, None] + hb_im
    y = (jnp.einsum('gpn,btgn->btgp', c_re.astype(jnp.float32), h_re)
         - jnp.einsum('gpn,btgn->btgp', c_im.astype(jnp.float32), h_im))
    end = 0 if reverse else -1
    return y, h_re[:, end], h_im[:, end]


def hgrn_direction(q, logf, k, v, s0):
    bsz, t, nh = q.shape[0], q.shape[1], q.shape[2]
    nc = t // HG_CHUNK

    def chunked(a):
        return a.reshape((bsz, nc, HG_CHUNK) + a.shape[2:]).transpose(1, 0, 3, 2, 4)

    qc, fc, kc, vc = chunked(q), chunked(logf), chunked(k), chunked(v)
    bcum = jnp.cumsum(fc, axis=3)
    lower = jnp.tril(jnp.ones((HG_CHUNK, HG_CHUNK), dtype=bool))
    diff = bcum[..., :, None, :] - bcum[..., None, :, :]
    decay = jnp.exp(jnp.where(lower[:, :, None], diff, -jnp.inf))
    scores = jnp.einsum('cbhjk,cbhjik,cbhik->cbhji', qc, decay, kc)
    o_intra = jnp.einsum('cbhji,cbhiv->cbhjv', scores, vc)
    b_last = bcum[..., -1:, :]
    ds = jnp.einsum('cbhik,cbhiv->cbhkv', kc * jnp.exp(b_last - bcum), vc)
    g_last = jnp.exp(b_last[..., 0, :])

    def step(s, inp):
        g, d = inp
        return g[..., None] * s + d, s

    s_fin, s_start = lax.scan(step, s0, (g_last, ds))
    o_inter = jnp.einsum('cbhjk,cbhkv->cbhjv', qc * jnp.exp(bcum), s_start)
    o = (o_intra + o_inter).transpose(1, 0, 3, 2, 4).reshape(bsz, t, nh, -1)
    return o, s_fin


def mixer(h, p, lb, s5_h0_re, s5_h0_im, hg_s0):
    dt = h.dtype
    f32 = jnp.float32
    bsz, t = h.shape[0], h.shape[1]
    proj = h @ p['w_in']
    xa, hq, hf_fwd, hf_bwd, hi, hgate, xc, gu, gv = jnp.split(proj, N_IN_SLICES, axis=-1)
    gn = p['grp_norm_g']
    xa32 = xa.astype(f32)
    u = xa32.reshape(bsz, t, S5_G, S5_P)
    ys, fre, fim = [], [], []
    for d in range(N_DIR):
        y_d, r_d, i_d = s5_direction(u, p['s5_lam_re'][d], p['s5_lam_im'][d], p['s5_log_dt'][d],
                                     p['s5_b_re'][d], p['s5_b_im'][d], p['s5_c_re'][d], p['s5_c_im'][d],
                                     s5_h0_re[:, d].astype(f32), s5_h0_im[:, d].astype(f32), d == 1)
        ys.append(y_d)
        fre.append(r_d)
        fim.append(i_d)
    y5 = (ys[0] + ys[1]).reshape(bsz, t, GROUP_W) + p['s5_d'].astype(f32) * xa32
    y5 = jax.nn.gelu(y5).astype(dt)
    out_a = rmsnorm(y5 * jax.nn.sigmoid(y5 @ p['s5_w_glu']), gn[:GROUP_W])
    q = hq.astype(f32).reshape(bsz, t, HG_HEADS, HG_DK)
    v = hi.astype(f32).reshape(bsz, t, HG_HEADS, HG_DV)
    outs, sfin = [], []
    for d, zf in enumerate((hf_fwd, hf_bwd)):
        z = zf.astype(f32).reshape(bsz, t, HG_HEADS, HG_DK)
        lbd = lb[d].astype(f32).reshape(HG_HEADS, HG_DK)
        logf = jnp.logaddexp(jnp.log(lbd), jnp.log1p(-lbd) + jax.nn.log_sigmoid(z))
        k = (1.0 - lbd) * jax.nn.sigmoid(-z)
        s0 = hg_s0[:, d].astype(f32)
        if d == 0:
            o_d, s_d = hgrn_direction(q, logf, k, v, s0)
        else:
            o_d, s_d = hgrn_direction(q[:, ::-1], logf[:, ::-1], k[:, ::-1], v[:, ::-1], s0)
            o_d = o_d[:, ::-1]
        outs.append(o_d)
        sfin.append(s_d)
    o = (outs[0] + outs[1]).reshape(bsz, t, GROUP_W).astype(dt)
    out_b = group_rmsnorm(o, gn[GROUP_W:2 * GROUP_W], HG_HEADS) * jax.nn.silu(hgate)
    xcf = xc.astype(f32).reshape(bsz, t, FN_HEADS, FN_DH)
    xfr = jnp.real(jnp.fft.fft2(xcf, axes=(1, 3), norm='ortho')).reshape(bsz, t, GROUP_W).astype(dt)
    out_c = rmsnorm(xfr @ p['fn_w'], gn[2 * GROUP_W:3 * GROUP_W])
    gu = jax.nn.gelu(gu)
    gv = rmsnorm(jax.nn.gelu(gv), p['gm_norm_g'])
    nc = t // GM_CHUNK
    gvc = gv.reshape(bsz, nc, GM_CHUNK, GM_HEADS, GM_DH)
    sp = jnp.einsum('hij,bcjhd->bcihd', p['gm_ws'], gvc) + p['gm_bs'].T[None, None, :, :, None]
    out_d = rmsnorm(gu * sp.reshape(bsz, t, GROUP_W), gn[3 * GROUP_W:])
    out = jnp.concatenate([out_a, out_b, out_c, out_d], axis=-1) @ p['w_out']
    return out, (jnp.stack(fre, axis=1), jnp.stack(fim, axis=1), jnp.stack(sfin, axis=1))


def conv_ffn(h, p, grid):
    z = h @ p['ffn_w_up']
    bsz, t, ch = z.shape
    if grid:
        zg = z.reshape(bsz, t // GRID_W, GRID_W, ch)
        axis = 2
    else:
        zg = z
        axis = 1
    pad = [(0, 0)] * zg.ndim
    pad[axis] = (CONV_W // 2, CONV_W // 2)
    zp = jnp.pad(zg, pad)
    n = zg.shape[axis]
    w = p['ffn_conv_w']
    zc = p['ffn_conv_b'] + lax.slice_in_dim(zp, 0, n, axis=axis) * w[0]
    for j in range(1, CONV_W):
        zc = zc + lax.slice_in_dim(zp, j, j + n, axis=axis) * w[j]
    a, b = jnp.split(zc.reshape(bsz, t, ch), 2, axis=-1)
    return (jax.nn.gelu(a) * b) @ p['ffn_w_down']


def trunk_layer(x, mod, p, lb, s5_h0_re, s5_h0_im, hg_s0, grid):
    sh1, sc1, g1, sh2, sc2, g2 = jnp.split(mod, N_MOD, axis=-1)
    h = rmsnorm(x, p['norm1_g']) * (1.0 + sc1) + sh1
    m, fin = mixer(h, p, lb, s5_h0_re, s5_h0_im, hg_s0)
    x = x + g1 * m
    h = rmsnorm(x, p['norm2_g']) * (1.0 + sc2) + sh2
    x = x + g2 * conv_ffn(h, p, grid)
    return x, fin


def setup_inputs(seed: int = 0) -> dict:
    key = jax.random.key(seed)
    ks = list(jax.random.split(key, 40))
    nrm = lambda i, shape, s: jax.random.normal(ks[i], shape, jnp.float32) * s
    n_idx = jnp.arange(S5_N, dtype=jnp.float32)
    return {
        'x_prompt': nrm(0, (BATCH, SEQ, D_MODEL), 1.0),
        'x_sample': nrm(1, (DEC_BATCH, DEC_SEQ, D_MODEL), 1.0),
        'state_s5_re': nrm(2, (DEC_BATCH, DEPTH, N_DIR, S5_G, S5_N), 0.5),
        'state_s5_im': nrm(3, (DEC_BATCH, DEPTH, N_DIR, S5_G, S5_N), 0.5),
        'state_hgrn': nrm(4, (DEC_BATCH, DEPTH, N_DIR, HG_HEADS, HG_DK, HG_DV), 0.5),
        'c': nrm(5, (DEC_BATCH, D_MODEL), 1.0),
        'c_ctx': nrm(6, (D_MODEL,), 1.0),
        'w_ada': nrm(7, (DEPTH, D_MODEL, N_MOD * D_MODEL), 0.5 / math.sqrt(D_MODEL)),
        'b_ada': nrm(8, (DEPTH, N_MOD * D_MODEL), 0.02),
        'norm1_g': 1.0 + nrm(9, (DEPTH, D_MODEL), 0.02),
        'norm2_g': 1.0 + nrm(10, (DEPTH, D_MODEL), 0.02),
        'w_in': nrm(11, (DEPTH, D_MODEL, D_IN), 1.0 / math.sqrt(D_MODEL)),
        's5_lam_re': -0.5 + nrm(12, (DEPTH, N_DIR, S5_G, S5_N), 0.02),
        's5_lam_im': math.pi * n_idx + nrm(13, (DEPTH, N_DIR, S5_G, S5_N), 0.02),
        's5_log_dt': jax.random.uniform(ks[14], (DEPTH, N_DIR, S5_G), jnp.float32, math.log(1e-3), math.log(1e-1)),
        's5_b_re': nrm(15, (DEPTH, N_DIR, S5_G, S5_N, S5_P), 1.0 / math.sqrt(2 * S5_P)),
        's5_b_im': nrm(16, (DEPTH, N_DIR, S5_G, S5_N, S5_P), 1.0 / math.sqrt(2 * S5_P)),
        's5_c_re': nrm(17, (DEPTH, N_DIR, S5_G, S5_P, S5_N), 1.0 / math.sqrt(2 * S5_N)),
        's5_c_im': nrm(18, (DEPTH, N_DIR, S5_G, S5_P, S5_N), 1.0 / math.sqrt(2 * S5_N)),
        's5_d': nrm(19, (DEPTH, GROUP_W), 1.0),
        's5_w_glu': nrm(20, (DEPTH, GROUP_W, GROUP_W), 1.0 / math.sqrt(GROUP_W)),
        'hg_lb_logits': nrm(21, (DEPTH, N_DIR, GROUP_W), 0.5),
        'fn_w': nrm(22, (DEPTH, GROUP_W, GROUP_W), 1.0 / math.sqrt(GROUP_W)),
        'gm_norm_g': 1.0 + nrm(23, (DEPTH, GROUP_W), 0.02),
        'gm_ws': nrm(24, (DEPTH, GM_HEADS, GM_CHUNK, GM_CHUNK), 1.0 / math.sqrt(GM_CHUNK)),
        'gm_bs': 1.0 + nrm(25, (DEPTH, GM_HEADS, GM_CHUNK), 0.02),
        'grp_norm_g': 1.0 + nrm(26, (DEPTH, D_MODEL), 0.02),
        'w_out': nrm(27, (DEPTH, D_MODEL, D_MODEL), 1.0 / math.sqrt(D_MODEL)),
        'ffn_w_up': nrm(28, (DEPTH, D_MODEL, 2 * D_FF), 1.0 / math.sqrt(D_MODEL)),
        'ffn_conv_w': nrm(29, (DEPTH, CONV_W, 2 * D_FF), 1.0 / math.sqrt(CONV_W)),
        'ffn_conv_b': nrm(30, (DEPTH, 2 * D_FF), 0.02),
        'ffn_w_down': nrm(31, (DEPTH, D_FF, D_MODEL), 1.0 / math.sqrt(D_FF)),
        'final_norm_g': 1.0 + nrm(32, (D_MODEL,), 0.02),
    }


def reference(x_prompt, x_sample, state_s5_re, state_s5_im, state_hgrn, c, c_ctx,
              w_ada, b_ada, norm1_g, norm2_g, w_in, s5_lam_re, s5_lam_im, s5_log_dt,
              s5_b_re, s5_b_im, s5_c_re, s5_c_im, s5_d, s5_w_glu, hg_lb_logits, fn_w,
              gm_norm_g, gm_ws, gm_bs, grp_norm_g, w_out, ffn_w_up, ffn_conv_w, ffn_conv_b,
              ffn_w_down, final_norm_g):
    lb_p = jax.nn.softmax(hg_lb_logits.astype(jnp.float32), axis=0)
    lbs = jnp.maximum(jnp.cumsum(lb_p, axis=0) - lb_p[0], 0.0)
    bp = x_prompt.shape[0]
    z_s5 = jnp.zeros((bp, N_DIR, S5_G, S5_N), jnp.float32)
    z_hg = jnp.zeros((bp, N_DIR, HG_HEADS, HG_DK, HG_DV), jnp.float32)
    xp, xs = x_prompt, x_sample
    new_re, new_im, new_hg = [], [], []
    for l in range(DEPTH):
        p = {'w_in': w_in[l], 'norm1_g': norm1_g[l], 'norm2_g': norm2_g[l],
             's5_lam_re': s5_lam_re[l], 's5_lam_im': s5_lam_im[l], 's5_log_dt': s5_log_dt[l],
             's5_b_re': s5_b_re[l], 's5_b_im': s5_b_im[l], 's5_c_re': s5_c_re[l], 's5_c_im': s5_c_im[l],
             's5_d': s5_d[l], 's5_w_glu': s5_w_glu[l], 'fn_w': fn_w[l], 'gm_norm_g': gm_norm_g[l],
             'gm_ws': gm_ws[l], 'gm_bs': gm_bs[l], 'grp_norm_g': grp_norm_g[l], 'w_out': w_out[l],
             'ffn_w_up': ffn_w_up[l], 'ffn_conv_w': ffn_conv_w[l], 'ffn_conv_b': ffn_conv_b[l],
             'ffn_w_down': ffn_w_down[l]}
        mod_ctx = (jax.nn.silu(c_ctx) @ w_ada[l] + b_ada[l])[None, None, :]
        xp, (fr, fi, fh) = trunk_layer(xp, mod_ctx, p, lbs[l], z_s5, z_s5, z_hg, False)
        new_re.append(fr)
        new_im.append(fi)
        new_hg.append(fh)
        mod_lat = (jax.nn.silu(c) @ w_ada[l] + b_ada[l])[:, None, :]
        xs, _ = trunk_layer(xs, mod_lat, p, lbs[l], state_s5_re[:, l], state_s5_im[:, l], state_hgrn[:, l], True)
    y_prompt = rmsnorm(xp, final_norm_g)
    y_sample = rmsnorm(xs, final_norm_g)
    new_state_s5_re = jnp.stack(new_re, axis=1)
    new_state_s5_im = jnp.stack(new_im, axis=1)
    new_state_hgrn = jnp.stack(new_hg, axis=1)
    return (y_prompt, y_sample, new_state_s5_re, new_state_s5_im, new_state_hgrn)
```

```cpp
#include <hip/hip_runtime.h>
#include <hip/hip_cooperative_groups.h>
#include <cstdio>
namespace cg = cooperative_groups;

typedef unsigned short bf16_t;
using bf16x8 = __attribute__((ext_vector_type(8))) short;
using f32x16 = __attribute__((ext_vector_type(16))) float;
using u32x4 = __attribute__((ext_vector_type(4))) unsigned;
using s16x4 = __attribute__((ext_vector_type(4))) short;
using f32x4 = __attribute__((ext_vector_type(4))) float;
#define LDS_FENCE() asm volatile("" ::: "memory")

#define DI __device__ __forceinline__
#define GAS __attribute__((address_space(1)))
template <class T> DI const GAS T* gptr(const T* p) { return (const GAS T*)p; }
template <class T> DI GAS T* gptr(T* p) { return (GAS T*)p; }
DI float4 ldg4(const float* p) { f32x4 v = *gptr((const f32x4*)p); return make_float4(v[0], v[1], v[2], v[3]); }
DI void stg4(float* p, float4 v) { f32x4 t; t[0] = v.x; t[1] = v.y; t[2] = v.z; t[3] = v.w; *gptr((f32x4*)p) = t; }
DI void stg_us4(unsigned short* p, ushort4 v) { s16x4 t; t[0] = (short)v.x; t[1] = (short)v.y; t[2] = (short)v.z; t[3] = (short)v.w; *gptr((s16x4*)p) = t; }

constexpr int NTOK = 8192;
constexpr int DM = 1024;
constexpr int NWIN = 2560;
constexpr int PLD = 2048;
constexpr int DFF = 2816;
constexpr int DUP = 5632;
constexpr float EPSF = 1e-6f;

constexpr int PC_XA = 0, PC_Q = 256, PC_ZF = 512, PC_V = 1024, PC_GATE = 1280, PC_GU = 1536, PC_GV = 1792;

constexpr size_t SZ_WIN = (size_t)NWIN * 1024 * 2;
constexpr size_t SZ_WOUT = (size_t)1024 * 1024 * 2;
constexpr size_t SZ_WUP = (size_t)DUP * 1024 * 2;
constexpr size_t SZ_WDN = (size_t)1024 * DFF * 2;
constexpr size_t SZ_W256 = (size_t)256 * 256 * 2;
constexpr size_t OFF_WIN = 0;
constexpr size_t OFF_WOUT = OFF_WIN + SZ_WIN;
constexpr size_t OFF_WUP = OFF_WOUT + SZ_WOUT;
constexpr size_t OFF_WDN = OFF_WUP + SZ_WUP;
constexpr size_t OFF_WGLU = OFF_WDN + SZ_WDN;
constexpr size_t OFF_DFTL = OFF_WGLU + SZ_W256;
constexpr size_t OFF_DFTC = OFF_DFTL + (size_t)2048 * 4096 * 2;
constexpr int NKC = 16;
constexpr size_t OFF_ADAP = OFF_DFTC + (size_t)256 * 512 * 2;
constexpr size_t OFF_MOD = OFF_ADAP + (size_t)NKC * 2 * 3 * 6144 * 4;
constexpr size_t OFF_S5A = OFF_MOD + (size_t)2 * 3 * 6144 * 4;
constexpr size_t OFF_S5AL = OFF_S5A + 4096 * 2 * 4;
constexpr size_t OFF_S5BBR = OFF_S5AL + 4096 * 2 * 4;
constexpr size_t OFF_S5BBI = OFF_S5BBR + 4096 * 16 * 4;
constexpr size_t OFF_X = OFF_S5BBI + 4096 * 16 * 4;
constexpr size_t OFF_H = OFF_X + (size_t)NTOK * DM * 4;
constexpr size_t OFF_R1 = OFF_H + (size_t)NTOK * DM * 2;
constexpr size_t OFF_PROJ = OFF_R1;
constexpr size_t OFF_UVT = OFF_PROJ + (size_t)NTOK * PLD * 4;
constexpr size_t OFF_YLOC = OFF_UVT + (size_t)NTOK * 512 * 2;
constexpr size_t OFF_Z = OFF_R1;
constexpr size_t SZ_R1 = (size_t)NTOK * DUP * 2;
constexpr size_t OFF_R2 = OFF_R1 + SZ_R1;
constexpr size_t OFF_HGS = OFF_R2;
constexpr size_t OFF_GCP0 = OFF_HGS + (size_t)2048 * 4096 * 4;
constexpr size_t OFF_GCP1 = OFF_GCP0 + (size_t)NTOK * 256 * 4;
constexpr size_t OFF_HGG = OFF_GCP1 + (size_t)3 * 4096 * 256 * 4;
constexpr size_t OFF_S5E = OFF_HGG + (size_t)2048 * 64 * 4;
constexpr size_t OFF_S5H = OFF_S5E + (size_t)256 * 2 * 16 * 64 * 2 * 4;
constexpr size_t OFF_CMT = OFF_S5H + (size_t)256 * 2 * 16 * 64 * 2 * 4;
constexpr size_t OFF_WSB = OFF_CMT + (size_t)2 * 2 * 16 * 16 * 128 * 2;
constexpr size_t OFF_ACT = OFF_R2;
constexpr int XCD_BAR_WORDS_C = 3456;
constexpr size_t OFF_MU = OFF_WSB + (size_t)2 * 4 * 128 * 128 * 2;
constexpr size_t OFF_WFOLD = OFF_MU + (size_t)2 * 2 * 256 * 256 * 4;
constexpr size_t OFF_BAR = OFF_WFOLD + (size_t)2 * 512 * 1024 * 2;
constexpr size_t WS_NEEDED = OFF_BAR + XCD_BAR_WORDS_C * 4;

constexpr size_t OUT_S5RE = (size_t)NTOK * DM;
constexpr size_t OUT_S5IM = OUT_S5RE + 65536;
constexpr size_t OUT_HG = OUT_S5IM + 65536;

constexpr int SMEM_BYTES = 63488;

struct Params {
  const float* in[33];
  float* out;
  char* ws;
  DI char* wsp() const { return *(char* const volatile __attribute__((address_space(3)))*)(&ws); }
  DI const float* inp(int i) const { return *(const float* const __attribute__((address_space(3)))*)(&in[i]); }
  DI float* outp() const { return *(float* const __attribute__((address_space(3)))*)(&out); }
};

enum { I_XP = 0, I_XS, I_S5RE, I_S5IM, I_HGST, I_C, I_CCTX, I_WADA, I_BADA, I_N1G, I_N2G, I_WIN, I_LAMRE, I_LAMIM, I_LOGDT,
       I_BRE, I_BIM, I_CRE, I_CIM, I_S5D, I_WGLU, I_LBLOG, I_FNW, I_GMNG, I_GMWS, I_GMBS, I_GRPG, I_WOUT, I_WUP, I_CONVW,
       I_CONVB, I_WDN, I_FING };

DI bf16_t f2bf(float x) { unsigned u = __float_as_uint(x); u += 0x7fffu + ((u >> 16) & 1u); return (bf16_t)(u >> 16); }
DI float bf2f(bf16_t b) { return __uint_as_float(((unsigned)b) << 16); }
DI float frcp(float x) { return __builtin_amdgcn_rcpf(x); }
DI float gelu_t(float x) { float u2 = 1.5957691216057308f * (x + 0.044715f * x * x * x); return x * frcp(1.f + __expf(-u2)); }
DI float sigm(float x) { return frcp(1.f + __expf(-x)); }
DI float silu_f(float x) { return x * sigm(x); }
DI int otid() { int t = threadIdx.x; asm volatile("" : "+v"(t)); return t; }
DI int obid() { int b = blockIdx.x; asm volatile("" : "+s"(b)); return b; }
DI unsigned pack_bf2(float a, float b) { return (unsigned)f2bf(a) | ((unsigned)f2bf(b) << 16); }
DI bf16x8 pack8(float a0, float a1, float a2, float a3, float a4, float a5, float a6, float a7) {
  u32x4 v; v[0] = pack_bf2(a0, a1); v[1] = pack_bf2(a2, a3); v[2] = pack_bf2(a4, a5); v[3] = pack_bf2(a6, a7);
  return __builtin_bit_cast(bf16x8, v);
}
DI float wave_sum(float v) {
#pragma unroll
  for (int o = 32; o > 0; o >>= 1) v += __shfl_xor(v, o, 64);
  return v;
}
DI void seq_of_tok(int tok, int& start, int& T) {
  if (tok < 4096) { start = tok & ~255; T = 256; } else { start = 4096 + ((tok - 4096) & ~2047); T = 2048; }
}
DI int cv_of_tok(int tok) { return tok < 4096 ? 0 : 1 + ((tok - 4096) >> 11); }
DI void seq_info(int seq, int& start, int& T) {
  if (seq < 16) { start = seq * 256; T = 256; } else { start = 4096 + (seq - 16) * 2048; T = 2048; }
}


#define XB_TMO      128
#define XB_XCNT(j)  (256  + 64 * (j))
#define XB_XSUB(j)  (1280 + 64 * (j))
#define XB_XGEN(j)  (2304 + 64 * (j))
#define XB_TOP      3328
#define XB_TOPGEN   3392
#define XCD_BAR_WORDS 3456
#define XB_SPIN_CAP (1u << 18)
#define LAS __attribute__((address_space(3)))
DI unsigned xb_ld(unsigned* p) { return __hip_atomic_load((GAS unsigned*)p, __ATOMIC_RELAXED, __HIP_MEMORY_SCOPE_AGENT); }
DI unsigned xb_add(unsigned* p, unsigned v) { return __hip_atomic_fetch_add((GAS unsigned*)p, v, __ATOMIC_RELAXED, __HIP_MEMORY_SCOPE_AGENT); }
DI unsigned xb_xcc_id() { return (unsigned)__builtin_amdgcn_s_getreg((3 << 11) | 20) & 0xFu; }
#define XB_SPIN(cond, bar) do { unsigned _sp = 0; while (cond) { __builtin_amdgcn_s_sleep(1); \
    if ((++_sp & 255u) == 0u) { if (xb_ld(&(bar)[XB_TMO])) break; if (_sp > XB_SPIN_CAP) { atomicAdd(&(bar)[XB_TMO], 1u); break; } } } } while (0)
struct XcdBarrier { unsigned* bar; volatile LAS unsigned* st; };
DI XcdBarrier xcd_barrier_post(unsigned* bar, volatile LAS unsigned* st) {
  XcdBarrier b; b.bar = bar; b.st = st;
  if (threadIdx.x == 0) { unsigned x = xb_xcc_id(); st[2] = x; (void)xb_add(&bar[XB_XCNT(x)], 1u); }
  return b;
}
DI void xcd_barrier_complete(unsigned* bar, unsigned x, unsigned& nloc, unsigned& nx) {
  const unsigned G = gridDim.x * gridDim.y * gridDim.z;
  unsigned sum, cnt, mine, sp = 0u;
  for (;;) {
    sum = 0u; cnt = 0u; mine = 0u;
#pragma unroll
    for (unsigned j = 0; j < 16; ++j) { const unsigned c = xb_ld(&bar[XB_XCNT(j)]); sum += c; cnt += (c > 0u) ? 1u : 0u; mine = (j == x) ? c : mine; }
    if (sum == G) break;
    __builtin_amdgcn_s_sleep(1);
    if ((++sp & 255u) == 0u) { if (xb_ld(&bar[XB_TMO])) break; if (sp > XB_SPIN_CAP) { atomicAdd(&bar[XB_TMO], 1u); break; } }
  }
  nloc = mine > 0u ? mine : 1u; nx = cnt > 0u ? cnt : 1u;
}
DI void xcd_barrier(const XcdBarrier& b) {
  asm volatile("s_waitcnt vmcnt(0)" ::: "memory");
  __syncthreads();
  if (threadIdx.x == 0) {
    unsigned* bar = b.bar;
    asm volatile("" : "+s"(bar));
    __builtin_amdgcn_s_waitcnt(0);
    unsigned nloc = b.st[0], nx = b.st[1]; const unsigned bx = b.st[2];
    if (nloc == 0u) { xcd_barrier_complete(bar, bx, nloc, nx); b.st[0] = nloc; b.st[1] = nx; }
    const unsigned old = xb_add(&bar[XB_XSUB(bx)], 1u);
    const unsigned gen = old / nloc;
    if (old + 1u == (gen + 1u) * nloc) {
      __builtin_amdgcn_fence(__ATOMIC_RELEASE, "agent");
      asm volatile("s_waitcnt vmcnt(0)" ::: "memory");
      const unsigned og = xb_add(&bar[XB_TOP], 1u);
      const unsigned tg = og / nx;
      if (og + 1u == (tg + 1u) * nx) xb_add(&bar[XB_TOPGEN], 1u);
      else XB_SPIN(xb_ld(&bar[XB_TOPGEN]) == tg, bar);
      __builtin_amdgcn_fence(__ATOMIC_ACQUIRE, "agent");
      xb_add(&bar[XB_XGEN(bx)], 1u);
      asm volatile("s_waitcnt vmcnt(0)" ::: "memory");
    } else {
      XB_SPIN(xb_ld(&bar[XB_XGEN(bx)]) == gen, bar);
      __builtin_amdgcn_fence(__ATOMIC_ACQUIRE, "agent");
      asm volatile("s_waitcnt vmcnt(0)" ::: "memory");
    }
  }
  __syncthreads();
}

template <int BM, int BN, class Epi>
DI void gemm_tile(const bf16_t* __restrict__ A, int lda, const bf16_t* __restrict__ Bt, int ldb, int K, char* smem, const Epi& epi) {
  constexpr int LS = 40;
  constexpr int MI = BM / 64, NI = BN / 64;
  constexpr int A_CH = BM * 4 / 256, B_CH = BN * 4 / 256;
  bf16_t* sbase = (bf16_t*)smem;
  const int tid = otid(), lane = tid & 63, w = tid >> 6, wm = w >> 1, wn = w & 1, r = lane & 31, h = lane >> 5;
  f32x16 acc[MI][NI];
#pragma unroll
  for (int mi = 0; mi < MI; ++mi)
#pragma unroll
    for (int ni = 0; ni < NI; ++ni)
#pragma unroll
      for (int i = 0; i < 16; ++i) acc[mi][ni][i] = 0.f;
  u32x4 ra[A_CH], rb[B_CH];
  const int KT = K / 32;
#define GLOAD(kt)                                                                                   \
  {                                                                                                 \
    _Pragma("unroll") for (int i = 0; i < A_CH; ++i) {                                              \
      int c = tid + i * 256; int row = c >> 2, kc = c & 3;                                          \
      ra[i] = *(const u32x4*)(A + (size_t)row * lda + (kt) * 32 + kc * 8);                          \
    }                                                                                               \
    _Pragma("unroll") for (int i = 0; i < B_CH; ++i) {                                              \
      int c = tid + i * 256; int row = c >> 2, kc = c & 3;                                          \
      rb[i] = *(const u32x4*)(Bt + (size_t)row * ldb + (kt) * 32 + kc * 8);                         \
    }                                                                                               \
  }
#define SSTORE(s)                                                                                   \
  {                                                                                                 \
    bf16_t* sa = sbase + (s) * (BM + BN) * LS; bf16_t* sb = sa + BM * LS;                           \
    _Pragma("unroll") for (int i = 0; i < A_CH; ++i) {                                              \
      int c = tid + i * 256; int row = c >> 2, kc = c & 3;                                          \
      *(u32x4*)(sa + row * LS + kc * 8) = ra[i];                                                    \
    }                                                                                               \
    _Pragma("unroll") for (int i = 0; i < B_CH; ++i) {                                              \
      int c = tid + i * 256; int row = c >> 2, kc = c & 3;                                          \
      *(u32x4*)(sb + row * LS + kc * 8) = rb[i];                                                    \
    }                                                                                               \
  }
  GLOAD(0);
  SSTORE(0);
  __syncthreads();
  for (int kt = 0; kt < KT; ++kt) {
    if (kt + 1 < KT) GLOAD(kt + 1);
    const bf16_t* sa = sbase + (kt & 1) * (BM + BN) * LS;
    const bf16_t* sb = sa + BM * LS;
    const bf16_t* a_s = sa + (wm * (BM / 2) + r) * LS + h * 8;
    const bf16_t* b_s = sb + (wn * (BN / 2) + r) * LS + h * 8;
#pragma unroll
    for (int ks = 0; ks < 2; ++ks) {
      bf16x8 af[MI], bfr[NI];
#pragma unroll
      for (int mi = 0; mi < MI; ++mi) af[mi] = *(const bf16x8*)(a_s + mi * 32 * LS + ks * 16);
#pragma unroll
      for (int ni = 0; ni < NI; ++ni) bfr[ni] = *(const bf16x8*)(b_s + ni * 32 * LS + ks * 16);
#pragma unroll
      for (int mi = 0; mi < MI; ++mi)
#pragma unroll
        for (int ni = 0; ni < NI; ++ni) acc[mi][ni] = __builtin_amdgcn_mfma_f32_32x32x16_bf16(af[mi], bfr[ni], acc[mi][ni], 0, 0, 0);
    }
    if (kt + 1 < KT) SSTORE((kt + 1) & 1);
    __syncthreads();
  }
#undef GLOAD
#undef SSTORE
#pragma unroll
  for (int mi = 0; mi < MI; ++mi)
#pragma unroll
    for (int ni = 0; ni < NI; ++ni) {
#pragma unroll
      for (int i = 0; i < 16; ++i) {
        int rr = wm * (BM / 2) + mi * 32 + (i & 3) + 8 * (i >> 2) + 4 * h;
        int cc = wn * (BN / 2) + ni * 32 + r;
        epi(rr, cc, acc[mi][ni][i]);
        if ((i & 3) == 3) __builtin_amdgcn_sched_barrier(0);
      }
    }
}

template <int BM, int BN, class Epi, bool TILE_EPI = false>
DI void gemm_tile64(const bf16_t* __restrict__ A, int lda, const bf16_t* __restrict__ Bt, int ldb, int K, char* smem, const Epi& epi) {
  constexpr int LS = 72;
  constexpr int MI = BM / 64, NI = BN / 64;
  constexpr int A_CH = BM * 8 / 256, B_CH = BN * 8 / 256;
  bf16_t* sa = (bf16_t*)smem;
  bf16_t* sb = sa + BM * LS;
  const int tid = otid(), lane = tid & 63, w = tid >> 6, wm = w >> 1, wn = w & 1, r = lane & 31, h = lane >> 5;
  f32x16 acc[MI][NI];
#pragma unroll
  for (int mi = 0; mi < MI; ++mi)
#pragma unroll
    for (int ni = 0; ni < NI; ++ni)
#pragma unroll
      for (int i = 0; i < 16; ++i) acc[mi][ni][i] = 0.f;
  u32x4 ra[A_CH], rb[B_CH];
  const int KT = K / 64;
  const bf16_t* ag = A + (size_t)(tid >> 3) * lda + (tid & 7) * 8;
  const bf16_t* bg = Bt + (size_t)(tid >> 3) * ldb + (tid & 7) * 8;
  bf16_t* sa_w = sa + (tid >> 3) * LS + (tid & 7) * 8;
  bf16_t* sb_w = sb + (tid >> 3) * LS + (tid & 7) * 8;
#pragma unroll
  for (int i = 0; i < A_CH; ++i) ra[i] = *gptr((const u32x4*)(ag + (size_t)i * 32 * lda));
#pragma unroll
  for (int i = 0; i < B_CH; ++i) rb[i] = *gptr((const u32x4*)(bg + (size_t)i * 32 * ldb));
  const bf16_t* a_s = sa + (wm * (BM / 2) + r) * LS + h * 8;
  const bf16_t* b_s = sb + (wn * (BN / 2) + r) * LS + h * 8;
#pragma unroll 1
  for (int kt = 0; kt < KT; ++kt) {
    __syncthreads();
#pragma unroll
    for (int i = 0; i < A_CH; ++i) *(u32x4*)(sa_w + i * 32 * LS) = ra[i];
#pragma unroll
    for (int i = 0; i < B_CH; ++i) *(u32x4*)(sb_w + i * 32 * LS) = rb[i];
    __syncthreads();
    if (kt + 1 < KT) {
#pragma unroll
      for (int i = 0; i < A_CH; ++i) ra[i] = *gptr((const u32x4*)(ag + (size_t)i * 32 * lda + (kt + 1) * 64));
#pragma unroll
      for (int i = 0; i < B_CH; ++i) rb[i] = *gptr((const u32x4*)(bg + (size_t)i * 32 * ldb + (kt + 1) * 64));
    }
#pragma unroll
    for (int ks = 0; ks < 4; ++ks) {
      bf16x8 af[MI], bfr[NI];
#pragma unroll
      for (int mi = 0; mi < MI; ++mi) af[mi] = *(const bf16x8*)(a_s + mi * 32 * LS + ks * 16);
#pragma unroll
      for (int ni = 0; ni < NI; ++ni) bfr[ni] = *(const bf16x8*)(b_s + ni * 32 * LS + ks * 16);
#pragma unroll
      for (int mi = 0; mi < MI; ++mi)
#pragma unroll
        for (int ni = 0; ni < NI; ++ni) acc[mi][ni] = __builtin_amdgcn_mfma_f32_32x32x16_bf16(af[mi], bfr[ni], acc[mi][ni], 0, 0, 0);
    }
  }
  if constexpr (TILE_EPI) {
    epi.tile(acc, wm, wn, r, h, smem);
  } else {
#pragma unroll
    for (int mi = 0; mi < MI; ++mi)
#pragma unroll
      for (int ni = 0; ni < NI; ++ni) {
#pragma unroll
        for (int i = 0; i < 16; ++i) {
          int rr = wm * (BM / 2) + mi * 32 + (i & 3) + 8 * (i >> 2) + 4 * h;
          int cc = wn * (BN / 2) + ni * 32 + r;
          epi(rr, cc, acc[mi][ni][i]);
          if ((i & 3) == 3) __builtin_amdgcn_sched_barrier(0);
        }
      }
  }
  __syncthreads();
}

template <class Epi>
DI void gemm_tile64_pf2(const bf16_t* __restrict__ A, int lda, const bf16_t* __restrict__ Bt, int ldb, int K, char* smem, const Epi& epi) {
  constexpr int BM = 128, BN = 128, LS = 72, MI = 2, NI = 2, CH = 4;
  bf16_t* sa = (bf16_t*)smem;
  bf16_t* sb = sa + BM * LS;
  const int tid = otid(), lane = tid & 63, w = tid >> 6, wm = w >> 1, wn = w & 1, r = lane & 31, h = lane >> 5;
  f32x16 acc[MI][NI];
#pragma unroll
  for (int mi = 0; mi < MI; ++mi)
#pragma unroll
    for (int ni = 0; ni < NI; ++ni)
#pragma unroll
      for (int i = 0; i < 16; ++i) acc[mi][ni][i] = 0.f;
  u32x4 ra0[CH], rb0[CH], ra1[CH], rb1[CH];
  const int KT = K / 64;
  const bf16_t* ag = A + (size_t)(tid >> 3) * lda + (tid & 7) * 8;
  const bf16_t* bg = Bt + (size_t)(tid >> 3) * ldb + (tid & 7) * 8;
  bf16_t* sa_w = sa + (tid >> 3) * LS + (tid & 7) * 8;
  bf16_t* sb_w = sb + (tid >> 3) * LS + (tid & 7) * 8;
#pragma unroll
  for (int i = 0; i < CH; ++i) { ra0[i] = *gptr((const u32x4*)(ag + (size_t)i * 32 * lda)); rb0[i] = *gptr((const u32x4*)(bg + (size_t)i * 32 * ldb)); }
#pragma unroll
  for (int i = 0; i < CH; ++i) { ra1[i] = *gptr((const u32x4*)(ag + (size_t)i * 32 * lda + 64)); rb1[i] = *gptr((const u32x4*)(bg + (size_t)i * 32 * ldb + 64)); }
  const bf16_t* a_s = sa + (wm * (BM / 2) + r) * LS + h * 8;
  const bf16_t* b_s = sb + (wn * (BN / 2) + r) * LS + h * 8;
#define PF2_COMPUTE()                                                                                  \
  _Pragma("unroll") for (int ks = 0; ks < 4; ++ks) {                                                   \
    bf16x8 af[MI], bfr[NI];                                                                            \
    _Pragma("unroll") for (int mi = 0; mi < MI; ++mi) af[mi] = *(const bf16x8*)(a_s + mi * 32 * LS + ks * 16);   \
    _Pragma("unroll") for (int ni = 0; ni < NI; ++ni) bfr[ni] = *(const bf16x8*)(b_s + ni * 32 * LS + ks * 16);  \
    _Pragma("unroll") for (int mi = 0; mi < MI; ++mi)                                                  \
      _Pragma("unroll") for (int ni = 0; ni < NI; ++ni)                                                \
        acc[mi][ni] = __builtin_amdgcn_mfma_f32_32x32x16_bf16(af[mi], bfr[ni], acc[mi][ni], 0, 0, 0);  \
  }
#pragma unroll 1
  for (int kt = 0; kt < KT; kt += 2) {
    __syncthreads();
#pragma unroll
    for (int i = 0; i < CH; ++i) { *(u32x4*)(sa_w + i * 32 * LS) = ra0[i]; *(u32x4*)(sb_w + i * 32 * LS) = rb0[i]; }
    __syncthreads();
    if (kt + 2 < KT) {
#pragma unroll
      for (int i = 0; i < CH; ++i) { ra0[i] = *gptr((const u32x4*)(ag + (size_t)i * 32 * lda + (kt + 2) * 64)); rb0[i] = *gptr((const u32x4*)(bg + (size_t)i * 32 * ldb + (kt + 2) * 64)); }
    }
    PF2_COMPUTE();
    __syncthreads();
#pragma unroll
    for (int i = 0; i < CH; ++i) { *(u32x4*)(sa_w + i * 32 * LS) = ra1[i]; *(u32x4*)(sb_w + i * 32 * LS) = rb1[i]; }
    __syncthreads();
    if (kt + 3 < KT) {
#pragma unroll
      for (int i = 0; i < CH; ++i) { ra1[i] = *gptr((const u32x4*)(ag + (size_t)i * 32 * lda + (kt + 3) * 64)); rb1[i] = *gptr((const u32x4*)(bg + (size_t)i * 32 * ldb + (kt + 3) * 64)); }
    }
    PF2_COMPUTE();
  }
#undef PF2_COMPUTE
#pragma unroll
  for (int mi = 0; mi < MI; ++mi)
#pragma unroll
    for (int ni = 0; ni < NI; ++ni) {
#pragma unroll
      for (int i = 0; i < 16; ++i) {
        int rr = wm * (BM / 2) + mi * 32 + (i & 3) + 8 * (i >> 2) + 4 * h;
        int cc = wn * (BN / 2) + ni * 32 + r;
        epi(rr, cc, acc[mi][ni][i]);
        if ((i & 3) == 3) __builtin_amdgcn_sched_barrier(0);
      }
    }
  __syncthreads();
}

DI bool xcd_tile(int k, int MT, int NT, int& mt, int& nt) {
  const int b = obid(), G = gridDim.x;
  if ((G & 7) == 0) {
    int xcd = b & 7, local = b >> 3, per = (MT >> 3) * NT, idx = local + k * (G >> 3);
    if (idx >= per) return false;
    mt = (idx / NT) * 8 + xcd; nt = idx % NT; return true;
  }
  int idx = b + k * G; if (idx >= MT * NT) return false;
  mt = idx / NT; nt = idx % NT; return true;
}

struct EpiG1 {
  float* proj; bf16_t* uvt; int m0, n0;
  DI void operator()(int r, int c, float v) const {
    int tok = m0 + r, n = n0 + c;
    if (n < 1536) gptr(proj)[(size_t)tok * PLD + n] = v;
    else if (n >= 2048) gptr(proj)[(size_t)tok * PLD + n - 512] = v;
    else {
      int cc = n - 1536; int part = cc >> 8, ch = cc & 255; int start, T; seq_of_tok(tok, start, T);
      gptr(uvt)[(size_t)512 * start + (size_t)ch * 2 * T + part * T + (tok - start)] = f2bf(v);
    }
  }
};
struct EpiStoreBf { bf16_t* dst; int ld; DI void operator()(int r, int c, float v) const { dst[(size_t)r * ld + c] = f2bf(v); } };
struct EpiStoreF { float* dst; int ld; DI void operator()(int r, int c, float v) const { gptr(dst)[(size_t)r * ld + c] = v; } };
struct EpiResid {
  float* x; const float* gate; int m0, n0;
  const float* xp; const float* xs;
  DI void operator()(int r, int c, float v) const {
    int tok = m0 + r, col = n0 + c; size_t i = (size_t)tok * DM + col;
    float xin = xp ? (tok < 4096 ? gptr(xp)[i] : gptr(xs)[i - (size_t)4096 * DM]) : gptr(x)[i];
    gptr(x)[i] = xin + gptr(gate)[cv_of_tok(tok) * 6144 + col] * v;
  }
};

struct EpiConvGate {
  bf16_t* act; const float* cw; const float* cb; int m0; int nt; bool ctx;
  DI void tile(f32x16 (&acc)[4][2], int wm, int wn, int r, int h, char* smem) const {
    const int j = nt * 64 + wn * 32 + r;
    float w0[2], w1[2], w2[2], bs[2];
#pragma unroll
    for (int ni = 0; ni < 2; ++ni) {
      int ch = ni * DFF + j;
      w0[ni] = gptr(cw)[ch]; w1[ni] = gptr(cw)[DUP + ch]; w2[ni] = gptr(cw)[2 * DUP + ch]; bs[ni] = gptr(cb)[ch];
    }
    float* edge = (float*)smem;
    __syncthreads();
#pragma unroll
    for (int ni = 0; ni < 2; ++ni) {
      if (h == 0) edge[((((wm * 2 + wn) * 2 + ni) * 2) + 0) * 32 + r] = acc[0][ni][0];
      else        edge[((((wm * 2 + wn) * 2 + ni) * 2) + 1) * 32 + r] = acc[3][ni][15];
    }
    __syncthreads();
    float up_edge[2], dn_edge[2];
#pragma unroll
    for (int ni = 0; ni < 2; ++ni) {
      float ue = edge[((((0 * 2 + wn) * 2 + ni) * 2) + 1) * 32 + r];
      float de = edge[((((1 * 2 + wn) * 2 + ni) * 2) + 0) * 32 + r];
      up_edge[ni] = (ctx && wm == 1) ? ue : 0.f;
      dn_edge[ni] = (ctx && wm == 0) ? de : 0.f;
    }
    float Bp[2][4], Tp[2][4];
#pragma unroll
    for (int ni = 0; ni < 2; ++ni)
#pragma unroll
      for (int mi = 0; mi < 4; ++mi) {
        Bp[ni][mi] = __shfl_xor(acc[mi][ni][15], 32, 64);
        Tp[ni][mi] = __shfl_xor(acc[mi][ni][0], 32, 64);
      }
#pragma unroll
    for (int mi = 0; mi < 4; ++mi) {
      float zc[2][16];
#pragma unroll
      for (int ni = 0; ni < 2; ++ni) {
        float prev_in = (mi == 0) ? up_edge[ni] : ((mi == 2 && !ctx) ? 0.f : Bp[ni][mi > 0 ? mi - 1 : 0]);
        float next_in = (mi == 3) ? dn_edge[ni] : ((mi == 1 && !ctx) ? 0.f : Tp[ni][mi < 3 ? mi + 1 : 3]);
        float rp[4], rn[4];
#pragma unroll
        for (int g = 0; g < 4; ++g) {
          float sp_ = (h == 0) ? acc[mi][ni][4 * g + 3] : acc[mi][ni][g > 0 ? 4 * g - 1 : 0];
          float sn_ = (h == 1) ? acc[mi][ni][4 * g] : acc[mi][ni][g < 3 ? 4 * g + 4 : 15];
          rp[g] = __shfl_xor(sp_, 32, 64);
          rn[g] = __shfl_xor(sn_, 32, 64);
        }
#pragma unroll
        for (int e = 0; e < 16; ++e) {
          const int g = e >> 2;
          float pv, nx;
          if ((e & 3) != 0) pv = acc[mi][ni][e - 1];
          else pv = (h == 1) ? rp[g] : (g > 0 ? rp[g] : prev_in);
          if ((e & 3) != 3) nx = acc[mi][ni][e + 1];
          else nx = (h == 0) ? rn[g] : (g < 3 ? rn[g] : next_in);
          zc[ni][e] = bs[ni] + w0[ni] * pv + w1[ni] * acc[mi][ni][e] + w2[ni] * nx;
        }
      }
#pragma unroll
      for (int e = 0; e < 16; ++e) {
        int row = m0 + wm * 128 + mi * 32 + (e & 3) + 8 * (e >> 2) + 4 * h;
        gptr(act)[(size_t)row * DFF + j] = f2bf(gelu_t(zc[0][e]) * zc[1][e]);
        if ((e & 3) == 3) __builtin_amdgcn_sched_barrier(0);
      }
    }
  }
};

DI void ph_convert_weights(const Params& p, int l, char* smem, bool skip_fold = false) {
  float(*tile)[65] = (float(*)[65])smem;
  float(*t1)[65] = (float(*)[65])(smem + 64 * 65 * 4);
  float(*t2)[65] = (float(*)[65])(smem + 2 * 64 * 65 * 4);
  float* tw = (float*)(smem + 3 * 64 * 65 * 4);
  const int tid = otid();
  constexpr int N_IT = 640 + 256 + 1408 + 704 + 16;
  for (int it = obid(); it < N_IT; it += gridDim.x) {
    const float* src; bf16_t* dst; int K, Nsrc, n0, k0, sc0, fold = -1; bool wup_perm = false;
    int j = it;
    if (j < 640) {
      int nt = j / 16, kt = j % 16; src = p.inp(I_WIN) + (size_t)l * 1024 * 2304; K = 1024; Nsrc = 2304; n0 = nt * 64; k0 = kt * 64;
      dst = (bf16_t*)(p.wsp() + OFF_WIN);
      if (n0 < 1536) sc0 = n0;
      else if (n0 < 2048) { int cc = n0 - 1536; fold = cc >> 8; sc0 = cc & 255; }
      else sc0 = n0 - 256;
    } else if ((j -= 640) < 256) {
      int nt = j / 16, kt = j % 16; src = p.inp(I_WOUT) + (size_t)l * 1024 * 1024; K = 1024; Nsrc = 1024; n0 = nt * 64; k0 = kt * 64; sc0 = n0;
      dst = (bf16_t*)(p.wsp() + OFF_WOUT);
    } else if ((j -= 256) < 1408) {
      int nt = j / 16, kt = j % 16; src = p.inp(I_WUP) + (size_t)l * 1024 * DUP; K = 1024; Nsrc = DUP; n0 = nt * 64; k0 = kt * 64; sc0 = n0;
      dst = (bf16_t*)(p.wsp() + OFF_WUP); wup_perm = true;
    } else if ((j -= 1408) < 704) {
      int nt = j / 44, kt = j % 44; src = p.inp(I_WDN) + (size_t)l * DFF * 1024; K = DFF; Nsrc = 1024; n0 = nt * 64; k0 = kt * 64; sc0 = n0;
      dst = (bf16_t*)(p.wsp() + OFF_WDN);
    } else {
      j -= 704; int nt = j / 4, kt = j % 4; src = p.inp(I_WGLU) + (size_t)l * 65536; K = 256; Nsrc = 256; n0 = nt * 64; k0 = kt * 64; sc0 = n0;
      dst = (bf16_t*)(p.wsp() + OFF_WGLU);
    }
    if (fold < 0) {
#pragma unroll
      for (int i = 0; i < 16; ++i) {
        int kk = (tid >> 6) + 4 * i, nn = tid & 63;
        int sc = sc0 + nn;
        if (wup_perm) sc = ((nn & 32) ? DFF : 0) + (n0 >> 7) * 64 + ((n0 >> 6) & 1) * 32 + (nn & 31);
        tile[kk][nn] = gptr(src)[(size_t)(k0 + kk) * Nsrc + sc];
      }
      __syncthreads();
#pragma unroll
      for (int i = 0; i < 16; ++i) {
        int kk = tid & 63, nn = (tid >> 6) + 4 * i;
        gptr(dst)[(size_t)(n0 + nn) * K + k0 + kk] = f2bf(tile[kk][nn]);
      }
      __syncthreads();
    } else if (!skip_fold) {
      const bf16_t* wf = (const bf16_t*)(p.wsp() + OFF_WFOLD) + (size_t)l * 512 * 1024;
#pragma unroll
      for (int i = 0; i < 16; ++i) {
        int kk = tid & 63, nn = (tid >> 6) + 4 * i;
        gptr(dst)[(size_t)(n0 + nn) * K + k0 + kk] = gptr(wf)[(size_t)(n0 - 1536 + nn) * 1024 + k0 + kk];
      }
      __syncthreads();
    }
  }
}

DI void ph_mu(const Params& p, char* smem) {
  float(*t1)[65] = (float(*)[65])smem;
  float* tw = (float*)(smem + 64 * 65 * 4);
  const int tid = otid();
  float* mu = (float*)(p.wsp() + OFF_MU);
  for (int it = obid(); it < 64; it += gridDim.x) {
    int ct = it & 3, hd = (it >> 2) & 3, part = (it >> 4) & 1, l = it >> 5;
    const float* fnw = p.inp(I_FNW) + (size_t)l * 65536;
    __syncthreads();
    if (tid < 64) tw[tid] = (part == 0) ? cospif((float)tid / 32.f) : sinpif((float)tid / 32.f);
#pragma unroll
    for (int i = 0; i < 16; ++i) { int rr = (tid >> 6) + 4 * i, cc = tid & 63; t1[rr][cc] = gptr(fnw)[(size_t)(hd * 64 + rr) * 256 + ct * 64 + cc]; }
    __syncthreads();
#pragma unroll 1
    for (int i = 0; i < 16; ++i) {
      int jj = (tid >> 6) + 4 * i, cc = tid & 63;
      float sacc = 0.f;
#pragma unroll 8
      for (int kk = 0; kk < 64; ++kk) sacc += tw[(jj * kk) & 63] * t1[kk][cc];
      gptr(mu)[((size_t)(l * 2 + part) * 256 + hd * 64 + jj) * 256 + ct * 64 + cc] = 0.125f * sacc;
    }
  }
  __syncthreads();
}
DI void ph_fold(const Params& p, char* smem) {
  float(*t0)[65] = (float(*)[65])smem;
  float(*t2)[65] = (float(*)[65])(smem + 64 * 65 * 4);
  const int tid = otid();
  const float* mu = (const float*)(p.wsp() + OFF_MU);
  bf16_t* wf = (bf16_t*)(p.wsp() + OFF_WFOLD);
  for (int it = obid(); it < 256; it += gridDim.x) {
    int ct = it & 3, kt = (it >> 2) & 15, part = (it >> 6) & 1, l = it >> 7;
    const float* src = p.inp(I_WIN) + (size_t)l * 1024 * 2304;
    float acc[16];
#pragma unroll
    for (int i = 0; i < 16; ++i) acc[i] = 0.f;
#pragma unroll 1
    for (int hd = 0; hd < 4; ++hd) {
      __syncthreads();
#pragma unroll
      for (int i = 0; i < 16; ++i) {
        int rr = (tid >> 6) + 4 * i, cc = tid & 63;
        t0[rr][cc] = gptr(src)[(size_t)(kt * 64 + rr) * 2304 + 1536 + hd * 64 + cc];
        t2[rr][cc] = gptr(mu)[((size_t)(l * 2 + part) * 256 + hd * 64 + rr) * 256 + ct * 64 + cc];
      }
      __syncthreads();
      const int kk = tid & 63;
#pragma unroll 2
      for (int jj = 0; jj < 64; ++jj) {
        float a = t0[kk][jj];
#pragma unroll
        for (int i = 0; i < 16; ++i) acc[i] += a * t2[jj][(tid >> 6) + 4 * i];
      }
    }
#pragma unroll
    for (int i = 0; i < 16; ++i) {
      int kk = tid & 63, nn = (tid >> 6) + 4 * i;
      gptr(wf)[((size_t)l * 512 + part * 256 + ct * 64 + nn) * 1024 + kt * 64 + kk] = f2bf(acc[i]);
    }
  }
  __syncthreads();
}

DI void ph_fold_copy(const Params& p, int l) {
  const int gtid = obid() * 256 + otid(), gsz = gridDim.x * 256;
  const u32x4* src = (const u32x4*)(p.wsp() + OFF_WFOLD + (size_t)l * 512 * 1024 * 2);
  u32x4* dst = (u32x4*)(p.wsp() + OFF_WIN + (size_t)1536 * 1024 * 2);
  for (int e = gtid; e < 512 * 1024 / 8; e += gsz) dst[e] = src[e];
}

DI void ph_prep(const Params& p, char* smem) {
  const int tid = otid();
  ph_convert_weights(p, 0, smem, true);
  {
    float* sl = (float*)smem;
    float* red = sl + 192;
    float* adap = (float*)(p.wsp() + OFF_ADAP);
    for (int it = obid(); it < 2 * 24 * NKC; it += gridDim.x) {
      int kc = it % NKC, nc = (it / NKC) % 24, l = it / (NKC * 24);
      if (tid < 192) {
        int cv = tid >> 6, kk = tid & 63; int k = kc * 64 + kk;
        float cval = (cv == 0) ? p.inp(I_CCTX)[k] : p.inp(I_C)[(cv - 1) * 1024 + k];
        sl[tid] = silu_f(cval);
      }
      __syncthreads();
      int rg = tid >> 6, lane = tid & 63;
      float a0[4] = {0, 0, 0, 0}, a1[4] = {0, 0, 0, 0}, a2[4] = {0, 0, 0, 0};
      const float* wsrc = p.inp(I_WADA) + (size_t)l * 1024 * 6144 + nc * 256 + lane * 4;
#pragma unroll 4
      for (int i = 0; i < 16; ++i) {
        int kk = rg * 16 + i;
        float4 wv = ldg4(wsrc + (size_t)(kc * 64 + kk) * 6144);
        float s0 = sl[kk], s1 = sl[64 + kk], s2 = sl[128 + kk];
        a0[0] += s0 * wv.x; a0[1] += s0 * wv.y; a0[2] += s0 * wv.z; a0[3] += s0 * wv.w;
        a1[0] += s1 * wv.x; a1[1] += s1 * wv.y; a1[2] += s1 * wv.z; a1[3] += s1 * wv.w;
        a2[0] += s2 * wv.x; a2[1] += s2 * wv.y; a2[2] += s2 * wv.z; a2[3] += s2 * wv.w;
      }
#pragma unroll
      for (int q = 0; q < 4; ++q) {
        red[(rg * 3 + 0) * 256 + lane * 4 + q] = a0[q];
        red[(rg * 3 + 1) * 256 + lane * 4 + q] = a1[q];
        red[(rg * 3 + 2) * 256 + lane * 4 + q] = a2[q];
      }
      __syncthreads();
#pragma unroll
      for (int cv = 0; cv < 3; ++cv) {
        float s = red[(0 * 3 + cv) * 256 + tid] + red[(1 * 3 + cv) * 256 + tid] + red[(2 * 3 + cv) * 256 + tid] + red[(3 * 3 + cv) * 256 + tid];
        adap[((size_t)(kc * 2 + l) * 3 + cv) * 6144 + nc * 256 + tid] = s;
      }
      __syncthreads();
    }
  }
  const int gtid = obid() * 256 + tid, gsz = gridDim.x * 256;
  {
    float* s5a = (float*)(p.wsp() + OFF_S5A); float* s5al = (float*)(p.wsp() + OFF_S5AL);
    float* bbr = (float*)(p.wsp() + OFF_S5BBR); float* bbi = (float*)(p.wsp() + OFF_S5BBI);
    for (int e = gtid; e < 4096 * 16; e += gsz) {
      int idx = e >> 4, pp = e & 15;
      float lr = fminf(p.inp(I_LAMRE)[idx], -1e-4f), li = p.inp(I_LAMIM)[idx];
      float dt = expf(p.inp(I_LOGDT)[idx >> 6]);
      float mag = expf(lr * dt), ang = li * dt;
      float are = mag * cosf(ang), aim = mag * sinf(ang);
      float den = lr * lr + li * li, xr = are - 1.f;
      float zre = (xr * lr + aim * li) / den, zim = (aim * lr - xr * li) / den;
      float br = p.inp(I_BRE)[e], bi = p.inp(I_BIM)[e];
      bbr[e] = zre * br - zim * bi;
      bbi[e] = zre * bi + zim * br;
      if (pp == 0) {
        s5a[idx * 2] = are; s5a[idx * 2 + 1] = aim;
        float pr = are, pi = aim;
#pragma unroll
        for (int q = 0; q < 5; ++q) { float nr = pr * pr - pi * pi, ni = 2.f * pr * pi; pr = nr; pi = ni; }
        s5al[idx * 2] = pr; s5al[idx * 2 + 1] = pi;
      }
    }
  }
  {
    bf16_t* cmt = (bf16_t*)(p.wsp() + OFF_CMT);
    for (int e = gtid; e < 2 * 2 * 16 * 16 * 128; e += gsz) {
      int k = e & 127, row = e >> 7; int n = k >> 1;
      float v = (k & 1) ? -p.inp(I_CIM)[(size_t)row * 64 + n] : p.inp(I_CRE)[(size_t)row * 64 + n];
      cmt[e] = f2bf(v);
    }
    bf16_t* wsb = (bf16_t*)(p.wsp() + OFF_WSB);
    for (int e = gtid; e < 2 * 4 * 128 * 128; e += gsz) wsb[e] = f2bf(p.inp(I_GMWS)[e]);
  }
  {
    float* ctab = (float*)smem; float* stab = ctab + 2048;
    __syncthreads();
    for (int m = tid; m < 2048; m += 256) { float a = (float)m / 1024.f; ctab[m] = cospif(a) * 0.02209708691207961f; stab[m] = -sinpif(a) * 0.02209708691207961f; }
    __syncthreads();
    bf16_t* dl = (bf16_t*)(p.wsp() + OFF_DFTL);
    for (int e = gtid; e < 2048 * 256; e += gsz) {
      int t = e >> 8, s0 = (e & 255) * 8;
      float c[8], sn[8];
#pragma unroll
      for (int q = 0; q < 8; ++q) { int m = (t * (s0 + q)) & 2047; c[q] = ctab[m]; sn[q] = stab[m]; }
      *(bf16x8*)(dl + (size_t)t * 4096 + s0) = pack8(c[0], c[1], c[2], c[3], c[4], c[5], c[6], c[7]);
      *(bf16x8*)(dl + (size_t)t * 4096 + 2048 + s0) = pack8(sn[0], sn[1], sn[2], sn[3], sn[4], sn[5], sn[6], sn[7]);
    }
    bf16_t* dc = (bf16_t*)(p.wsp() + OFF_DFTC);
    const float rs = 0.0625f / 0.02209708691207961f;
    for (int e = gtid; e < 256 * 256; e += gsz) {
      int t = e >> 8, s2 = e & 255; int m = ((t * s2) & 255) * 8;
      dc[t * 512 + s2] = f2bf(ctab[m] * rs);
      dc[t * 512 + 256 + s2] = f2bf(stab[m] * rs);
    }
    __syncthreads();
  }
}

DI void ph_mod_reduce(const Params& p) {
  const int gtid = obid() * 256 + otid(), gsz = gridDim.x * 256;
  const float* adap = (const float*)(p.wsp() + OFF_ADAP); float* mod = (float*)(p.wsp() + OFF_MOD);
  for (int e = gtid; e < 2 * 3 * 6144; e += gsz) {
    int n = e % 6144, l = e / (3 * 6144);
    float s = p.inp(I_BADA)[l * 6144 + n];
    for (int kc = 0; kc < NKC; ++kc) s += gptr(adap)[(size_t)kc * 2 * 3 * 6144 + e];
    mod[e] = s;
  }
}

DI void ph_norm_mod(const Params& p, int l, const float* gnorm, int sh_off, int sc_off, bool from_input = false) {
  const int tid_ = otid(); const int lane = tid_ & 63, w = tid_ >> 6;
  const float* x = (const float*)(p.wsp() + OFF_X); bf16_t* hb = (bf16_t*)(p.wsp() + OFF_H);
  const float* mod = (const float*)(p.wsp() + OFF_MOD) + (size_t)l * 3 * 6144;
  for (int tok = obid() * 4 + w; tok < NTOK; tok += gridDim.x * 4) {
    const float* xr = from_input ? (tok < 4096 ? p.inp(I_XP) + (size_t)tok * DM : p.inp(I_XS) + (size_t)(tok - 4096) * DM) : x + (size_t)tok * DM;
    float4 v[4]; float ss = 0.f;
#pragma unroll
    for (int i = 0; i < 4; ++i) { v[i] = ldg4(xr + i * 256 + lane * 4); ss += v[i].x * v[i].x + v[i].y * v[i].y + v[i].z * v[i].z + v[i].w * v[i].w; }
    ss = wave_sum(ss);
    float rstd = rsqrtf(ss * (1.f / 1024.f) + EPSF);
    const float* mm = mod + cv_of_tok(tok) * 6144;
#pragma unroll
    for (int i = 0; i < 4; ++i) {
      int col = i * 256 + lane * 4;
      float4 g = ldg4(gnorm + col); float4 sc = ldg4(mm + sc_off + col); float4 sh = ldg4(mm + sh_off + col);
      ushort4 o;
      o.x = f2bf(v[i].x * rstd * g.x * (1.f + sc.x) + sh.x);
      o.y = f2bf(v[i].y * rstd * g.y * (1.f + sc.y) + sh.y);
      o.z = f2bf(v[i].z * rstd * g.z * (1.f + sc.z) + sh.z);
      o.w = f2bf(v[i].w * rstd * g.w * (1.f + sc.w) + sh.w);
      stg_us4(hb + (size_t)tok * DM + col, o);
    }
  }
}

DI void ph_final_norm(const Params& p) {
  const int tid_ = otid(); const int lane = tid_ & 63, w = tid_ >> 6;
  const float* x = (const float*)(p.wsp() + OFF_X);
  const float* g = p.inp(I_FING);
  for (int tok = obid() * 4 + w; tok < NTOK; tok += gridDim.x * 4) {
    const float* xr = x + (size_t)tok * DM;
    float4 v[4]; float ss = 0.f;
#pragma unroll
    for (int i = 0; i < 4; ++i) { v[i] = ldg4(xr + i * 256 + lane * 4); ss += v[i].x * v[i].x + v[i].y * v[i].y + v[i].z * v[i].z + v[i].w * v[i].w; }
    ss = wave_sum(ss);
    float rstd = rsqrtf(ss * (1.f / 1024.f) + EPSF);
#pragma unroll
    for (int i = 0; i < 4; ++i) {
      int col = i * 256 + lane * 4; float4 gg = ldg4(g + col);
      float4 o; o.x = v[i].x * rstd * gg.x; o.y = v[i].y * rstd * gg.y; o.z = v[i].z * rstd * gg.z; o.w = v[i].w * rstd * gg.w;
      stg4(p.outp() + (size_t)tok * DM + col, o);
    }
  }
}

DI void ph_gemm_in(const Params& p, char* smem) {
  const bf16_t* A = (const bf16_t*)(p.wsp() + OFF_H); const bf16_t* Bt = (const bf16_t*)(p.wsp() + OFF_WIN);
  int mt, nt;
  for (int k = 0; xcd_tile(k, 64, 20, mt, nt); ++k) {
    EpiG1 epi{(float*)(p.wsp() + OFF_PROJ), (bf16_t*)(p.wsp() + OFF_UVT), mt * 128, nt * 128};
    gemm_tile64_pf2(A + (size_t)mt * 128 * 1024, 1024, Bt + (size_t)nt * 128 * 1024, 1024, 1024, smem, epi);
  }
}
DI void ph_gemm_out(const Params& p, int l, char* smem) {
  int mt, nt;
  for (int k = 0; xcd_tile(k, 64, 8, mt, nt); ++k) {
    EpiResid epi{(float*)(p.wsp() + OFF_X), (const float*)(p.wsp() + OFF_MOD) + (size_t)l * 3 * 6144 + 2048, mt * 128, nt * 128, l == 0 ? p.inp(I_XP) : nullptr, l == 0 ? p.inp(I_XS) : nullptr};
    gemm_tile64_pf2((const bf16_t*)(p.wsp() + OFF_H) + (size_t)mt * 128 * 1024, 1024, (const bf16_t*)(p.wsp() + OFF_WOUT) + (size_t)nt * 128 * 1024, 1024, 1024, smem, epi);
  }
}
DI void ph_gemm_up(const Params& p, int l, char* smem) {
  int mt, nt;
  for (int k = 0; xcd_tile(k, 32, 44, mt, nt); ++k) {
    EpiConvGate epi{(bf16_t*)(p.wsp() + OFF_ACT), p.inp(I_CONVW) + (size_t)l * 3 * DUP, p.inp(I_CONVB) + (size_t)l * DUP, mt * 256, nt, mt < 16};
    gemm_tile64<256, 128, EpiConvGate, true>((const bf16_t*)(p.wsp() + OFF_H) + (size_t)mt * 256 * 1024, 1024, (const bf16_t*)(p.wsp() + OFF_WUP) + (size_t)nt * 128 * 1024, 1024, 1024, smem, epi);
  }
}
DI void ph_gemm_down(const Params& p, int l, char* smem) {
  int mt, nt;
  for (int k = 0; xcd_tile(k, 64, 8, mt, nt); ++k) {
    EpiResid epi{(float*)(p.wsp() + OFF_X), (const float*)(p.wsp() + OFF_MOD) + (size_t)l * 3 * 6144 + 5120, mt * 128, nt * 128, nullptr, nullptr};
    gemm_tile64_pf2((const bf16_t*)(p.wsp() + OFF_ACT) + (size_t)mt * 128 * DFF, DFF, (const bf16_t*)(p.wsp() + OFF_WDN) + (size_t)nt * 128 * DFF, DFF, DFF, smem, epi);
  }
}

DI void ph_scans(const Params& p, int l) {
  const int gtid = obid() * 256 + otid(), gsz = gridDim.x * 256;
  {
    float* hgs = (float*)(p.wsp() + OFF_HGS); const float* hgg = (const float*)(p.wsp() + OFF_HGG);
    for (int e = gtid; e < 18 * 2 * 4 * 4096; e += gsz) {
      int k = e & 63, v = (e >> 6) & 63, hd = (e >> 12) & 3, d = (e >> 14) & 1, seq = e >> 15;
      int start, T; seq_info(seq, start, T);
      int nc = T >> 5, cb = start >> 5;
      float S = 0.f;
      if (seq >= 16) S = p.inp(I_HGST)[((((size_t)(seq - 16) * 2 + l) * 2 + d) * 4 + hd) * 4096 + k * 64 + v];
      for (int s0 = 0; s0 < nc; s0 += 8) {
        float tv[8], gv[8];
#pragma unroll
        for (int u = 0; u < 8; ++u) {
          int s = s0 + u; int cc = d ? nc - 1 - s : s; size_t idx = (size_t)((cb + cc) * 2 + d) * 4 + hd;
          tv[u] = gptr(hgs)[idx * 4096 + v * 64 + k]; gv[u] = gptr(hgg)[idx * 64 + k];
        }
#pragma unroll
        for (int u = 0; u < 8; ++u) {
          int s = s0 + u; int cc = d ? nc - 1 - s : s; size_t idx = (size_t)((cb + cc) * 2 + d) * 4 + hd;
          gptr(hgs)[idx * 4096 + v * 64 + k] = S;
          S = gv[u] * S + tv[u];
        }
      }
      if (seq < 16) p.outp()[OUT_HG + ((((size_t)seq * 2 + l) * 2 + d) * 4 + hd) * 4096 + k * 64 + v] = S;
    }
  }
  {
    const float* s5e = (const float*)(p.wsp() + OFF_S5E); float* s5h = (float*)(p.wsp() + OFF_S5H);
    const float* s5al = (const float*)(p.wsp() + OFF_S5AL);
    for (int e = gtid; e < 18 * 2 * 16 * 64; e += gsz) {
      int n = e & 63, g = (e >> 6) & 15, d = (e >> 10) & 1, seq = e >> 11;
      int start, T; seq_info(seq, start, T);
      int nc = T >> 5, cb = start >> 5;
      int pidx = ((l * 2 + d) * 16 + g) * 64 + n;
      float ar = s5al[pidx * 2], ai = s5al[pidx * 2 + 1];
      float hr = 0.f, hi = 0.f;
      if (seq >= 16) {
        size_t si = ((((size_t)(seq - 16) * 2 + l) * 2 + d) * 16 + g) * 64 + n;
        hr = p.inp(I_S5RE)[si]; hi = p.inp(I_S5IM)[si];
      }
      for (int s0 = 0; s0 < nc; s0 += 8) {
        float er[8], ei[8];
#pragma unroll
        for (int u = 0; u < 8; ++u) {
          int s = s0 + u; int cc = d ? nc - 1 - s : s; size_t idx = ((size_t)(((cb + cc) * 2 + d) * 16 + g) * 64 + n) * 2;
          er[u] = gptr(s5e)[idx]; ei[u] = gptr(s5e)[idx + 1];
        }
#pragma unroll
        for (int u = 0; u < 8; ++u) {
          int s = s0 + u; int cc = d ? nc - 1 - s : s; size_t idx = ((size_t)(((cb + cc) * 2 + d) * 16 + g) * 64 + n) * 2;
          gptr(s5h)[idx] = hr; gptr(s5h)[idx + 1] = hi;
          float nr = ar * hr - ai * hi + er[u], ni = ar * hi + ai * hr + ei[u];
          hr = nr; hi = ni;
        }
      }
      if (seq < 16) {
        size_t oi = ((((size_t)seq * 2 + l) * 2 + d) * 16 + g) * 64 + n;
        p.outp()[OUT_S5RE + oi] = hr; p.outp()[OUT_S5IM + oi] = hi;
      }
    }
  }
}

constexpr int HS5 = 136;
DI void s5_stage_u(const float* up, int lane, float* ub) {
  const float* src = up + (size_t)(lane >> 1) * PLD + (lane & 1) * 8;
  f32x4 a = *gptr((const f32x4*)src), b = *gptr((const f32x4*)(src + 4));
  *(f32x4*)(ub + lane * 8) = a; *(f32x4*)(ub + lane * 8 + 4) = b;
}
template <bool WRITE_H>
DI void s5_scan(const float* ub, float are, float aim, const float (&br)[16], const float (&bi)[16], int d, int lane, float& hr, float& hi, bf16_t* HB) {
#pragma unroll 4
  for (int s = 0; s < 32; ++s) {
    const int j = d ? 31 - s : s;
    const float4* u4 = (const float4*)(ub + j * 16);
    float4 u0 = u4[0], u1 = u4[1], u2 = u4[2], u3 = u4[3];
    float ur0 = br[0] * u0.x, ur1 = br[4] * u1.x, ur2 = br[8] * u2.x, ur3 = br[12] * u3.x;
    float ui0 = bi[0] * u0.x, ui1 = bi[4] * u1.x, ui2 = bi[8] * u2.x, ui3 = bi[12] * u3.x;
    ur0 += br[1] * u0.y; ur1 += br[5] * u1.y; ur2 += br[9] * u2.y; ur3 += br[13] * u3.y;
    ui0 += bi[1] * u0.y; ui1 += bi[5] * u1.y; ui2 += bi[9] * u2.y; ui3 += bi[13] * u3.y;
    ur0 += br[2] * u0.z; ur1 += br[6] * u1.z; ur2 += br[10] * u2.z; ur3 += br[14] * u3.z;
    ui0 += bi[2] * u0.z; ui1 += bi[6] * u1.z; ui2 += bi[10] * u2.z; ui3 += bi[14] * u3.z;
    ur0 += br[3] * u0.w; ur1 += br[7] * u1.w; ur2 += br[11] * u2.w; ur3 += br[15] * u3.w;
    ui0 += bi[3] * u0.w; ui1 += bi[7] * u1.w; ui2 += bi[11] * u2.w; ui3 += bi[15] * u3.w;
    float ur = (ur0 + ur1) + (ur2 + ur3), ui = (ui0 + ui1) + (ui2 + ui3);
    float nr = are * hr - aim * hi + ur, ni = are * hi + aim * hr + ui;
    hr = nr; hi = ni;
    if (WRITE_H) *(unsigned*)(HB + j * HS5 + lane * 2) = pack_bf2(hr, hi);
  }
}

DI void ph_s5_local(const Params& p, int l, char* smem) {
  const int tid = otid(), lane = tid & 63, w = tid >> 6;
  float* ub = (float*)(smem + w * 11264);
  bf16_t* HB = (bf16_t*)(smem + w * 11264 + 2048);
  const float* proj = (const float*)(p.wsp() + OFF_PROJ);
  const float* s5a = (const float*)(p.wsp() + OFF_S5A); const float* bbr = (const float*)(p.wsp() + OFF_S5BBR); const float* bbi = (const float*)(p.wsp() + OFF_S5BBI);
  float* s5e = (float*)(p.wsp() + OFF_S5E);
  float* yloc = (float*)(p.wsp() + OFF_YLOC);
  const bf16_t* cmt = (const bf16_t*)(p.wsp() + OFF_CMT);
  const int row16 = lane & 15, quad = lane >> 4;
  for (int wi = obid() * 4 + w; wi < 8192; wi += gridDim.x * 4) {
    int g = wi & 15, d = (wi >> 4) & 1, c = wi >> 5;
    int pidx = ((l * 2 + d) * 16 + g) * 64 + lane;
    float hr = 0.f, hi = 0.f;
    const float are = gptr(s5a)[pidx * 2], aim = gptr(s5a)[pidx * 2 + 1];
    float br[16], bi[16];
#pragma unroll
    for (int q = 0; q < 4; ++q) {
      f32x4 t = *gptr((const f32x4*)(bbr + (size_t)pidx * 16 + q * 4)); br[q * 4] = t[0]; br[q * 4 + 1] = t[1]; br[q * 4 + 2] = t[2]; br[q * 4 + 3] = t[3];
      f32x4 u = *gptr((const f32x4*)(bbi + (size_t)pidx * 16 + q * 4)); bi[q * 4] = u[0]; bi[q * 4 + 1] = u[1]; bi[q * 4 + 2] = u[2]; bi[q * 4 + 3] = u[3];
    }
    const bf16_t* cb = cmt + ((size_t)(((l * 2 + d) * 16 + g) * 16 + row16)) * 128 + quad * 8;
    bf16x8 bbv[4];
#pragma unroll
    for (int ks = 0; ks < 4; ++ks) bbv[ks] = *gptr((const bf16x8*)(cb + ks * 32));
    LDS_FENCE();
    s5_stage_u(proj + (size_t)(c * 32) * PLD + PC_XA + g * 16, lane, ub);
    LDS_FENCE();
    s5_scan<true>(ub, are, aim, br, bi, d, lane, hr, hi, HB);
    size_t eo = ((size_t)((c * 2 + d) * 16 + g) * 64 + lane) * 2;
    gptr(s5e)[eo] = hr; gptr(s5e)[eo + 1] = hi;
    LDS_FENCE();
    f32x4 yacc[2];
#pragma unroll
    for (int mt = 0; mt < 2; ++mt) { yacc[mt][0] = 0.f; yacc[mt][1] = 0.f; yacc[mt][2] = 0.f; yacc[mt][3] = 0.f; }
#pragma unroll
    for (int ks = 0; ks < 4; ++ks) {
#pragma unroll
      for (int mt = 0; mt < 2; ++mt) {
        bf16x8 a = *(const bf16x8*)(HB + (mt * 16 + row16) * HS5 + ks * 32 + quad * 8);
        yacc[mt] = __builtin_amdgcn_mfma_f32_16x16x32_bf16(a, bbv[ks], yacc[mt], 0, 0, 0);
      }
    }
#pragma unroll
    for (int mt = 0; mt < 2; ++mt)
#pragma unroll
      for (int i = 0; i < 4; ++i)
        gptr(yloc)[((size_t)d * NTOK + c * 32 + mt * 16 + quad * 4 + i) * 256 + g * 16 + row16] = yacc[mt][i];
  }
}

DI void s5_out_task(const Params& p, int l, int c, char* smem) {
  const int tid = otid(), lane = tid & 63, w = tid >> 6;
  bf16_t* HB = (bf16_t*)(smem + w * 8704);
  bf16_t* Y5 = (bf16_t*)(smem + 4 * 8704);
  float* red = (float*)(smem + 4 * 8704 + 32 * 264 * 2);
  const float* proj = (const float*)(p.wsp() + OFF_PROJ);
  const float* s5a = (const float*)(p.wsp() + OFF_S5A);
  const float* s5h = (const float*)(p.wsp() + OFF_S5H);
  const bf16_t* cmt = (const bf16_t*)(p.wsp() + OFF_CMT);
  const float* yloc = (const float*)(p.wsp() + OFF_YLOC);
  const int row16 = lane & 15, quad = lane >> 4;
  float are[8], aim[8], hr0[8], hi0[8];
#pragma unroll
  for (int q = 0; q < 8; ++q) {
    const int g = w * 4 + (q >> 1), d = q & 1;
    const int pidx = ((l * 2 + d) * 16 + g) * 64 + lane;
    const size_t ho = ((size_t)((c * 2 + d) * 16 + g) * 64 + lane) * 2;
    are[q] = gptr(s5a)[pidx * 2]; aim[q] = gptr(s5a)[pidx * 2 + 1];
    hr0[q] = gptr(s5h)[ho]; hi0[q] = gptr(s5h)[ho + 1];
  }
#pragma unroll
  for (int gq = 0; gq < 4; ++gq) {
    const int g = w * 4 + gq;
    float yl[8], xav[8];
#pragma unroll
    for (int mt = 0; mt < 2; ++mt)
#pragma unroll
      for (int i = 0; i < 4; ++i) {
        const int tl = mt * 16 + quad * 4 + i;
        const size_t yo = (size_t)(c * 32 + tl) * 256 + g * 16 + row16;
        yl[mt * 4 + i] = gptr(yloc)[yo] + gptr(yloc)[(size_t)NTOK * 256 + yo];
        xav[mt * 4 + i] = gptr(proj)[(size_t)(c * 32 + tl) * PLD + PC_XA + g * 16 + row16];
      }
    const float dsk = gptr(p.inp(I_S5D))[l * 256 + g * 16 + row16];
    f32x4 yacc[2];
#pragma unroll
    for (int mt = 0; mt < 2; ++mt) { yacc[mt][0] = 0.f; yacc[mt][1] = 0.f; yacc[mt][2] = 0.f; yacc[mt][3] = 0.f; }
#pragma unroll
    for (int d = 0; d < 2; ++d) {
      const bf16_t* cb = cmt + ((size_t)(((l * 2 + d) * 16 + g) * 16 + row16)) * 128 + quad * 8;
      bf16x8 bb[4];
#pragma unroll
      for (int ks = 0; ks < 4; ++ks) bb[ks] = *gptr((const bf16x8*)(cb + ks * 32));
      const float ar = are[gq * 2 + d], ai = aim[gq * 2 + d];
      float pr = hr0[gq * 2 + d], pi = hi0[gq * 2 + d];
      LDS_FENCE();
#pragma unroll 8
      for (int sft = 0; sft < 32; ++sft) {
        const int j = d ? 31 - sft : sft;
        float nr = ar * pr - ai * pi, ni = ar * pi + ai * pr;
        pr = nr; pi = ni;
        *(unsigned*)(HB + j * HS5 + lane * 2) = pack_bf2(pr, pi);
      }
      LDS_FENCE();
#pragma unroll
      for (int ks = 0; ks < 4; ++ks) {
#pragma unroll
        for (int mt = 0; mt < 2; ++mt) {
          bf16x8 a = *(const bf16x8*)(HB + (mt * 16 + row16) * HS5 + ks * 32 + quad * 8);
          yacc[mt] = __builtin_amdgcn_mfma_f32_16x16x32_bf16(a, bb[ks], yacc[mt], 0, 0, 0);
        }
      }
    }
    LDS_FENCE();
#pragma unroll
    for (int mt = 0; mt < 2; ++mt)
#pragma unroll
      for (int i = 0; i < 4; ++i) {
        int tl = mt * 16 + quad * 4 + i;
        float y = gelu_t(yacc[mt][i] + yl[mt * 4 + i] + dsk * xav[mt * 4 + i]);
        Y5[tl * 264 + g * 16 + row16] = f2bf(y);
      }
  }
  __syncthreads();
  const int r = lane & 31, h = lane >> 5;
  f32x16 acc[2];
#pragma unroll
  for (int nt = 0; nt < 2; ++nt)
#pragma unroll
    for (int i = 0; i < 16; ++i) acc[nt][i] = 0.f;
  const bf16_t* wg = (const bf16_t*)(p.wsp() + OFF_WGLU);
#pragma unroll 8
  for (int ks = 0; ks < 16; ++ks) {
    bf16x8 a = *(const bf16x8*)(Y5 + r * 264 + ks * 16 + h * 8);
#pragma unroll
    for (int nt = 0; nt < 2; ++nt) {
      bf16x8 b = *gptr((const bf16x8*)(wg + (size_t)(w * 64 + nt * 32 + r) * 256 + ks * 16 + h * 8));
      acc[nt] = __builtin_amdgcn_mfma_f32_32x32x16_bf16(a, b, acc[nt], 0, 0, 0);
    }
  }
#pragma unroll
  for (int i = 0; i < 16; ++i) {
    int tl = (i & 3) + 8 * (i >> 2) + 4 * h;
    float s = 0.f;
#pragma unroll
    for (int nt = 0; nt < 2; ++nt) { float v = bf2f(Y5[tl * 264 + w * 64 + nt * 32 + r]) * sigm(acc[nt][i]); acc[nt][i] = v; s += v * v; }
#pragma unroll
    for (int o = 16; o > 0; o >>= 1) s += __shfl_xor(s, o, 64);
    if (r == 0) red[w * 32 + tl] = s;
  }
  __syncthreads();
  bf16_t* cat = (bf16_t*)(p.wsp() + OFF_H);
#pragma unroll
  for (int i = 0; i < 16; ++i) {
    int tl = (i & 3) + 8 * (i >> 2) + 4 * h;
    float tot = red[tl] + red[32 + tl] + red[64 + tl] + red[96 + tl];
    float rstd = rsqrtf(tot * (1.f / 256.f) + EPSF);
#pragma unroll
    for (int nt = 0; nt < 2; ++nt) {
      int ch = w * 64 + nt * 32 + r;
      gptr(cat)[(size_t)(c * 32 + tl) * DM + ch] = f2bf(acc[nt][i] * rstd * gptr(p.inp(I_GRPG))[l * 1024 + ch]);
    }
  }
  __syncthreads();
}

DI void hg_gate_vals(float z, float lb, float& lf, float& kv) {
  float e = __expf(-fabsf(z));
  float inv = frcp(1.f + e);
  float sg = (z >= 0.f) ? inv : e * inv;
  float sn = (z >= 0.f) ? e * inv : inv;
  lf = (lb == 0.f) ? (fminf(z, 0.f) - __logf(1.f + e)) : __logf(lb + (1.f - lb) * sg);
  kv = (1.f - lb) * sn;
}
DI float hg_lb(const Params& p, int l, int d, int ch) {
  if (l == 0) return 0.f;
  float x0 = p.inp(I_LBLOG)[(0 * 2 + d) * 256 + ch], x1 = p.inp(I_LBLOG)[(1 * 2 + d) * 256 + ch];
  return 1.f / (1.f + expf(x0 - x1));
}
DI void hg_build_vt(const float* proj, int c, int hd, int lane, bf16_t* Vt) {
#pragma unroll
  for (int j0 = 0; j0 < 32; j0 += 8) {
    float v[8];
#pragma unroll
    for (int q = 0; q < 8; ++q) v[q] = gptr(proj)[(size_t)(c * 32 + j0 + q) * PLD + PC_V + hd * 64 + lane];
    *(bf16x8*)(Vt + lane * 40 + j0) = pack8(v[0], v[1], v[2], v[3], v[4], v[5], v[6], v[7]);
  }
}

DI void ph_hg_local(const Params& p, int l, char* smem) {
  const int tid = otid(), lane = tid & 63, w = tid >> 6, r = lane & 31, h = lane >> 5;
  bf16_t* Vt = (bf16_t*)(smem + w * 11264);
  bf16_t* KhT = Vt + 64 * 40;
  const float* proj = (const float*)(p.wsp() + OFF_PROJ);
  float* hgs = (float*)(p.wsp() + OFF_HGS); float* hgg = (float*)(p.wsp() + OFF_HGG);
  for (int wi = obid() * 4 + w; wi < 2048; wi += gridDim.x * 4) {
    int hd = wi & 3, d = (wi >> 2) & 1, c = wi >> 3;
    hg_build_vt(proj, c, hd, lane, Vt);
    const float lb = hg_lb(p, l, d, hd * 64 + lane);
    float bcs[32], kvs[32];
    float run = 0.f;
#pragma unroll
    for (int s = 0; s < 32; ++s) {
      int j = d ? 31 - s : s;
      float z = gptr(proj)[(size_t)(c * 32 + j) * PLD + PC_ZF + d * 256 + hd * 64 + lane];
      float lf, kv; hg_gate_vals(z, lb, lf, kv);
      run += lf; bcs[s] = run; kvs[s] = kv;
    }
    const float blast = run;
#pragma unroll
    for (int j0 = 0; j0 < 32; j0 += 8) {
      float kh[8];
#pragma unroll
      for (int q = 0; q < 8; ++q) {
        int j = j0 + q;
        float b = d ? bcs[31 - j] : bcs[j];
        float kk = d ? kvs[31 - j] : kvs[j];
        kh[q] = kk * __expf(blast - b);
      }
      *(bf16x8*)(KhT + lane * 40 + j0) = pack8(kh[0], kh[1], kh[2], kh[3], kh[4], kh[5], kh[6], kh[7]);
    }
    hgg[(size_t)wi * 64 + lane] = __expf(blast);
    LDS_FENCE();
    f32x16 acc[2][2];
#pragma unroll
    for (int a = 0; a < 2; ++a)
#pragma unroll
      for (int b = 0; b < 2; ++b)
#pragma unroll
        for (int i = 0; i < 16; ++i) acc[a][b][i] = 0.f;
#pragma unroll
    for (int ks = 0; ks < 2; ++ks) {
      bf16x8 af[2], bf[2];
#pragma unroll
      for (int t = 0; t < 2; ++t) { af[t] = *(const bf16x8*)(Vt + (t * 32 + r) * 40 + ks * 16 + h * 8); bf[t] = *(const bf16x8*)(KhT + (t * 32 + r) * 40 + ks * 16 + h * 8); }
#pragma unroll
      for (int vt = 0; vt < 2; ++vt)
#pragma unroll
        for (int kt = 0; kt < 2; ++kt) acc[vt][kt] = __builtin_amdgcn_mfma_f32_32x32x16_bf16(af[vt], bf[kt], acc[vt][kt], 0, 0, 0);
    }
    float* dst = hgs + (size_t)wi * 4096;
#pragma unroll
    for (int vt = 0; vt < 2; ++vt)
#pragma unroll
      for (int kt = 0; kt < 2; ++kt)
#pragma unroll
        for (int i = 0; i < 16; ++i) gptr(dst)[(vt * 32 + (i & 3) + 8 * (i >> 2) + 4 * h) * 64 + kt * 32 + r] = acc[vt][kt][i];
  }
}

DI void hg_out_task(const Params& p, int l, int c, int hd, char* smem_w) {
  const int tid = otid(), lane = tid & 63, r = lane & 31, h = lane >> 5;
  bf16_t* Qt = (bf16_t*)smem_w;
  bf16_t* Kt = Qt + 32 * 72;
  bf16_t* Vt = Kt + 32 * 72;
  const float* proj = (const float*)(p.wsp() + OFF_PROJ);
  const float* hgs = (const float*)(p.wsp() + OFF_HGS);
  hg_build_vt(proj, c, hd, lane, Vt);
  f32x16 oT[2];
#pragma unroll
  for (int vt = 0; vt < 2; ++vt)
#pragma unroll
    for (int i = 0; i < 16; ++i) oT[vt][i] = 0.f;
#pragma unroll 1
  for (int d = 0; d < 2; ++d) {
    LDS_FENCE();
    const float lb = hg_lb(p, l, d, hd * 64 + lane);
    float run = 0.f;
    float zz[32], qq[32];
#pragma unroll
    for (int s = 0; s < 32; ++s) {
      int j = d ? 31 - s : s;
      zz[s] = gptr(proj)[(size_t)(c * 32 + j) * PLD + PC_ZF + d * 256 + hd * 64 + lane];
      qq[s] = gptr(proj)[(size_t)(c * 32 + j) * PLD + PC_Q + hd * 64 + lane];
    }
#pragma unroll
    for (int s = 0; s < 32; ++s) {
      int j = d ? 31 - s : s;
      float z = zz[s], q = qq[s];
      float lf, kv; hg_gate_vals(z, lb, lf, kv);
      run += lf;
      Qt[j * 72 + lane] = f2bf(q * __expf(run));
      Kt[j * 72 + lane] = f2bf(kv * __expf(-run));
    }
    LDS_FENCE();
    f32x16 sT;
#pragma unroll
    for (int i = 0; i < 16; ++i) sT[i] = 0.f;
    bf16x8 qf[4];
#pragma unroll
    for (int ks = 0; ks < 4; ++ks) {
      bf16x8 a = *(const bf16x8*)(Kt + r * 72 + ks * 16 + h * 8);
      qf[ks] = *(const bf16x8*)(Qt + r * 72 + ks * 16 + h * 8);
      sT = __builtin_amdgcn_mfma_f32_32x32x16_bf16(a, qf[ks], sT, 0, 0, 0);
    }
#pragma unroll
    for (int i = 0; i < 16; ++i) {
      int ii = (i & 3) + 8 * (i >> 2) + 4 * h;
      bool valid = d ? (ii >= r) : (ii <= r);
      sT[i] = valid ? sT[i] : 0.f;
    }
#pragma unroll
    for (int s2 = 0; s2 < 2; ++s2) {
      bf16x8 pb = pack8(sT[8 * s2], sT[8 * s2 + 1], sT[8 * s2 + 2], sT[8 * s2 + 3], sT[8 * s2 + 4], sT[8 * s2 + 5], sT[8 * s2 + 6], sT[8 * s2 + 7]);
#pragma unroll
      for (int vt = 0; vt < 2; ++vt) {
        s16x4 lo = *(const s16x4*)(Vt + (vt * 32 + r) * 40 + 16 * s2 + 4 * h);
        s16x4 hi2 = *(const s16x4*)(Vt + (vt * 32 + r) * 40 + 16 * s2 + 8 + 4 * h);
        bf16x8 av = __builtin_shufflevector(lo, hi2, 0, 1, 2, 3, 4, 5, 6, 7);
        oT[vt] = __builtin_amdgcn_mfma_f32_32x32x16_bf16(av, pb, oT[vt], 0, 0, 0);
      }
    }
    const float* st = hgs + (size_t)((c * 2 + d) * 4 + hd) * 4096;
#pragma unroll
    for (int ks = 0; ks < 4; ++ks) {
#pragma unroll
      for (int vt = 0; vt < 2; ++vt) {
        const GAS f32x4* sp4 = gptr((const f32x4*)(st + (vt * 32 + r) * 64 + ks * 16 + h * 8));
        f32x4 s0 = sp4[0], s1 = sp4[1];
        bf16x8 a = pack8(s0[0], s0[1], s0[2], s0[3], s1[0], s1[1], s1[2], s1[3]);
        oT[vt] = __builtin_amdgcn_mfma_f32_32x32x16_bf16(a, qf[ks], oT[vt], 0, 0, 0);
      }
    }
  }
  float ss = 0.f;
#pragma unroll
  for (int vt = 0; vt < 2; ++vt)
#pragma unroll
    for (int i = 0; i < 16; ++i) ss += oT[vt][i] * oT[vt][i];
  ss += __shfl_xor(ss, 32, 64);
  const float rstd = rsqrtf(ss * (1.f / 64.f) + EPSF);
  const int tok = c * 32 + r;
  bf16_t* cat = (bf16_t*)(p.wsp() + OFF_H);
#pragma unroll
  for (int vt = 0; vt < 2; ++vt)
#pragma unroll
    for (int g4 = 0; g4 < 4; ++g4) {
      int v0 = vt * 32 + 8 * g4 + 4 * h;
      f32x4 gt = *gptr((const f32x4*)(proj + (size_t)tok * PLD + PC_GATE + hd * 64 + v0));
      f32x4 gn = *gptr((const f32x4*)(p.inp(I_GRPG) + l * 1024 + 256 + hd * 64 + v0));
      s16x4 o;
      o[0] = (short)f2bf(oT[vt][4 * g4 + 0] * rstd * gn[0] * silu_f(gt[0]));
      o[1] = (short)f2bf(oT[vt][4 * g4 + 1] * rstd * gn[1] * silu_f(gt[1]));
      o[2] = (short)f2bf(oT[vt][4 * g4 + 2] * rstd * gn[2] * silu_f(gt[2]));
      o[3] = (short)f2bf(oT[vt][4 * g4 + 3] * rstd * gn[3] * silu_f(gt[3]));
      *gptr((s16x4*)(cat + (size_t)tok * DM + 256 + hd * 64 + v0)) = o;
    }
}

DI void ph_mix_out(const Params& p, int l, char* smem) {
  const int b = obid(); const int nb = gridDim.x;
  if (nb >= 2) {
    if ((b & 1) == 0) { for (int c = b >> 1; c < 256; c += (nb + 1) >> 1) s5_out_task(p, l, c, smem); }
    else {
      const int w = otid() >> 6;
      for (int c = b >> 1; c < 256; c += nb >> 1) hg_out_task(p, l, c, w, smem + w * 14336);
    }
  } else {
    for (int c = 0; c < 256; ++c) s5_out_task(p, l, c, smem);
    const int w = otid() >> 6;
    for (int c = 0; c < 256; ++c) hg_out_task(p, l, c, w, smem + w * 14336);
  }
}

DI void gmlp_task(const Params& p, int l, int C, int half, char* smem) {
  const int tid = otid(), lane = tid & 63, w = tid >> 6, r = lane & 31, h = lane >> 5;
  const int hd = w;
  float* rstd = (float*)smem;
  float* part = rstd + 128;
  bf16_t* GvT = (bf16_t*)(smem + 2560 + w * 9216);
  const float* proj = (const float*)(p.wsp() + OFF_PROJ);
  const bf16_t* wsb = (const bf16_t*)(p.wsp() + OFF_WSB) + (size_t)(l * 4 + hd) * 128 * 128;
#pragma unroll 4
  for (int i = 0; i < 8; ++i) {
    int tl = w * 32 + i * 4 + (lane >> 4);
    const float* src = proj + (size_t)(C * 128 + tl) * PLD + PC_GV + (lane & 15) * 16;
    float ss = 0.f;
#pragma unroll
    for (int q = 0; q < 4; ++q) {
      f32x4 v = *gptr((const f32x4*)(src + q * 4));
      float a = gelu_t(v[0]), b = gelu_t(v[1]), cc = gelu_t(v[2]), dd = gelu_t(v[3]);
      ss += a * a + b * b + cc * cc + dd * dd;
    }
#pragma unroll
    for (int o = 8; o > 0; o >>= 1) ss += __shfl_xor(ss, o, 64);
    if ((lane & 15) == 0) rstd[tl] = rsqrtf(ss * (1.f / 256.f) + EPSF);
  }
  __syncthreads();
  const float gmg = p.inp(I_GMNG)[l * 256 + hd * 64 + lane];
  bf16_t* cat = (bf16_t*)(p.wsp() + OFF_H);
  f32x16 acc[2][2];
#pragma unroll
  for (int a = 0; a < 2; ++a)
#pragma unroll
    for (int b = 0; b < 2; ++b)
#pragma unroll
      for (int i = 0; i < 16; ++i) acc[a][b][i] = 0.f;
#pragma unroll 1
  for (int pass = 0; pass < 2; ++pass) {
    LDS_FENCE();
#pragma unroll 4
    for (int j0 = 0; j0 < 64; j0 += 8) {
      float v[8];
#pragma unroll
      for (int q = 0; q < 8; ++q) {
        int j = pass * 64 + j0 + q;
        v[q] = gelu_t(gptr(proj)[(size_t)(C * 128 + j) * PLD + PC_GV + hd * 64 + lane]) * rstd[j] * gmg;
      }
      *(bf16x8*)(GvT + lane * 72 + j0) = pack8(v[0], v[1], v[2], v[3], v[4], v[5], v[6], v[7]);
    }
    LDS_FENCE();
#pragma unroll
    for (int ks = 0; ks < 4; ++ks) {
      bf16x8 af[2];
#pragma unroll
      for (int mt = 0; mt < 2; ++mt) af[mt] = *(const bf16x8*)(GvT + (mt * 32 + r) * 72 + ks * 16 + h * 8);
#pragma unroll
      for (int nt = 0; nt < 2; ++nt) {
        bf16x8 b = *gptr((const bf16x8*)(wsb + (size_t)((half * 2 + nt) * 32 + r) * 128 + pass * 64 + ks * 16 + h * 8));
#pragma unroll
        for (int mt = 0; mt < 2; ++mt) acc[mt][nt] = __builtin_amdgcn_mfma_f32_32x32x16_bf16(af[mt], b, acc[mt][nt], 0, 0, 0);
      }
    }
  }
#pragma unroll
  for (int nt = 0; nt < 2; ++nt) {
    const int ti = (half * 2 + nt) * 32 + r; const int tok = C * 128 + ti;
    const float bsv = p.inp(I_GMBS)[(l * 4 + hd) * 128 + ti];
    float ss = 0.f;
#pragma unroll
    for (int mt = 0; mt < 2; ++mt)
#pragma unroll
      for (int g4 = 0; g4 < 4; ++g4) {
        int d0 = mt * 32 + 8 * g4 + 4 * h;
        f32x4 gu = *gptr((const f32x4*)(proj + (size_t)tok * PLD + PC_GU + hd * 64 + d0));
        float v0 = gelu_t(gu[0]) * (acc[mt][nt][4 * g4 + 0] + bsv);
        float v1 = gelu_t(gu[1]) * (acc[mt][nt][4 * g4 + 1] + bsv);
        float v2 = gelu_t(gu[2]) * (acc[mt][nt][4 * g4 + 2] + bsv);
        float v3 = gelu_t(gu[3]) * (acc[mt][nt][4 * g4 + 3] + bsv);
        acc[mt][nt][4 * g4 + 0] = v0; acc[mt][nt][4 * g4 + 1] = v1; acc[mt][nt][4 * g4 + 2] = v2; acc[mt][nt][4 * g4 + 3] = v3;
        ss += v0 * v0 + v1 * v1 + v2 * v2 + v3 * v3;
      }
    ss += __shfl_xor(ss, 32, 64);
    if (h == 0) part[w * 64 + nt * 32 + r] = ss;
  }
  __syncthreads();
#pragma unroll
  for (int nt = 0; nt < 2; ++nt) {
    const int ti = (half * 2 + nt) * 32 + r; const int tok = C * 128 + ti;
    const int pi = nt * 32 + r;
    float tot = part[pi] + part[64 + pi] + part[128 + pi] + part[192 + pi];
    float rs = rsqrtf(tot * (1.f / 256.f) + EPSF);
#pragma unroll
    for (int mt = 0; mt < 2; ++mt)
#pragma unroll
      for (int g4 = 0; g4 < 4; ++g4) {
        int d0 = mt * 32 + 8 * g4 + 4 * h;
        f32x4 gn = *gptr((const f32x4*)(p.inp(I_GRPG) + l * 1024 + 768 + hd * 64 + d0));
        s16x4 o;
        o[0] = (short)f2bf(acc[mt][nt][4 * g4 + 0] * rs * gn[0]); o[1] = (short)f2bf(acc[mt][nt][4 * g4 + 1] * rs * gn[1]);
        o[2] = (short)f2bf(acc[mt][nt][4 * g4 + 2] * rs * gn[2]); o[3] = (short)f2bf(acc[mt][nt][4 * g4 + 3] * rs * gn[3]);
        *gptr((s16x4*)(cat + (size_t)tok * DM + 768 + hd * 64 + d0)) = o;
      }
  }
  __syncthreads();
}

DI void ph_c_norm(const Params& p, int l) {
  const int tid_ = otid(); const int lane = tid_ & 63, w = tid_ >> 6;
  bf16_t* cat = (bf16_t*)(p.wsp() + OFF_H);
  const float* g0 = (const float*)(p.wsp() + OFF_GCP0); const float* g1 = (const float*)(p.wsp() + OFF_GCP1);
  for (int tok = obid() * 4 + w; tok < NTOK; tok += gridDim.x * 4) {
    float4 v = ldg4(g0 + (size_t)tok * 256 + lane * 4);
    if (tok >= 4096) {
#pragma unroll
      for (int q = 0; q < 3; ++q) {
        float4 u = ldg4(g1 + ((size_t)q * 4096 + (tok - 4096)) * 256 + lane * 4);
        v.x += u.x; v.y += u.y; v.z += u.z; v.w += u.w;
      }
    }
    float ss = wave_sum(v.x * v.x + v.y * v.y + v.z * v.z + v.w * v.w);
    float rstd = rsqrtf(ss * (1.f / 256.f) + EPSF);
    float4 g = ldg4(p.inp(I_GRPG) + l * 1024 + 512 + lane * 4);
    ushort4 o; o.x = f2bf(v.x * rstd * g.x); o.y = f2bf(v.y * rstd * g.y); o.z = f2bf(v.z * rstd * g.z); o.w = f2bf(v.w * rstd * g.w);
    stg_us4(cat + (size_t)tok * DM + 512 + lane * 4, o);
  }
}

DI void ph_local(const Params& p, int l, char* smem) {
  for (int it = obid(); it < 448; it += gridDim.x) {
    if (it < 320) {
      int seq, mt, nt, ks, T, start, klen;
      if (it < 256) { ks = it & 3; nt = (it >> 2) & 1; mt = (it >> 3) & 15; seq = 16 + (it >> 7); klen = 1024; }
      else { int j = it - 256; ks = 0; nt = j & 1; mt = (j >> 1) & 1; seq = j >> 2; klen = 512; }
      seq_info(seq, start, T);
      const bf16_t* A = (const bf16_t*)(p.wsp() + (T == 256 ? OFF_DFTC : OFF_DFTL)) + (size_t)mt * 128 * 2 * T + ks * 1024;
      const bf16_t* Bt = (const bf16_t*)(p.wsp() + OFF_UVT) + (size_t)512 * start + (size_t)nt * 128 * 2 * T + ks * 1024;
      float* dst = (ks == 0) ? (float*)(p.wsp() + OFF_GCP0) + (size_t)(start + mt * 128) * 256 + nt * 128
                             : (float*)(p.wsp() + OFF_GCP1) + ((size_t)(ks - 1) * 4096 + (start - 4096) + mt * 128) * 256 + nt * 128;
      EpiStoreF epi{dst, 256};
      gemm_tile64_pf2(A, 2 * T, Bt, 2 * T, klen, smem, epi);
    } else {
      gmlp_task(p, l, (it - 320) >> 1, (it - 320) & 1, smem);
    }
  }
  ph_hg_local(p, l, smem);
  ph_s5_local(p, l, smem);
}

DI void ph_conv_gate(const Params& p, int l) {
  const int gtid = obid() * 256 + otid(), gsz = gridDim.x * 256;
  const bf16_t* z = (const bf16_t*)(p.wsp() + OFF_Z); bf16_t* act = (bf16_t*)(p.wsp() + OFF_ACT);
  const float* cw = p.inp(I_CONVW) + (size_t)l * 3 * DUP; const float* cb = p.inp(I_CONVB) + (size_t)l * DUP;
  for (int e = gtid; e < NTOK * (DFF / 8); e += gsz) {
    int tok = e / (DFF / 8), j0 = (e % (DFF / 8)) * 8;
    int seg = tok < 4096 ? 256 : 64; int tt = tok & (seg - 1);
    bool hp = tt > 0, hn = tt < seg - 1;
    float res[8];
    float za[2][8];
#pragma unroll
    for (int half = 0; half < 2; ++half) {
      int ch = half * DFF + j0;
      uint4 zc = *(const uint4*)(z + (size_t)tok * DUP + ch);
      uint4 zp = hp ? *(const uint4*)(z + (size_t)(tok - 1) * DUP + ch) : make_uint4(0, 0, 0, 0);
      uint4 zn = hn ? *(const uint4*)(z + (size_t)(tok + 1) * DUP + ch) : make_uint4(0, 0, 0, 0);
      const unsigned* pc = (const unsigned*)&zc; const unsigned* pp = (const unsigned*)&zp; const unsigned* pn = (const unsigned*)&zn;
#pragma unroll
      for (int q = 0; q < 8; ++q) {
        float vc = bf2f((bf16_t)((pc[q >> 1] >> ((q & 1) * 16)) & 0xffff));
        float vp = bf2f((bf16_t)((pp[q >> 1] >> ((q & 1) * 16)) & 0xffff));
        float vn = bf2f((bf16_t)((pn[q >> 1] >> ((q & 1) * 16)) & 0xffff));
        za[half][q] = cb[ch + q] + cw[ch + q] * vp + cw[DUP + ch + q] * vc + cw[2 * DUP + ch + q] * vn;
      }
    }
#pragma unroll
    for (int q = 0; q < 8; ++q) res[q] = gelu_t(za[0][q]) * za[1][q];
    uint4 o;
    o.x = (unsigned)f2bf(res[0]) | ((unsigned)f2bf(res[1]) << 16);
    o.y = (unsigned)f2bf(res[2]) | ((unsigned)f2bf(res[3]) << 16);
    o.z = (unsigned)f2bf(res[4]) | ((unsigned)f2bf(res[5]) << 16);
    o.w = (unsigned)f2bf(res[6]) | ((unsigned)f2bf(res[7]) << 16);
    *(uint4*)(act + (size_t)tok * DFF + j0) = o;
  }
}

#define EXP 0
#define GSYNC() xcd_barrier(xb)
#define XS(n) if (EXP == n) { GSYNC(); }
__global__ void __launch_bounds__(256, 2) mega_kernel(Params pk) {
  __shared__ __attribute__((aligned(16))) char smem[SMEM_BYTES];
  cg::grid_group grid = cg::this_grid();
  __shared__ uint4 xb_words;
  __shared__ Params sp;
  if (threadIdx.x == 0) { xb_words = make_uint4(0u, 0u, 0u, 0u); sp = pk; }
  __syncthreads();
  const Params& p = sp;
  XcdBarrier xb = xcd_barrier_post((unsigned*)(pk.ws + OFF_BAR), (volatile LAS unsigned*)&xb_words);
  if (p.wsp() == nullptr) grid.sync();
  ph_mu(p, smem);
  ph_prep(p, smem);
  GSYNC();
  ph_fold(p, smem);
  ph_mod_reduce(p);
  GSYNC();
  ph_fold_copy(p, 0);
  for (int l = 0; l < 2; ++l) {
    if (l > 0) ph_convert_weights(p, l, smem);
    ph_norm_mod(p, l, p.inp(I_N1G) + l * 1024, 0, 1024, l == 0);
    GSYNC();
    ph_gemm_in(p, smem);
    GSYNC();
    ph_local(p, l, smem);
    if (EXP == 11) ph_local(p, l, smem);
    GSYNC();
    ph_scans(p, l);
    ph_c_norm(p, l);
    GSYNC();
    ph_mix_out(p, l, smem);
    if (EXP == 12) ph_mix_out(p, l, smem);
    GSYNC();
    ph_gemm_out(p, l, smem);
    GSYNC();
    ph_norm_mod(p, l, p.inp(I_N2G) + l * 1024, 3072, 4096);
    GSYNC();
    ph_gemm_up(p, l, smem);
    GSYNC();
    ph_gemm_down(p, l, smem);
    GSYNC();
  }
  ph_final_norm(p);
}

extern "C" void kernel_launch(void* const* d_in, const int* in_sizes, int n_in, void* d_out, int out_size, void* d_ws, size_t ws_size,
                              hipStream_t stream) {
  static int grid_blocks = 0;
  if (!grid_blocks) {
    int dev = 0, cus = 0, per_cu = 0;
    hipGetDevice(&dev);
    hipDeviceGetAttribute(&cus, hipDeviceAttributeMultiprocessorCount, dev);
    hipOccupancyMaxActiveBlocksPerMultiprocessor(&per_cu, mega_kernel, 256, 0);
    if (per_cu > 2) per_cu = 2;
    if (per_cu < 1) per_cu = 1;
    grid_blocks = cus * per_cu;
  }
  if (ws_size < WS_NEEDED) fprintf(stderr, "workspace too small: %zu < %zu\n", ws_size, (size_t)WS_NEEDED);
  Params p{};
  for (int i = 0; i < 33; ++i) p.in[i] = (const float*)d_in[i];
  p.out = (float*)d_out;
  p.ws = (char*)d_ws;
  void* args[] = {&p};
  hipMemsetAsync((char*)d_ws + OFF_BAR, 0, XCD_BAR_WORDS_C * 4, stream);
  hipError_t e = hipLaunchCooperativeKernel((void*)mega_kernel, dim3(grid_blocks), dim3(256), args, 0, stream);
  if (e != hipSuccess) fprintf(stderr, "cooperative launch failed: %s (grid %d)\n", hipGetErrorString(e), grid_blocks);
}
```

```cpp
#include <hip/hip_runtime.h>
#include <hip/hip_cooperative_groups.h>
#include <cstdio>
namespace cg = cooperative_groups;

typedef unsigned short bf16_t;
using bf16x8 = __attribute__((ext_vector_type(8))) short;
using f32x16 = __attribute__((ext_vector_type(16))) float;
using u32x4 = __attribute__((ext_vector_type(4))) unsigned;
using s16x4 = __attribute__((ext_vector_type(4))) short;
using f32x4 = __attribute__((ext_vector_type(4))) float;
#define LDS_FENCE() asm volatile("" ::: "memory")

#define DI __device__ __forceinline__
#define GAS __attribute__((address_space(1)))
template <class T> DI const GAS T* gptr(const T* p) { return (const GAS T*)p; }
template <class T> DI GAS T* gptr(T* p) { return (GAS T*)p; }
DI float4 ldg4(const float* p) { f32x4 v = *gptr((const f32x4*)p); return make_float4(v[0], v[1], v[2], v[3]); }
DI void stg4(float* p, float4 v) { f32x4 t; t[0] = v.x; t[1] = v.y; t[2] = v.z; t[3] = v.w; *gptr((f32x4*)p) = t; }
DI void stg_us4(unsigned short* p, ushort4 v) { s16x4 t; t[0] = (short)v.x; t[1] = (short)v.y; t[2] = (short)v.z; t[3] = (short)v.w; *gptr((s16x4*)p) = t; }

constexpr int NTOK = 8192;
constexpr int DM = 1024;
constexpr int NWIN = 2560;
constexpr int PLD = 2048;
constexpr int DFF = 2816;
constexpr int DUP = 5632;
constexpr float EPSF = 1e-6f;

constexpr int PC_XA = 0, PC_Q = 256, PC_ZF = 512, PC_V = 1024, PC_GATE = 1280, PC_GU = 1536, PC_GV = 1792;

constexpr size_t SZ_WIN = (size_t)NWIN * 1024 * 2;
constexpr size_t SZ_WOUT = (size_t)1024 * 1024 * 2;
constexpr size_t SZ_WUP = (size_t)DUP * 1024 * 2;
constexpr size_t SZ_WDN = (size_t)1024 * DFF * 2;
constexpr size_t SZ_W256 = (size_t)256 * 256 * 2;
constexpr size_t OFF_WIN = 0;
constexpr size_t OFF_WOUT = OFF_WIN + SZ_WIN;
constexpr size_t OFF_WUP = OFF_WOUT + SZ_WOUT;
constexpr size_t OFF_WDN = OFF_WUP + SZ_WUP;
constexpr size_t OFF_WGLU = OFF_WDN + SZ_WDN;
constexpr size_t OFF_DFTL = OFF_WGLU + SZ_W256;
constexpr size_t OFF_DFTC = OFF_DFTL + (size_t)2048 * 4096 * 2;
constexpr int NKC = 16;
constexpr size_t OFF_ADAP = OFF_DFTC + (size_t)256 * 512 * 2;
constexpr size_t OFF_MOD = OFF_ADAP + (size_t)NKC * 2 * 3 * 6144 * 4;
constexpr size_t OFF_S5A = OFF_MOD + (size_t)2 * 3 * 6144 * 4;
constexpr size_t OFF_S5AL = OFF_S5A + 4096 * 2 * 4;
constexpr size_t OFF_S5BBR = OFF_S5AL + 4096 * 2 * 4;
constexpr size_t OFF_S5BBI = OFF_S5BBR + 4096 * 16 * 4;
constexpr size_t OFF_X = OFF_S5BBI + 4096 * 16 * 4;
constexpr size_t OFF_H = OFF_X + (size_t)NTOK * DM * 4;
constexpr size_t OFF_R1 = OFF_H + (size_t)NTOK * DM * 2;
constexpr size_t OFF_PROJ = OFF_R1;
constexpr size_t OFF_UVT = OFF_PROJ + (size_t)NTOK * PLD * 4;
constexpr size_t OFF_YLOC = OFF_UVT + (size_t)NTOK * 512 * 2;
constexpr size_t OFF_Z = OFF_R1;
constexpr size_t SZ_R1 = (size_t)NTOK * DUP * 2;
constexpr size_t OFF_R2 = OFF_R1 + SZ_R1;
constexpr size_t OFF_HGS = OFF_R2;
constexpr size_t OFF_GCP0 = OFF_HGS + (size_t)2048 * 4096 * 4;
constexpr size_t OFF_GCP1 = OFF_GCP0 + (size_t)NTOK * 256 * 4;
constexpr size_t OFF_HGG = OFF_GCP1 + (size_t)3 * 4096 * 256 * 4;
constexpr size_t OFF_S5E = OFF_HGG + (size_t)2048 * 64 * 4;
constexpr size_t OFF_S5H = OFF_S5E + (size_t)256 * 2 * 16 * 64 * 2 * 4;
constexpr size_t OFF_CMT = OFF_S5H + (size_t)256 * 2 * 16 * 64 * 2 * 4;
constexpr size_t OFF_WSB = OFF_CMT + (size_t)2 * 2 * 16 * 16 * 128 * 2;
constexpr size_t OFF_ACT = OFF_R2;
constexpr int XCD_BAR_WORDS_C = 3456;
constexpr size_t OFF_MU = OFF_WSB + (size_t)2 * 4 * 128 * 128 * 2;
constexpr size_t OFF_WFOLD = OFF_MU + (size_t)2 * 2 * 256 * 256 * 4;
constexpr size_t OFF_BAR = OFF_WFOLD + (size_t)2 * 512 * 1024 * 2;
constexpr size_t WS_NEEDED = OFF_BAR + XCD_BAR_WORDS_C * 4;

constexpr size_t OUT_S5RE = (size_t)NTOK * DM;
constexpr size_t OUT_S5IM = OUT_S5RE + 65536;
constexpr size_t OUT_HG = OUT_S5IM + 65536;

constexpr int SMEM_BYTES = 63488;

struct Params {
  const float* in[33];
  float* out;
  char* ws;
  DI char* wsp() const { return *(char* const volatile __attribute__((address_space(3)))*)(&ws); }
  DI const float* inp(int i) const { return *(const float* const __attribute__((address_space(3)))*)(&in[i]); }
  DI float* outp() const { return *(float* const __attribute__((address_space(3)))*)(&out); }
};

enum { I_XP = 0, I_XS, I_S5RE, I_S5IM, I_HGST, I_C, I_CCTX, I_WADA, I_BADA, I_N1G, I_N2G, I_WIN, I_LAMRE, I_LAMIM, I_LOGDT,
       I_BRE, I_BIM, I_CRE, I_CIM, I_S5D, I_WGLU, I_LBLOG, I_FNW, I_GMNG, I_GMWS, I_GMBS, I_GRPG, I_WOUT, I_WUP, I_CONVW,
       I_CONVB, I_WDN, I_FING };

DI bf16_t f2bf(float x) { unsigned u = __float_as_uint(x); u += 0x7fffu + ((u >> 16) & 1u); return (bf16_t)(u >> 16); }
DI float bf2f(bf16_t b) { return __uint_as_float(((unsigned)b) << 16); }
DI float frcp(float x) { return __builtin_amdgcn_rcpf(x); }
DI float gelu_t(float x) { float u2 = 1.5957691216057308f * (x + 0.044715f * x * x * x); return x * frcp(1.f + __expf(-u2)); }
DI float sigm(float x) { return frcp(1.f + __expf(-x)); }
DI float silu_f(float x) { return x * sigm(x); }
DI int otid() { int t = threadIdx.x; asm volatile("" : "+v"(t)); return t; }
DI int obid() { int b = blockIdx.x; asm volatile("" : "+s"(b)); return b; }
DI unsigned pack_bf2(float a, float b) { return (unsigned)f2bf(a) | ((unsigned)f2bf(b) << 16); }
DI bf16x8 pack8(float a0, float a1, float a2, float a3, float a4, float a5, float a6, float a7) {
  u32x4 v; v[0] = pack_bf2(a0, a1); v[1] = pack_bf2(a2, a3); v[2] = pack_bf2(a4, a5); v[3] = pack_bf2(a6, a7);
  return __builtin_bit_cast(bf16x8, v);
}
DI float wave_sum(float v) {
#pragma unroll
  for (int o = 32; o > 0; o >>= 1) v += __shfl_xor(v, o, 64);
  return v;
}
DI void seq_of_tok(int tok, int& start, int& T) {
  if (tok < 4096) { start = tok & ~255; T = 256; } else { start = 4096 + ((tok - 4096) & ~2047); T = 2048; }
}
DI int cv_of_tok(int tok) { return tok < 4096 ? 0 : 1 + ((tok - 4096) >> 11); }
DI void seq_info(int seq, int& start, int& T) {
  if (seq < 16) { start = seq * 256; T = 256; } else { start = 4096 + (seq - 16) * 2048; T = 2048; }
}


#define XB_TMO      128
#define XB_XCNT(j)  (256  + 64 * (j))
#define XB_XSUB(j)  (1280 + 64 * (j))
#define XB_XGEN(j)  (2304 + 64 * (j))
#define XB_TOP      3328
#define XB_TOPGEN   3392
#define XCD_BAR_WORDS 3456
#define XB_SPIN_CAP (1u << 18)
#define LAS __attribute__((address_space(3)))
DI unsigned xb_ld(unsigned* p) { return __hip_atomic_load((GAS unsigned*)p, __ATOMIC_RELAXED, __HIP_MEMORY_SCOPE_AGENT); }
DI unsigned xb_add(unsigned* p, unsigned v) { return __hip_atomic_fetch_add((GAS unsigned*)p, v, __ATOMIC_RELAXED, __HIP_MEMORY_SCOPE_AGENT); }
DI unsigned xb_xcc_id() { return (unsigned)__builtin_amdgcn_s_getreg((3 << 11) | 20) & 0xFu; }
#define XB_SPIN(cond, bar) do { unsigned _sp = 0; while (cond) { __builtin_amdgcn_s_sleep(1); \
    if ((++_sp & 255u) == 0u) { if (xb_ld(&(bar)[XB_TMO])) break; if (_sp > XB_SPIN_CAP) { atomicAdd(&(bar)[XB_TMO], 1u); break; } } } } while (0)
struct XcdBarrier { unsigned* bar; volatile LAS unsigned* st; };
DI XcdBarrier xcd_barrier_post(unsigned* bar, volatile LAS unsigned* st) {
  XcdBarrier b; b.bar = bar; b.st = st;
  if (threadIdx.x == 0) { unsigned x = xb_xcc_id(); st[2] = x; (void)xb_add(&bar[XB_XCNT(x)], 1u); }
  return b;
}
DI void xcd_barrier_complete(unsigned* bar, unsigned x, unsigned& nloc, unsigned& nx) {
  const unsigned G = gridDim.x * gridDim.y * gridDim.z;
  unsigned sum, cnt, mine, sp = 0u;
  for (;;) {
    sum = 0u; cnt = 0u; mine = 0u;
#pragma unroll
    for (unsigned j = 0; j < 16; ++j) { const unsigned c = xb_ld(&bar[XB_XCNT(j)]); sum += c; cnt += (c > 0u) ? 1u : 0u; mine = (j == x) ? c : mine; }
    if (sum == G) break;
    __builtin_amdgcn_s_sleep(1);
    if ((++sp & 255u) == 0u) { if (xb_ld(&bar[XB_TMO])) break; if (sp > XB_SPIN_CAP) { atomicAdd(&bar[XB_TMO], 1u); break; } }
  }
  nloc = mine > 0u ? mine : 1u; nx = cnt > 0u ? cnt : 1u;
}
DI void xcd_barrier(const XcdBarrier& b) {
  asm volatile("s_waitcnt vmcnt(0)" ::: "memory");
  __syncthreads();
  if (threadIdx.x == 0) {
    unsigned* bar = b.bar;
    asm volatile("" : "+s"(bar));
    __builtin_amdgcn_s_waitcnt(0);
    unsigned nloc = b.st[0], nx = b.st[1]; const unsigned bx = b.st[2];
    if (nloc == 0u) { xcd_barrier_complete(bar, bx, nloc, nx); b.st[0] = nloc; b.st[1] = nx; }
    const unsigned old = xb_add(&bar[XB_XSUB(bx)], 1u);
    const unsigned gen = old / nloc;
    if (old + 1u == (gen + 1u) * nloc) {
      __builtin_amdgcn_fence(__ATOMIC_RELEASE, "agent");
      asm volatile("s_waitcnt vmcnt(0)" ::: "memory");
      const unsigned og = xb_add(&bar[XB_TOP], 1u);
      const unsigned tg = og / nx;
      if (og + 1u == (tg + 1u) * nx) xb_add(&bar[XB_TOPGEN], 1u);
      else XB_SPIN(xb_ld(&bar[XB_TOPGEN]) == tg, bar);
      __builtin_amdgcn_fence(__ATOMIC_ACQUIRE, "agent");
      xb_add(&bar[XB_XGEN(bx)], 1u);
      asm volatile("s_waitcnt vmcnt(0)" ::: "memory");
    } else {
      XB_SPIN(xb_ld(&bar[XB_XGEN(bx)]) == gen, bar);
      __builtin_amdgcn_fence(__ATOMIC_ACQUIRE, "agent");
      asm volatile("s_waitcnt vmcnt(0)" ::: "memory");
    }
  }
  __syncthreads();
}

template <int BM, int BN, class Epi>
DI void gemm_tile(const bf16_t* __restrict__ A, int lda, const bf16_t* __restrict__ Bt, int ldb, int K, char* smem, const Epi& epi) {
  constexpr int LS = 40;
  constexpr int MI = BM / 64, NI = BN / 64;
  constexpr int A_CH = BM * 4 / 256, B_CH = BN * 4 / 256;
  bf16_t* sbase = (bf16_t*)smem;
  const int tid = otid(), lane = tid & 63, w = tid >> 6, wm = w >> 1, wn = w & 1, r = lane & 31, h = lane >> 5;
  f32x16 acc[MI][NI];
#pragma unroll
  for (int mi = 0; mi < MI; ++mi)
#pragma unroll
    for (int ni = 0; ni < NI; ++ni)
#pragma unroll
      for (int i = 0; i < 16; ++i) acc[mi][ni][i] = 0.f;
  u32x4 ra[A_CH], rb[B_CH];
  const int KT = K / 32;
#define GLOAD(kt)                                                                                   \
  {                                                                                                 \
    _Pragma("unroll") for (int i = 0; i < A_CH; ++i) {                                              \
      int c = tid + i * 256; int row = c >> 2, kc = c & 3;                                          \
      ra[i] = *(const u32x4*)(A + (size_t)row * lda + (kt) * 32 + kc * 8);                          \
    }                                                                                               \
    _Pragma("unroll") for (int i = 0; i < B_CH; ++i) {                                              \
      int c = tid + i * 256; int row = c >> 2, kc = c & 3;                                          \
      rb[i] = *(const u32x4*)(Bt + (size_t)row * ldb + (kt) * 32 + kc * 8);                         \
    }                                                                                               \
  }
#define SSTORE(s)                                                                                   \
  {                                                                                                 \
    bf16_t* sa = sbase + (s) * (BM + BN) * LS; bf16_t* sb = sa + BM * LS;                           \
    _Pragma("unroll") for (int i = 0; i < A_CH; ++i) {                                              \
      int c = tid + i * 256; int row = c >> 2, kc = c & 3;                                          \
      *(u32x4*)(sa + row * LS + kc * 8) = ra[i];                                                    \
    }                                                                                               \
    _Pragma("unroll") for (int i = 0; i < B_CH; ++i) {                                              \
      int c = tid + i * 256; int row = c >> 2, kc = c & 3;                                          \
      *(u32x4*)(sb + row * LS + kc * 8) = rb[i];                                                    \
    }                                                                                               \
  }
  GLOAD(0);
  SSTORE(0);
  __syncthreads();
  for (int kt = 0; kt < KT; ++kt) {
    if (kt + 1 < KT) GLOAD(kt + 1);
    const bf16_t* sa = sbase + (kt & 1) * (BM + BN) * LS;
    const bf16_t* sb = sa + BM * LS;
    const bf16_t* a_s = sa + (wm * (BM / 2) + r) * LS + h * 8;
    const bf16_t* b_s = sb + (wn * (BN / 2) + r) * LS + h * 8;
#pragma unroll
    for (int ks = 0; ks < 2; ++ks) {
      bf16x8 af[MI], bfr[NI];
#pragma unroll
      for (int mi = 0; mi < MI; ++mi) af[mi] = *(const bf16x8*)(a_s + mi * 32 * LS + ks * 16);
#pragma unroll
      for (int ni = 0; ni < NI; ++ni) bfr[ni] = *(const bf16x8*)(b_s + ni * 32 * LS + ks * 16);
#pragma unroll
      for (int mi = 0; mi < MI; ++mi)
#pragma unroll
        for (int ni = 0; ni < NI; ++ni) acc[mi][ni] = __builtin_amdgcn_mfma_f32_32x32x16_bf16(af[mi], bfr[ni], acc[mi][ni], 0, 0, 0);
    }
    if (kt + 1 < KT) SSTORE((kt + 1) & 1);
    __syncthreads();
  }
#undef GLOAD
#undef SSTORE
#pragma unroll
  for (int mi = 0; mi < MI; ++mi)
#pragma unroll
    for (int ni = 0; ni < NI; ++ni) {
#pragma unroll
      for (int i = 0; i < 16; ++i) {
        int rr = wm * (BM / 2) + mi * 32 + (i & 3) + 8 * (i >> 2) + 4 * h;
        int cc = wn * (BN / 2) + ni * 32 + r;
        epi(rr, cc, acc[mi][ni][i]);
        if ((i & 3) == 3) __builtin_amdgcn_sched_barrier(0);
      }
    }
}

template <int BM, int BN, class Epi, bool TILE_EPI = false>
DI void gemm_tile64(const bf16_t* __restrict__ A, int lda, const bf16_t* __restrict__ Bt, int ldb, int K, char* smem, const Epi& epi) {
  constexpr int LS = 72;
  constexpr int MI = BM / 64, NI = BN / 64;
  constexpr int A_CH = BM * 8 / 256, B_CH = BN * 8 / 256;
  bf16_t* sa = (bf16_t*)smem;
  bf16_t* sb = sa + BM * LS;
  const int tid = otid(), lane = tid & 63, w = tid >> 6, wm = w >> 1, wn = w & 1, r = lane & 31, h = lane >> 5;
  f32x16 acc[MI][NI];
#pragma unroll
  for (int mi = 0; mi < MI; ++mi)
#pragma unroll
    for (int ni = 0; ni < NI; ++ni)
#pragma unroll
      for (int i = 0; i < 16; ++i) acc[mi][ni][i] = 0.f;
  u32x4 ra[A_CH], rb[B_CH];
  const int KT = K / 64;
  const bf16_t* ag = A + (size_t)(tid >> 3) * lda + (tid & 7) * 8;
  const bf16_t* bg = Bt + (size_t)(tid >> 3) * ldb + (tid & 7) * 8;
  bf16_t* sa_w = sa + (tid >> 3) * LS + (tid & 7) * 8;
  bf16_t* sb_w = sb + (tid >> 3) * LS + (tid & 7) * 8;
#pragma unroll
  for (int i = 0; i < A_CH; ++i) ra[i] = *gptr((const u32x4*)(ag + (size_t)i * 32 * lda));
#pragma unroll
  for (int i = 0; i < B_CH; ++i) rb[i] = *gptr((const u32x4*)(bg + (size_t)i * 32 * ldb));
  const bf16_t* a_s = sa + (wm * (BM / 2) + r) * LS + h * 8;
  const bf16_t* b_s = sb + (wn * (BN / 2) + r) * LS + h * 8;
#pragma unroll 1
  for (int kt = 0; kt < KT; ++kt) {
    __syncthreads();
#pragma unroll
    for (int i = 0; i < A_CH; ++i) *(u32x4*)(sa_w + i * 32 * LS) = ra[i];
#pragma unroll
    for (int i = 0; i < B_CH; ++i) *(u32x4*)(sb_w + i * 32 * LS) = rb[i];
    __syncthreads();
    if (kt + 1 < KT) {
#pragma unroll
      for (int i = 0; i < A_CH; ++i) ra[i] = *gptr((const u32x4*)(ag + (size_t)i * 32 * lda + (kt + 1) * 64));
#pragma unroll
      for (int i = 0; i < B_CH; ++i) rb[i] = *gptr((const u32x4*)(bg + (size_t)i * 32 * ldb + (kt + 1) * 64));
    }
#pragma unroll
    for (int ks = 0; ks < 4; ++ks) {
      bf16x8 af[MI], bfr[NI];
#pragma unroll
      for (int mi = 0; mi < MI; ++mi) af[mi] = *(const bf16x8*)(a_s + mi * 32 * LS + ks * 16);
#pragma unroll
      for (int ni = 0; ni < NI; ++ni) bfr[ni] = *(const bf16x8*)(b_s + ni * 32 * LS + ks * 16);
#pragma unroll
      for (int mi = 0; mi < MI; ++mi)
#pragma unroll
        for (int ni = 0; ni < NI; ++ni) acc[mi][ni] = __builtin_amdgcn_mfma_f32_32x32x16_bf16(af[mi], bfr[ni], acc[mi][ni], 0, 0, 0);
    }
  }
  if constexpr (TILE_EPI) {
    epi.tile(acc, wm, wn, r, h, smem);
  } else {
#pragma unroll
    for (int mi = 0; mi < MI; ++mi)
#pragma unroll
      for (int ni = 0; ni < NI; ++ni) {
#pragma unroll
        for (int i = 0; i < 16; ++i) {
          int rr = wm * (BM / 2) + mi * 32 + (i & 3) + 8 * (i >> 2) + 4 * h;
          int cc = wn * (BN / 2) + ni * 32 + r;
          epi(rr, cc, acc[mi][ni][i]);
          if ((i & 3) == 3) __builtin_amdgcn_sched_barrier(0);
        }
      }
  }
  __syncthreads();
}

template <class Epi>
DI void gemm_tile64_pf2(const bf16_t* __restrict__ A, int lda, const bf16_t* __restrict__ Bt, int ldb, int K, char* smem, const Epi& epi) {
  constexpr int BM = 128, BN = 128, LS = 72, MI = 2, NI = 2, CH = 4;
  bf16_t* sa = (bf16_t*)smem;
  bf16_t* sb = sa + BM * LS;
  const int tid = otid(), lane = tid & 63, w = tid >> 6, wm = w >> 1, wn = w & 1, r = lane & 31, h = lane >> 5;
  f32x16 acc[MI][NI];
#pragma unroll
  for (int mi = 0; mi < MI; ++mi)
#pragma unroll
    for (int ni = 0; ni < NI; ++ni)
#pragma unroll
      for (int i = 0; i < 16; ++i) acc[mi][ni][i] = 0.f;
  u32x4 ra0[CH], rb0[CH], ra1[CH], rb1[CH];
  const int KT = K / 64;
  const bf16_t* ag = A + (size_t)(tid >> 3) * lda + (tid & 7) * 8;
  const bf16_t* bg = Bt + (size_t)(tid >> 3) * ldb + (tid & 7) * 8;
  bf16_t* sa_w = sa + (tid >> 3) * LS + (tid & 7) * 8;
  bf16_t* sb_w = sb + (tid >> 3) * LS + (tid & 7) * 8;
#pragma unroll
  for (int i = 0; i < CH; ++i) { ra0[i] = *gptr((const u32x4*)(ag + (size_t)i * 32 * lda)); rb0[i] = *gptr((const u32x4*)(bg + (size_t)i * 32 * ldb)); }
#pragma unroll
  for (int i = 0; i < CH; ++i) { ra1[i] = *gptr((const u32x4*)(ag + (size_t)i * 32 * lda + 64)); rb1[i] = *gptr((const u32x4*)(bg + (size_t)i * 32 * ldb + 64)); }
  const bf16_t* a_s = sa + (wm * (BM / 2) + r) * LS + h * 8;
  const bf16_t* b_s = sb + (wn * (BN / 2) + r) * LS + h * 8;
#define PF2_COMPUTE()                                                                                  \
  {                                                                                                    \
    bf16x8 af[4][MI], bfr[4][NI];                                                                      \
    _Pragma("unroll") for (int ks = 0; ks < 4; ++ks) {                                                 \
      _Pragma("unroll") for (int mi = 0; mi < MI; ++mi) af[ks][mi] = *(const bf16x8*)(a_s + mi * 32 * LS + ks * 16);   \
      _Pragma("unroll") for (int ni = 0; ni < NI; ++ni) bfr[ks][ni] = *(const bf16x8*)(b_s + ni * 32 * LS + ks * 16);  \
    }                                                                                                  \
    __builtin_amdgcn_sched_barrier(0);     \
    _Pragma("unroll") for (int ks = 0; ks < 4; ++ks)                                                   \
      _Pragma("unroll") for (int mi = 0; mi < MI; ++mi)                                                \
        _Pragma("unroll") for (int ni = 0; ni < NI; ++ni)                                              \
          acc[mi][ni] = __builtin_amdgcn_mfma_f32_32x32x16_bf16(af[ks][mi], bfr[ks][ni], acc[mi][ni], 0, 0, 0);  \
    __builtin_amdgcn_sched_barrier(0);                                                                 \
  }
#pragma unroll 1
  for (int kt = 0; kt < KT; kt += 2) {
    __syncthreads();
#pragma unroll
    for (int i = 0; i < CH; ++i) { *(u32x4*)(sa_w + i * 32 * LS) = ra0[i]; *(u32x4*)(sb_w + i * 32 * LS) = rb0[i]; }
    __syncthreads();
    if (kt + 2 < KT) {
#pragma unroll
      for (int i = 0; i < CH; ++i) { ra0[i] = *gptr((const u32x4*)(ag + (size_t)i * 32 * lda + (kt + 2) * 64)); rb0[i] = *gptr((const u32x4*)(bg + (size_t)i * 32 * ldb + (kt + 2) * 64)); }
    }
    PF2_COMPUTE();
    __syncthreads();
#pragma unroll
    for (int i = 0; i < CH; ++i) { *(u32x4*)(sa_w + i * 32 * LS) = ra1[i]; *(u32x4*)(sb_w + i * 32 * LS) = rb1[i]; }
    __syncthreads();
    if (kt + 3 < KT) {
#pragma unroll
      for (int i = 0; i < CH; ++i) { ra1[i] = *gptr((const u32x4*)(ag + (size_t)i * 32 * lda + (kt + 3) * 64)); rb1[i] = *gptr((const u32x4*)(bg + (size_t)i * 32 * ldb + (kt + 3) * 64)); }
    }
    PF2_COMPUTE();
  }
#undef PF2_COMPUTE
#pragma unroll
  for (int mi = 0; mi < MI; ++mi)
#pragma unroll
    for (int ni = 0; ni < NI; ++ni) {
#pragma unroll
      for (int i = 0; i < 16; ++i) {
        int rr = wm * (BM / 2) + mi * 32 + (i & 3) + 8 * (i >> 2) + 4 * h;
        int cc = wn * (BN / 2) + ni * 32 + r;
        epi(rr, cc, acc[mi][ni][i]);
        if ((i & 3) == 3) __builtin_amdgcn_sched_barrier(0);
      }
    }
  __syncthreads();
}

DI bool xcd_tile(int k, int MT, int NT, int& mt, int& nt) {
  const int b = obid(), G = gridDim.x;
  if ((G & 7) == 0) {
    int xcd = b & 7, local = b >> 3, per = (MT >> 3) * NT, idx = local + k * (G >> 3);
    if (idx >= per) return false;
    mt = (idx / NT) * 8 + xcd; nt = idx % NT; return true;
  }
  int idx = b + k * G; if (idx >= MT * NT) return false;
  mt = idx / NT; nt = idx % NT; return true;
}

struct EpiG1 {
  float* proj; bf16_t* uvt; int m0, n0;
  DI void operator()(int r, int c, float v) const {
    int tok = m0 + r, n = n0 + c;
    if (n < 1536) gptr(proj)[(size_t)tok * PLD + n] = v;
    else if (n >= 2048) gptr(proj)[(size_t)tok * PLD + n - 512] = v;
    else {
      int cc = n - 1536; int part = cc >> 8, ch = cc & 255; int start, T; seq_of_tok(tok, start, T);
      gptr(uvt)[(size_t)512 * start + (size_t)ch * 2 * T + part * T + (tok - start)] = f2bf(v);
    }
  }
};
struct EpiStoreBf { bf16_t* dst; int ld; DI void operator()(int r, int c, float v) const { dst[(size_t)r * ld + c] = f2bf(v); } };
struct EpiStoreF { float* dst; int ld; DI void operator()(int r, int c, float v) const { gptr(dst)[(size_t)r * ld + c] = v; } };
struct EpiResid {
  float* x; const float* gate; int m0, n0;
  const float* xp; const float* xs;
  DI void operator()(int r, int c, float v) const {
    int tok = m0 + r, col = n0 + c; size_t i = (size_t)tok * DM + col;
    float xin = xp ? (tok < 4096 ? gptr(xp)[i] : gptr(xs)[i - (size_t)4096 * DM]) : gptr(x)[i];
    gptr(x)[i] = xin + gptr(gate)[cv_of_tok(tok) * 6144 + col] * v;
  }
};

struct EpiConvGate {
  bf16_t* act; const float* cw; const float* cb; int m0; int nt; bool ctx;
  DI void tile(f32x16 (&acc)[4][2], int wm, int wn, int r, int h, char* smem) const {
    const int j = nt * 64 + wn * 32 + r;
    float w0[2], w1[2], w2[2], bs[2];
#pragma unroll
    for (int ni = 0; ni < 2; ++ni) {
      int ch = ni * DFF + j;
      w0[ni] = gptr(cw)[ch]; w1[ni] = gptr(cw)[DUP + ch]; w2[ni] = gptr(cw)[2 * DUP + ch]; bs[ni] = gptr(cb)[ch];
    }
    float* edge = (float*)smem;
    __syncthreads();
#pragma unroll
    for (int ni = 0; ni < 2; ++ni) {
      if (h == 0) edge[((((wm * 2 + wn) * 2 + ni) * 2) + 0) * 32 + r] = acc[0][ni][0];
      else        edge[((((wm * 2 + wn) * 2 + ni) * 2) + 1) * 32 + r] = acc[3][ni][15];
    }
    __syncthreads();
    float up_edge[2], dn_edge[2];
#pragma unroll
    for (int ni = 0; ni < 2; ++ni) {
      float ue = edge[((((0 * 2 + wn) * 2 + ni) * 2) + 1) * 32 + r];
      float de = edge[((((1 * 2 + wn) * 2 + ni) * 2) + 0) * 32 + r];
      up_edge[ni] = (ctx && wm == 1) ? ue : 0.f;
      dn_edge[ni] = (ctx && wm == 0) ? de : 0.f;
    }
    float Bp[2][4], Tp[2][4];
#pragma unroll
    for (int ni = 0; ni < 2; ++ni)
#pragma unroll
      for (int mi = 0; mi < 4; ++mi) {
        Bp[ni][mi] = __shfl_xor(acc[mi][ni][15], 32, 64);
        Tp[ni][mi] = __shfl_xor(acc[mi][ni][0], 32, 64);
      }
#pragma unroll
    for (int mi = 0; mi < 4; ++mi) {
      float zc[2][16];
#pragma unroll
      for (int ni = 0; ni < 2; ++ni) {
        float prev_in = (mi == 0) ? up_edge[ni] : ((mi == 2 && !ctx) ? 0.f : Bp[ni][mi > 0 ? mi - 1 : 0]);
        float next_in = (mi == 3) ? dn_edge[ni] : ((mi == 1 && !ctx) ? 0.f : Tp[ni][mi < 3 ? mi + 1 : 3]);
        float rp[4], rn[4];
#pragma unroll
        for (int g = 0; g < 4; ++g) {
          float sp_ = (h == 0) ? acc[mi][ni][4 * g + 3] : acc[mi][ni][g > 0 ? 4 * g - 1 : 0];
          float sn_ = (h == 1) ? acc[mi][ni][4 * g] : acc[mi][ni][g < 3 ? 4 * g + 4 : 15];
          rp[g] = __shfl_xor(sp_, 32, 64);
          rn[g] = __shfl_xor(sn_, 32, 64);
        }
#pragma unroll
        for (int e = 0; e < 16; ++e) {
          const int g = e >> 2;
          float pv, nx;
          if ((e & 3) != 0) pv = acc[mi][ni][e - 1];
          else pv = (h == 1) ? rp[g] : (g > 0 ? rp[g] : prev_in);
          if ((e & 3) != 3) nx = acc[mi][ni][e + 1];
          else nx = (h == 0) ? rn[g] : (g < 3 ? rn[g] : next_in);
          zc[ni][e] = bs[ni] + w0[ni] * pv + w1[ni] * acc[mi][ni][e] + w2[ni] * nx;
        }
      }
#pragma unroll
      for (int e = 0; e < 16; ++e) {
        int row = m0 + wm * 128 + mi * 32 + (e & 3) + 8 * (e >> 2) + 4 * h;
        gptr(act)[(size_t)row * DFF + j] = f2bf(gelu_t(zc[0][e]) * zc[1][e]);
        if ((e & 3) == 3) __builtin_amdgcn_sched_barrier(0);
      }
    }
  }
};

DI void ph_convert_weights(const Params& p, int l, char* smem, bool skip_fold = false) {
  float(*tile)[65] = (float(*)[65])smem;
  float(*t1)[65] = (float(*)[65])(smem + 64 * 65 * 4);
  float(*t2)[65] = (float(*)[65])(smem + 2 * 64 * 65 * 4);
  float* tw = (float*)(smem + 3 * 64 * 65 * 4);
  const int tid = otid();
  constexpr int N_IT = 640 + 256 + 1408 + 704 + 16;
  for (int it = obid(); it < N_IT; it += gridDim.x) {
    const float* src; bf16_t* dst; int K, Nsrc, n0, k0, sc0, fold = -1; bool wup_perm = false;
    int j = it;
    if (j < 640) {
      int nt = j / 16, kt = j % 16; src = p.inp(I_WIN) + (size_t)l * 1024 * 2304; K = 1024; Nsrc = 2304; n0 = nt * 64; k0 = kt * 64;
      dst = (bf16_t*)(p.wsp() + OFF_WIN);
      if (n0 < 1536) sc0 = n0;
      else if (n0 < 2048) { int cc = n0 - 1536; fold = cc >> 8; sc0 = cc & 255; }
      else sc0 = n0 - 256;
    } else if ((j -= 640) < 256) {
      int nt = j / 16, kt = j % 16; src = p.inp(I_WOUT) + (size_t)l * 1024 * 1024; K = 1024; Nsrc = 1024; n0 = nt * 64; k0 = kt * 64; sc0 = n0;
      dst = (bf16_t*)(p.wsp() + OFF_WOUT);
    } else if ((j -= 256) < 1408) {
      int nt = j / 16, kt = j % 16; src = p.inp(I_WUP) + (size_t)l * 1024 * DUP; K = 1024; Nsrc = DUP; n0 = nt * 64; k0 = kt * 64; sc0 = n0;
      dst = (bf16_t*)(p.wsp() + OFF_WUP); wup_perm = true;
    } else if ((j -= 1408) < 704) {
      int nt = j / 44, kt = j % 44; src = p.inp(I_WDN) + (size_t)l * DFF * 1024; K = DFF; Nsrc = 1024; n0 = nt * 64; k0 = kt * 64; sc0 = n0;
      dst = (bf16_t*)(p.wsp() + OFF_WDN);
    } else {
      j -= 704; int nt = j / 4, kt = j % 4; src = p.inp(I_WGLU) + (size_t)l * 65536; K = 256; Nsrc = 256; n0 = nt * 64; k0 = kt * 64; sc0 = n0;
      dst = (bf16_t*)(p.wsp() + OFF_WGLU);
    }
    if (fold < 0) {
#pragma unroll
      for (int i = 0; i < 16; ++i) {
        int kk = (tid >> 6) + 4 * i, nn = tid & 63;
        int sc = sc0 + nn;
        if (wup_perm) sc = ((nn & 32) ? DFF : 0) + (n0 >> 7) * 64 + ((n0 >> 6) & 1) * 32 + (nn & 31);
        tile[kk][nn] = gptr(src)[(size_t)(k0 + kk) * Nsrc + sc];
      }
      __syncthreads();
#pragma unroll
      for (int i = 0; i < 16; ++i) {
        int kk = tid & 63, nn = (tid >> 6) + 4 * i;
        gptr(dst)[(size_t)(n0 + nn) * K + k0 + kk] = f2bf(tile[kk][nn]);
      }
      __syncthreads();
    } else if (!skip_fold) {
      const bf16_t* wf = (const bf16_t*)(p.wsp() + OFF_WFOLD) + (size_t)l * 512 * 1024;
#pragma unroll
      for (int i = 0; i < 16; ++i) {
        int kk = tid & 63, nn = (tid >> 6) + 4 * i;
        gptr(dst)[(size_t)(n0 + nn) * K + k0 + kk] = gptr(wf)[(size_t)(n0 - 1536 + nn) * 1024 + k0 + kk];
      }
      __syncthreads();
    }
  }
}

DI void ph_mu(const Params& p, char* smem) {
  float(*t1)[65] = (float(*)[65])smem;
  float* tw = (float*)(smem + 64 * 65 * 4);
  const int tid = otid();
  float* mu = (float*)(p.wsp() + OFF_MU);
  for (int it = obid(); it < 64; it += gridDim.x) {
    int ct = it & 3, hd = (it >> 2) & 3, part = (it >> 4) & 1, l = it >> 5;
    const float* fnw = p.inp(I_FNW) + (size_t)l * 65536;
    __syncthreads();
    if (tid < 64) tw[tid] = (part == 0) ? cospif((float)tid / 32.f) : sinpif((float)tid / 32.f);
#pragma unroll
    for (int i = 0; i < 16; ++i) { int rr = (tid >> 6) + 4 * i, cc = tid & 63; t1[rr][cc] = gptr(fnw)[(size_t)(hd * 64 + rr) * 256 + ct * 64 + cc]; }
    __syncthreads();
#pragma unroll 1
    for (int i = 0; i < 16; ++i) {
      int jj = (tid >> 6) + 4 * i, cc = tid & 63;
      float sacc = 0.f;
#pragma unroll 8
      for (int kk = 0; kk < 64; ++kk) sacc += tw[(jj * kk) & 63] * t1[kk][cc];
      gptr(mu)[((size_t)(l * 2 + part) * 256 + hd * 64 + jj) * 256 + ct * 64 + cc] = 0.125f * sacc;
    }
  }
  __syncthreads();
}
DI void ph_fold(const Params& p, char* smem) {
  float(*t0)[65] = (float(*)[65])smem;
  float(*t2)[65] = (float(*)[65])(smem + 64 * 65 * 4);
  const int tid = otid();
  const float* mu = (const float*)(p.wsp() + OFF_MU);
  bf16_t* wf = (bf16_t*)(p.wsp() + OFF_WFOLD);
  for (int it = obid(); it < 256; it += gridDim.x) {
    int ct = it & 3, kt = (it >> 2) & 15, part = (it >> 6) & 1, l = it >> 7;
    const float* src = p.inp(I_WIN) + (size_t)l * 1024 * 2304;
    float acc[16];
#pragma unroll
    for (int i = 0; i < 16; ++i) acc[i] = 0.f;
#pragma unroll 1
    for (int hd = 0; hd < 4; ++hd) {
      __syncthreads();
#pragma unroll
      for (int i = 0; i < 16; ++i) {
        int rr = (tid >> 6) + 4 * i, cc = tid & 63;
        t0[rr][cc] = gptr(src)[(size_t)(kt * 64 + rr) * 2304 + 1536 + hd * 64 + cc];
        t2[rr][cc] = gptr(mu)[((size_t)(l * 2 + part) * 256 + hd * 64 + rr) * 256 + ct * 64 + cc];
      }
      __syncthreads();
      const int kk = tid & 63;
#pragma unroll 2
      for (int jj = 0; jj < 64; ++jj) {
        float a = t0[kk][jj];
#pragma unroll
        for (int i = 0; i < 16; ++i) acc[i] += a * t2[jj][(tid >> 6) + 4 * i];
      }
    }
#pragma unroll
    for (int i = 0; i < 16; ++i) {
      int kk = tid & 63, nn = (tid >> 6) + 4 * i;
      gptr(wf)[((size_t)l * 512 + part * 256 + ct * 64 + nn) * 1024 + kt * 64 + kk] = f2bf(acc[i]);
    }
  }
  __syncthreads();
}

DI void ph_fold_copy(const Params& p, int l) {
  const int gtid = obid() * 256 + otid(), gsz = gridDim.x * 256;
  const u32x4* src = (const u32x4*)(p.wsp() + OFF_WFOLD + (size_t)l * 512 * 1024 * 2);
  u32x4* dst = (u32x4*)(p.wsp() + OFF_WIN + (size_t)1536 * 1024 * 2);
  for (int e = gtid; e < 512 * 1024 / 8; e += gsz) dst[e] = src[e];
}

DI void ph_prep(const Params& p, char* smem) {
  const int tid = otid();
  ph_convert_weights(p, 0, smem, true);
  {
    float* sl = (float*)smem;
    float* red = sl + 192;
    float* adap = (float*)(p.wsp() + OFF_ADAP);
    for (int it = obid(); it < 2 * 24 * NKC; it += gridDim.x) {
      int kc = it % NKC, nc = (it / NKC) % 24, l = it / (NKC * 24);
      if (tid < 192) {
        int cv = tid >> 6, kk = tid & 63; int k = kc * 64 + kk;
        float cval = (cv == 0) ? p.inp(I_CCTX)[k] : p.inp(I_C)[(cv - 1) * 1024 + k];
        sl[tid] = silu_f(cval);
      }
      __syncthreads();
      int rg = tid >> 6, lane = tid & 63;
      float a0[4] = {0, 0, 0, 0}, a1[4] = {0, 0, 0, 0}, a2[4] = {0, 0, 0, 0};
      const float* wsrc = p.inp(I_WADA) + (size_t)l * 1024 * 6144 + nc * 256 + lane * 4;
#pragma unroll 4
      for (int i = 0; i < 16; ++i) {
        int kk = rg * 16 + i;
        float4 wv = ldg4(wsrc + (size_t)(kc * 64 + kk) * 6144);
        float s0 = sl[kk], s1 = sl[64 + kk], s2 = sl[128 + kk];
        a0[0] += s0 * wv.x; a0[1] += s0 * wv.y; a0[2] += s0 * wv.z; a0[3] += s0 * wv.w;
        a1[0] += s1 * wv.x; a1[1] += s1 * wv.y; a1[2] += s1 * wv.z; a1[3] += s1 * wv.w;
        a2[0] += s2 * wv.x; a2[1] += s2 * wv.y; a2[2] += s2 * wv.z; a2[3] += s2 * wv.w;
      }
#pragma unroll
      for (int q = 0; q < 4; ++q) {
        red[(rg * 3 + 0) * 256 + lane * 4 + q] = a0[q];
        red[(rg * 3 + 1) * 256 + lane * 4 + q] = a1[q];
        red[(rg * 3 + 2) * 256 + lane * 4 + q] = a2[q];
      }
      __syncthreads();
#pragma unroll
      for (int cv = 0; cv < 3; ++cv) {
        float s = red[(0 * 3 + cv) * 256 + tid] + red[(1 * 3 + cv) * 256 + tid] + red[(2 * 3 + cv) * 256 + tid] + red[(3 * 3 + cv) * 256 + tid];
        adap[((size_t)(kc * 2 + l) * 3 + cv) * 6144 + nc * 256 + tid] = s;
      }
      __syncthreads();
    }
  }
  const int gtid = obid() * 256 + tid, gsz = gridDim.x * 256;
  {
    float* s5a = (float*)(p.wsp() + OFF_S5A); float* s5al = (float*)(p.wsp() + OFF_S5AL);
    float* bbr = (float*)(p.wsp() + OFF_S5BBR); float* bbi = (float*)(p.wsp() + OFF_S5BBI);
    for (int e = gtid; e < 4096 * 16; e += gsz) {
      int idx = e >> 4, pp = e & 15;
      float lr = fminf(p.inp(I_LAMRE)[idx], -1e-4f), li = p.inp(I_LAMIM)[idx];
      float dt = expf(p.inp(I_LOGDT)[idx >> 6]);
      float mag = expf(lr * dt), ang = li * dt;
      float are = mag * cosf(ang), aim = mag * sinf(ang);
      float den = lr * lr + li * li, xr = are - 1.f;
      float zre = (xr * lr + aim * li) / den, zim = (aim * lr - xr * li) / den;
      float br = p.inp(I_BRE)[e], bi = p.inp(I_BIM)[e];
      bbr[e] = zre * br - zim * bi;
      bbi[e] = zre * bi + zim * br;
      if (pp == 0) {
        s5a[idx * 2] = are; s5a[idx * 2 + 1] = aim;
        float pr = are, pi = aim;
#pragma unroll
        for (int q = 0; q < 5; ++q) { float nr = pr * pr - pi * pi, ni = 2.f * pr * pi; pr = nr; pi = ni; }
        s5al[idx * 2] = pr; s5al[idx * 2 + 1] = pi;
      }
    }
  }
  {
    bf16_t* cmt = (bf16_t*)(p.wsp() + OFF_CMT);
    for (int e = gtid; e < 2 * 2 * 16 * 16 * 128; e += gsz) {
      int k = e & 127, row = e >> 7; int n = k >> 1;
      float v = (k & 1) ? -p.inp(I_CIM)[(size_t)row * 64 + n] : p.inp(I_CRE)[(size_t)row * 64 + n];
      cmt[e] = f2bf(v);
    }
    bf16_t* wsb = (bf16_t*)(p.wsp() + OFF_WSB);
    for (int e = gtid; e < 2 * 4 * 128 * 128; e += gsz) wsb[e] = f2bf(p.inp(I_GMWS)[e]);
  }
  {
    float* ctab = (float*)smem; float* stab = ctab + 2048;
    __syncthreads();
    for (int m = tid; m < 2048; m += 256) { float a = (float)m / 1024.f; ctab[m] = cospif(a) * 0.02209708691207961f; stab[m] = -sinpif(a) * 0.02209708691207961f; }
    __syncthreads();
    bf16_t* dl = (bf16_t*)(p.wsp() + OFF_DFTL);
    for (int e = gtid; e < 2048 * 256; e += gsz) {
      int t = e >> 8, s0 = (e & 255) * 8;
      float c[8], sn[8];
#pragma unroll
      for (int q = 0; q < 8; ++q) { int m = (t * (s0 + q)) & 2047; c[q] = ctab[m]; sn[q] = stab[m]; }
      *(bf16x8*)(dl + (size_t)t * 4096 + s0) = pack8(c[0], c[1], c[2], c[3], c[4], c[5], c[6], c[7]);
      *(bf16x8*)(dl + (size_t)t * 4096 + 2048 + s0) = pack8(sn[0], sn[1], sn[2], sn[3], sn[4], sn[5], sn[6], sn[7]);
    }
    bf16_t* dc = (bf16_t*)(p.wsp() + OFF_DFTC);
    const float rs = 0.0625f / 0.02209708691207961f;
    for (int e = gtid; e < 256 * 256; e += gsz) {
      int t = e >> 8, s2 = e & 255; int m = ((t * s2) & 255) * 8;
      dc[t * 512 + s2] = f2bf(ctab[m] * rs);
      dc[t * 512 + 256 + s2] = f2bf(stab[m] * rs);
    }
    __syncthreads();
  }
}

DI void ph_mod_reduce(const Params& p) {
  const int gtid = obid() * 256 + otid(), gsz = gridDim.x * 256;
  const float* adap = (const float*)(p.wsp() + OFF_ADAP); float* mod = (float*)(p.wsp() + OFF_MOD);
  for (int e = gtid; e < 2 * 3 * 6144; e += gsz) {
    int n = e % 6144, l = e / (3 * 6144);
    float s = p.inp(I_BADA)[l * 6144 + n];
    for (int kc = 0; kc < NKC; ++kc) s += gptr(adap)[(size_t)kc * 2 * 3 * 6144 + e];
    mod[e] = s;
  }
}

DI void ph_norm_mod(const Params& p, int l, const float* gnorm, int sh_off, int sc_off, bool from_input = false) {
  const int tid_ = otid(); const int lane = tid_ & 63, w = tid_ >> 6;
  const float* x = (const float*)(p.wsp() + OFF_X); bf16_t* hb = (bf16_t*)(p.wsp() + OFF_H);
  const float* mod = (const float*)(p.wsp() + OFF_MOD) + (size_t)l * 3 * 6144;
  for (int tok = obid() * 4 + w; tok < NTOK; tok += gridDim.x * 4) {
    const float* xr = from_input ? (tok < 4096 ? p.inp(I_XP) + (size_t)tok * DM : p.inp(I_XS) + (size_t)(tok - 4096) * DM) : x + (size_t)tok * DM;
    float4 v[4]; float ss = 0.f;
#pragma unroll
    for (int i = 0; i < 4; ++i) { v[i] = ldg4(xr + i * 256 + lane * 4); ss += v[i].x * v[i].x + v[i].y * v[i].y + v[i].z * v[i].z + v[i].w * v[i].w; }
    ss = wave_sum(ss);
    float rstd = rsqrtf(ss * (1.f / 1024.f) + EPSF);
    const float* mm = mod + cv_of_tok(tok) * 6144;
#pragma unroll
    for (int i = 0; i < 4; ++i) {
      int col = i * 256 + lane * 4;
      float4 g = ldg4(gnorm + col); float4 sc = ldg4(mm + sc_off + col); float4 sh = ldg4(mm + sh_off + col);
      ushort4 o;
      o.x = f2bf(v[i].x * rstd * g.x * (1.f + sc.x) + sh.x);
      o.y = f2bf(v[i].y * rstd * g.y * (1.f + sc.y) + sh.y);
      o.z = f2bf(v[i].z * rstd * g.z * (1.f + sc.z) + sh.z);
      o.w = f2bf(v[i].w * rstd * g.w * (1.f + sc.w) + sh.w);
      stg_us4(hb + (size_t)tok * DM + col, o);
    }
  }
}

DI void ph_final_norm(const Params& p) {
  const int tid_ = otid(); const int lane = tid_ & 63, w = tid_ >> 6;
  const float* x = (const float*)(p.wsp() + OFF_X);
  const float* g = p.inp(I_FING);
  for (int tok = obid() * 4 + w; tok < NTOK; tok += gridDim.x * 4) {
    const float* xr = x + (size_t)tok * DM;
    float4 v[4]; float ss = 0.f;
#pragma unroll
    for (int i = 0; i < 4; ++i) { v[i] = ldg4(xr + i * 256 + lane * 4); ss += v[i].x * v[i].x + v[i].y * v[i].y + v[i].z * v[i].z + v[i].w * v[i].w; }
    ss = wave_sum(ss);
    float rstd = rsqrtf(ss * (1.f / 1024.f) + EPSF);
#pragma unroll
    for (int i = 0; i < 4; ++i) {
      int col = i * 256 + lane * 4; float4 gg = ldg4(g + col);
      float4 o; o.x = v[i].x * rstd * gg.x; o.y = v[i].y * rstd * gg.y; o.z = v[i].z * rstd * gg.z; o.w = v[i].w * rstd * gg.w;
      stg4(p.outp() + (size_t)tok * DM + col, o);
    }
  }
}

DI void ph_gemm_in(const Params& p, char* smem) {
  const bf16_t* A = (const bf16_t*)(p.wsp() + OFF_H); const bf16_t* Bt = (const bf16_t*)(p.wsp() + OFF_WIN);
  int mt, nt;
  for (int k = 0; xcd_tile(k, 64, 20, mt, nt); ++k) {
    EpiG1 epi{(float*)(p.wsp() + OFF_PROJ), (bf16_t*)(p.wsp() + OFF_UVT), mt * 128, nt * 128};
    gemm_tile64_pf2(A + (size_t)mt * 128 * 1024, 1024, Bt + (size_t)nt * 128 * 1024, 1024, 1024, smem, epi);
  }
}
DI void ph_gemm_out(const Params& p, int l, char* smem) {
  int mt, nt;
  for (int k = 0; xcd_tile(k, 64, 8, mt, nt); ++k) {
    EpiResid epi{(float*)(p.wsp() + OFF_X), (const float*)(p.wsp() + OFF_MOD) + (size_t)l * 3 * 6144 + 2048, mt * 128, nt * 128, l == 0 ? p.inp(I_XP) : nullptr, l == 0 ? p.inp(I_XS) : nullptr};
    gemm_tile64_pf2((const bf16_t*)(p.wsp() + OFF_H) + (size_t)mt * 128 * 1024, 1024, (const bf16_t*)(p.wsp() + OFF_WOUT) + (size_t)nt * 128 * 1024, 1024, 1024, smem, epi);
  }
}
DI void ph_gemm_up(const Params& p, int l, char* smem) {
  int mt, nt;
  for (int k = 0; xcd_tile(k, 32, 44, mt, nt); ++k) {
    EpiConvGate epi{(bf16_t*)(p.wsp() + OFF_ACT), p.inp(I_CONVW) + (size_t)l * 3 * DUP, p.inp(I_CONVB) + (size_t)l * DUP, mt * 256, nt, mt < 16};
    gemm_tile64<256, 128, EpiConvGate, true>((const bf16_t*)(p.wsp() + OFF_H) + (size_t)mt * 256 * 1024, 1024, (const bf16_t*)(p.wsp() + OFF_WUP) + (size_t)nt * 128 * 1024, 1024, 1024, smem, epi);
  }
}
DI void ph_gemm_down(const Params& p, int l, char* smem) {
  int mt, nt;
  for (int k = 0; xcd_tile(k, 64, 8, mt, nt); ++k) {
    EpiResid epi{(float*)(p.wsp() + OFF_X), (const float*)(p.wsp() + OFF_MOD) + (size_t)l * 3 * 6144 + 5120, mt * 128, nt * 128, nullptr, nullptr};
    gemm_tile64_pf2((const bf16_t*)(p.wsp() + OFF_ACT) + (size_t)mt * 128 * DFF, DFF, (const bf16_t*)(p.wsp() + OFF_WDN) + (size_t)nt * 128 * DFF, DFF, DFF, smem, epi);
  }
}

DI void ph_scans(const Params& p, int l) {
  const int gtid = obid() * 256 + otid(), gsz = gridDim.x * 256;
  {
    float* hgs = (float*)(p.wsp() + OFF_HGS); const float* hgg = (const float*)(p.wsp() + OFF_HGG);
    for (int e = gtid; e < 18 * 2 * 4 * 4096; e += gsz) {
      int k = e & 63, v = (e >> 6) & 63, hd = (e >> 12) & 3, d = (e >> 14) & 1, seq = e >> 15;
      int start, T; seq_info(seq, start, T);
      int nc = T >> 5, cb = start >> 5;
      float S = 0.f;
      if (seq >= 16) S = p.inp(I_HGST)[((((size_t)(seq - 16) * 2 + l) * 2 + d) * 4 + hd) * 4096 + k * 64 + v];
      for (int s0 = 0; s0 < nc; s0 += 8) {
        float tv[8], gv[8];
#pragma unroll
        for (int u = 0; u < 8; ++u) {
          int s = s0 + u; int cc = d ? nc - 1 - s : s; size_t idx = (size_t)((cb + cc) * 2 + d) * 4 + hd;
          tv[u] = gptr(hgs)[idx * 4096 + v * 64 + k]; gv[u] = gptr(hgg)[idx * 64 + k];
        }
#pragma unroll
        for (int u = 0; u < 8; ++u) {
          int s = s0 + u; int cc = d ? nc - 1 - s : s; size_t idx = (size_t)((cb + cc) * 2 + d) * 4 + hd;
          gptr(hgs)[idx * 4096 + v * 64 + k] = S;
          S = gv[u] * S + tv[u];
        }
      }
      if (seq < 16) p.outp()[OUT_HG + ((((size_t)seq * 2 + l) * 2 + d) * 4 + hd) * 4096 + k * 64 + v] = S;
    }
  }
  {
    const float* s5e = (const float*)(p.wsp() + OFF_S5E); float* s5h = (float*)(p.wsp() + OFF_S5H);
    const float* s5al = (const float*)(p.wsp() + OFF_S5AL);
    for (int e = gtid; e < 18 * 2 * 16 * 64; e += gsz) {
      int n = e & 63, g = (e >> 6) & 15, d = (e >> 10) & 1, seq = e >> 11;
      int start, T; seq_info(seq, start, T);
      int nc = T >> 5, cb = start >> 5;
      int pidx = ((l * 2 + d) * 16 + g) * 64 + n;
      float ar = s5al[pidx * 2], ai = s5al[pidx * 2 + 1];
      float hr = 0.f, hi = 0.f;
      if (seq >= 16) {
        size_t si = ((((size_t)(seq - 16) * 2 + l) * 2 + d) * 16 + g) * 64 + n;
        hr = p.inp(I_S5RE)[si]; hi = p.inp(I_S5IM)[si];
      }
      for (int s0 = 0; s0 < nc; s0 += 8) {
        float er[8], ei[8];
#pragma unroll
        for (int u = 0; u < 8; ++u) {
          int s = s0 + u; int cc = d ? nc - 1 - s : s; size_t idx = ((size_t)(((cb + cc) * 2 + d) * 16 + g) * 64 + n) * 2;
          er[u] = gptr(s5e)[idx]; ei[u] = gptr(s5e)[idx + 1];
        }
#pragma unroll
        for (int u = 0; u < 8; ++u) {
          int s = s0 + u; int cc = d ? nc - 1 - s : s; size_t idx = ((size_t)(((cb + cc) * 2 + d) * 16 + g) * 64 + n) * 2;
          gptr(s5h)[idx] = hr; gptr(s5h)[idx + 1] = hi;
          float nr = ar * hr - ai * hi + er[u], ni = ar * hi + ai * hr + ei[u];
          hr = nr; hi = ni;
        }
      }
      if (seq < 16) {
        size_t oi = ((((size_t)seq * 2 + l) * 2 + d) * 16 + g) * 64 + n;
        p.outp()[OUT_S5RE + oi] = hr; p.outp()[OUT_S5IM + oi] = hi;
      }
    }
  }
}

constexpr int HS5 = 136;
DI void s5_stage_u(const float* up, int lane, float* ub) {
  const float* src = up + (size_t)(lane >> 1) * PLD + (lane & 1) * 8;
  f32x4 a = *gptr((const f32x4*)src), b = *gptr((const f32x4*)(src + 4));
  *(f32x4*)(ub + lane * 8) = a; *(f32x4*)(ub + lane * 8 + 4) = b;
}
template <bool WRITE_H>
DI void s5_scan(const float* ub, float are, float aim, const float (&br)[16], const float (&bi)[16], int d, int lane, float& hr, float& hi, bf16_t* HB) {
#pragma unroll 4
  for (int s = 0; s < 32; ++s) {
    const int j = d ? 31 - s : s;
    const float4* u4 = (const float4*)(ub + j * 16);
    float4 u0 = u4[0], u1 = u4[1], u2 = u4[2], u3 = u4[3];
    float ur0 = br[0] * u0.x, ur1 = br[4] * u1.x, ur2 = br[8] * u2.x, ur3 = br[12] * u3.x;
    float ui0 = bi[0] * u0.x, ui1 = bi[4] * u1.x, ui2 = bi[8] * u2.x, ui3 = bi[12] * u3.x;
    ur0 += br[1] * u0.y; ur1 += br[5] * u1.y; ur2 += br[9] * u2.y; ur3 += br[13] * u3.y;
    ui0 += bi[1] * u0.y; ui1 += bi[5] * u1.y; ui2 += bi[9] * u2.y; ui3 += bi[13] * u3.y;
    ur0 += br[2] * u0.z; ur1 += br[6] * u1.z; ur2 += br[10] * u2.z; ur3 += br[14] * u3.z;
    ui0 += bi[2] * u0.z; ui1 += bi[6] * u1.z; ui2 += bi[10] * u2.z; ui3 += bi[14] * u3.z;
    ur0 += br[3] * u0.w; ur1 += br[7] * u1.w; ur2 += br[11] * u2.w; ur3 += br[15] * u3.w;
    ui0 += bi[3] * u0.w; ui1 += bi[7] * u1.w; ui2 += bi[11] * u2.w; ui3 += bi[15] * u3.w;
    float ur = (ur0 + ur1) + (ur2 + ur3), ui = (ui0 + ui1) + (ui2 + ui3);
    float nr = are * hr - aim * hi + ur, ni = are * hi + aim * hr + ui;
    hr = nr; hi = ni;
    if (WRITE_H) *(unsigned*)(HB + j * HS5 + lane * 2) = pack_bf2(hr, hi);
  }
}

DI void ph_s5_local(const Params& p, int l, char* smem) {
  const int tid = otid(), lane = tid & 63, w = tid >> 6;
  float* ub = (float*)(smem + w * 11264);
  bf16_t* HB = (bf16_t*)(smem + w * 11264 + 2048);
  const float* proj = (const float*)(p.wsp() + OFF_PROJ);
  const float* s5a = (const float*)(p.wsp() + OFF_S5A); const float* bbr = (const float*)(p.wsp() + OFF_S5BBR); const float* bbi = (const float*)(p.wsp() + OFF_S5BBI);
  float* s5e = (float*)(p.wsp() + OFF_S5E);
  float* yloc = (float*)(p.wsp() + OFF_YLOC);
  const bf16_t* cmt = (const bf16_t*)(p.wsp() + OFF_CMT);
  const int row16 = lane & 15, quad = lane >> 4;
  for (int wi = obid() * 4 + w; wi < 8192; wi += gridDim.x * 4) {
    int g = wi & 15, d = (wi >> 4) & 1, c = wi >> 5;
    int pidx = ((l * 2 + d) * 16 + g) * 64 + lane;
    float hr = 0.f, hi = 0.f;
    const float are = gptr(s5a)[pidx * 2], aim = gptr(s5a)[pidx * 2 + 1];
    float br[16], bi[16];
#pragma unroll
    for (int q = 0; q < 4; ++q) {
      f32x4 t = *gptr((const f32x4*)(bbr + (size_t)pidx * 16 + q * 4)); br[q * 4] = t[0]; br[q * 4 + 1] = t[1]; br[q * 4 + 2] = t[2]; br[q * 4 + 3] = t[3];
      f32x4 u = *gptr((const f32x4*)(bbi + (size_t)pidx * 16 + q * 4)); bi[q * 4] = u[0]; bi[q * 4 + 1] = u[1]; bi[q * 4 + 2] = u[2]; bi[q * 4 + 3] = u[3];
    }
    const bf16_t* cb = cmt + ((size_t)(((l * 2 + d) * 16 + g) * 16 + row16)) * 128 + quad * 8;
    bf16x8 bbv[4];
#pragma unroll
    for (int ks = 0; ks < 4; ++ks) bbv[ks] = *gptr((const bf16x8*)(cb + ks * 32));
    LDS_FENCE();
    s5_stage_u(proj + (size_t)(c * 32) * PLD + PC_XA + g * 16, lane, ub);
    LDS_FENCE();
    s5_scan<true>(ub, are, aim, br, bi, d, lane, hr, hi, HB);
    size_t eo = ((size_t)((c * 2 + d) * 16 + g) * 64 + lane) * 2;
    gptr(s5e)[eo] = hr; gptr(s5e)[eo + 1] = hi;
    LDS_FENCE();
    f32x4 yacc[2];
#pragma unroll
    for (int mt = 0; mt < 2; ++mt) { yacc[mt][0] = 0.f; yacc[mt][1] = 0.f; yacc[mt][2] = 0.f; yacc[mt][3] = 0.f; }
#pragma unroll
    for (int ks = 0; ks < 4; ++ks) {
#pragma unroll
      for (int mt = 0; mt < 2; ++mt) {
        bf16x8 a = *(const bf16x8*)(HB + (mt * 16 + row16) * HS5 + ks * 32 + quad * 8);
        yacc[mt] = __builtin_amdgcn_mfma_f32_16x16x32_bf16(a, bbv[ks], yacc[mt], 0, 0, 0);
      }
    }
#pragma unroll
    for (int mt = 0; mt < 2; ++mt)
#pragma unroll
      for (int i = 0; i < 4; ++i)
        gptr(yloc)[((size_t)d * NTOK + c * 32 + mt * 16 + quad * 4 + i) * 256 + g * 16 + row16] = yacc[mt][i];
  }
}

DI void s5_out_task(const Params& p, int l, int c, char* smem) {
  const int tid = otid(), lane = tid & 63, w = tid >> 6;
  bf16_t* HB = (bf16_t*)(smem + w * 8704);
  bf16_t* Y5 = (bf16_t*)(smem + 4 * 8704);
  float* red = (float*)(smem + 4 * 8704 + 32 * 264 * 2);
  const float* proj = (const float*)(p.wsp() + OFF_PROJ);
  const float* s5a = (const float*)(p.wsp() + OFF_S5A);
  const float* s5h = (const float*)(p.wsp() + OFF_S5H);
  const bf16_t* cmt = (const bf16_t*)(p.wsp() + OFF_CMT);
  const float* yloc = (const float*)(p.wsp() + OFF_YLOC);
  const int row16 = lane & 15, quad = lane >> 4;
  float are[8], aim[8], hr0[8], hi0[8];
#pragma unroll
  for (int q = 0; q < 8; ++q) {
    const int g = w * 4 + (q >> 1), d = q & 1;
    const int pidx = ((l * 2 + d) * 16 + g) * 64 + lane;
    const size_t ho = ((size_t)((c * 2 + d) * 16 + g) * 64 + lane) * 2;
    are[q] = gptr(s5a)[pidx * 2]; aim[q] = gptr(s5a)[pidx * 2 + 1];
    hr0[q] = gptr(s5h)[ho]; hi0[q] = gptr(s5h)[ho + 1];
  }
#pragma unroll
  for (int gq = 0; gq < 4; ++gq) {
    const int g = w * 4 + gq;
    float yl[8], xav[8];
#pragma unroll
    for (int mt = 0; mt < 2; ++mt)
#pragma unroll
      for (int i = 0; i < 4; ++i) {
        const int tl = mt * 16 + quad * 4 + i;
        const size_t yo = (size_t)(c * 32 + tl) * 256 + g * 16 + row16;
        yl[mt * 4 + i] = gptr(yloc)[yo] + gptr(yloc)[(size_t)NTOK * 256 + yo];
        xav[mt * 4 + i] = gptr(proj)[(size_t)(c * 32 + tl) * PLD + PC_XA + g * 16 + row16];
      }
    const float dsk = gptr(p.inp(I_S5D))[l * 256 + g * 16 + row16];
    f32x4 yacc[2];
#pragma unroll
    for (int mt = 0; mt < 2; ++mt) { yacc[mt][0] = 0.f; yacc[mt][1] = 0.f; yacc[mt][2] = 0.f; yacc[mt][3] = 0.f; }
#pragma unroll
    for (int d = 0; d < 2; ++d) {
      const bf16_t* cb = cmt + ((size_t)(((l * 2 + d) * 16 + g) * 16 + row16)) * 128 + quad * 8;
      bf16x8 bb[4];
#pragma unroll
      for (int ks = 0; ks < 4; ++ks) bb[ks] = *gptr((const bf16x8*)(cb + ks * 32));
      const float ar = are[gq * 2 + d], ai = aim[gq * 2 + d];
      float pr = hr0[gq * 2 + d], pi = hi0[gq * 2 + d];
      LDS_FENCE();
#pragma unroll 8
      for (int sft = 0; sft < 32; ++sft) {
        const int j = d ? 31 - sft : sft;
        float nr = ar * pr - ai * pi, ni = ar * pi + ai * pr;
        pr = nr; pi = ni;
        *(unsigned*)(HB + j * HS5 + lane * 2) = pack_bf2(pr, pi);
      }
      LDS_FENCE();
#pragma unroll
      for (int ks = 0; ks < 4; ++ks) {
#pragma unroll
        for (int mt = 0; mt < 2; ++mt) {
          bf16x8 a = *(const bf16x8*)(HB + (mt * 16 + row16) * HS5 + ks * 32 + quad * 8);
          yacc[mt] = __builtin_amdgcn_mfma_f32_16x16x32_bf16(a, bb[ks], yacc[mt], 0, 0, 0);
        }
      }
    }
    LDS_FENCE();
#pragma unroll
    for (int mt = 0; mt < 2; ++mt)
#pragma unroll
      for (int i = 0; i < 4; ++i) {
        int tl = mt * 16 + quad * 4 + i;
        float y = gelu_t(yacc[mt][i] + yl[mt * 4 + i] + dsk * xav[mt * 4 + i]);
        Y5[tl * 264 + g * 16 + row16] = f2bf(y);
      }
  }
  __syncthreads();
  const int r = lane & 31, h = lane >> 5;
  f32x16 acc[2];
#pragma unroll
  for (int nt = 0; nt < 2; ++nt)
#pragma unroll
    for (int i = 0; i < 16; ++i) acc[nt][i] = 0.f;
  const bf16_t* wg = (const bf16_t*)(p.wsp() + OFF_WGLU);
#pragma unroll 8
  for (int ks = 0; ks < 16; ++ks) {
    bf16x8 a = *(const bf16x8*)(Y5 + r * 264 + ks * 16 + h * 8);
#pragma unroll
    for (int nt = 0; nt < 2; ++nt) {
      bf16x8 b = *gptr((const bf16x8*)(wg + (size_t)(w * 64 + nt * 32 + r) * 256 + ks * 16 + h * 8));
      acc[nt] = __builtin_amdgcn_mfma_f32_32x32x16_bf16(a, b, acc[nt], 0, 0, 0);
    }
  }
#pragma unroll
  for (int i = 0; i < 16; ++i) {
    int tl = (i & 3) + 8 * (i >> 2) + 4 * h;
    float s = 0.f;
#pragma unroll
    for (int nt = 0; nt < 2; ++nt) { float v = bf2f(Y5[tl * 264 + w * 64 + nt * 32 + r]) * sigm(acc[nt][i]); acc[nt][i] = v; s += v * v; }
#pragma unroll
    for (int o = 16; o > 0; o >>= 1) s += __shfl_xor(s, o, 64);
    if (r == 0) red[w * 32 + tl] = s;
  }
  __syncthreads();
  bf16_t* cat = (bf16_t*)(p.wsp() + OFF_H);
#pragma unroll
  for (int i = 0; i < 16; ++i) {
    int tl = (i & 3) + 8 * (i >> 2) + 4 * h;
    float tot = red[tl] + red[32 + tl] + red[64 + tl] + red[96 + tl];
    float rstd = rsqrtf(tot * (1.f / 256.f) + EPSF);
#pragma unroll
    for (int nt = 0; nt < 2; ++nt) {
      int ch = w * 64 + nt * 32 + r;
      gptr(cat)[(size_t)(c * 32 + tl) * DM + ch] = f2bf(acc[nt][i] * rstd * gptr(p.inp(I_GRPG))[l * 1024 + ch]);
    }
  }
  __syncthreads();
}

DI void hg_gate_vals(float z, float lb, float& lf, float& kv) {
  float e = __expf(-fabsf(z));
  float inv = frcp(1.f + e);
  float sg = (z >= 0.f) ? inv : e * inv;
  float sn = (z >= 0.f) ? e * inv : inv;
  lf = (lb == 0.f) ? (fminf(z, 0.f) - __logf(1.f + e)) : __logf(lb + (1.f - lb) * sg);
  kv = (1.f - lb) * sn;
}
DI float hg_lb(const Params& p, int l, int d, int ch) {
  if (l == 0) return 0.f;
  float x0 = p.inp(I_LBLOG)[(0 * 2 + d) * 256 + ch], x1 = p.inp(I_LBLOG)[(1 * 2 + d) * 256 + ch];
  return 1.f / (1.f + expf(x0 - x1));
}
DI void hg_build_vt(const float* proj, int c, int hd, int lane, bf16_t* Vt) {
#pragma unroll
  for (int j0 = 0; j0 < 32; j0 += 8) {
    float v[8];
#pragma unroll
    for (int q = 0; q < 8; ++q) v[q] = gptr(proj)[(size_t)(c * 32 + j0 + q) * PLD + PC_V + hd * 64 + lane];
    *(bf16x8*)(Vt + lane * 40 + j0) = pack8(v[0], v[1], v[2], v[3], v[4], v[5], v[6], v[7]);
  }
}

DI void ph_hg_local(const Params& p, int l, char* smem) {
  const int tid = otid(), lane = tid & 63, w = tid >> 6, r = lane & 31, h = lane >> 5;
  bf16_t* Vt = (bf16_t*)(smem + w * 11264);
  bf16_t* KhT = Vt + 64 * 40;
  const float* proj = (const float*)(p.wsp() + OFF_PROJ);
  float* hgs = (float*)(p.wsp() + OFF_HGS); float* hgg = (float*)(p.wsp() + OFF_HGG);
  for (int wi = obid() * 4 + w; wi < 2048; wi += gridDim.x * 4) {
    int hd = wi & 3, d = (wi >> 2) & 1, c = wi >> 3;
    hg_build_vt(proj, c, hd, lane, Vt);
    const float lb = hg_lb(p, l, d, hd * 64 + lane);
    float bcs[32], kvs[32];
    float run = 0.f;
#pragma unroll
    for (int s = 0; s < 32; ++s) {
      int j = d ? 31 - s : s;
      float z = gptr(proj)[(size_t)(c * 32 + j) * PLD + PC_ZF + d * 256 + hd * 64 + lane];
      float lf, kv; hg_gate_vals(z, lb, lf, kv);
      run += lf; bcs[s] = run; kvs[s] = kv;
    }
    const float blast = run;
#pragma unroll
    for (int j0 = 0; j0 < 32; j0 += 8) {
      float kh[8];
#pragma unroll
      for (int q = 0; q < 8; ++q) {
        int j = j0 + q;
        float b = d ? bcs[31 - j] : bcs[j];
        float kk = d ? kvs[31 - j] : kvs[j];
        kh[q] = kk * __expf(blast - b);
      }
      *(bf16x8*)(KhT + lane * 40 + j0) = pack8(kh[0], kh[1], kh[2], kh[3], kh[4], kh[5], kh[6], kh[7]);
    }
    hgg[(size_t)wi * 64 + lane] = __expf(blast);
    LDS_FENCE();
    f32x16 acc[2][2];
#pragma unroll
    for (int a = 0; a < 2; ++a)
#pragma unroll
      for (int b = 0; b < 2; ++b)
#pragma unroll
        for (int i = 0; i < 16; ++i) acc[a][b][i] = 0.f;
#pragma unroll
    for (int ks = 0; ks < 2; ++ks) {
      bf16x8 af[2], bf[2];
#pragma unroll
      for (int t = 0; t < 2; ++t) { af[t] = *(const bf16x8*)(Vt + (t * 32 + r) * 40 + ks * 16 + h * 8); bf[t] = *(const bf16x8*)(KhT + (t * 32 + r) * 40 + ks * 16 + h * 8); }
#pragma unroll
      for (int vt = 0; vt < 2; ++vt)
#pragma unroll
        for (int kt = 0; kt < 2; ++kt) acc[vt][kt] = __builtin_amdgcn_mfma_f32_32x32x16_bf16(af[vt], bf[kt], acc[vt][kt], 0, 0, 0);
    }
    float* dst = hgs + (size_t)wi * 4096;
#pragma unroll
    for (int vt = 0; vt < 2; ++vt)
#pragma unroll
      for (int kt = 0; kt < 2; ++kt)
#pragma unroll
        for (int i = 0; i < 16; ++i) gptr(dst)[(vt * 32 + (i & 3) + 8 * (i >> 2) + 4 * h) * 64 + kt * 32 + r] = acc[vt][kt][i];
  }
}

DI void hg_out_task(const Params& p, int l, int c, int hd, char* smem_w) {
  const int tid = otid(), lane = tid & 63, r = lane & 31, h = lane >> 5;
  bf16_t* Qt = (bf16_t*)smem_w;
  bf16_t* Kt = Qt + 32 * 72;
  bf16_t* Vt = Kt + 32 * 72;
  const float* proj = (const float*)(p.wsp() + OFF_PROJ);
  const float* hgs = (const float*)(p.wsp() + OFF_HGS);
  hg_build_vt(proj, c, hd, lane, Vt);
  f32x16 oT[2];
#pragma unroll
  for (int vt = 0; vt < 2; ++vt)
#pragma unroll
    for (int i = 0; i < 16; ++i) oT[vt][i] = 0.f;
#pragma unroll 1
  for (int d = 0; d < 2; ++d) {
    LDS_FENCE();
    const float lb = hg_lb(p, l, d, hd * 64 + lane);
    float run = 0.f;
    float zz[32], qq[32];
#pragma unroll
    for (int s = 0; s < 32; ++s) {
      int j = d ? 31 - s : s;
      zz[s] = gptr(proj)[(size_t)(c * 32 + j) * PLD + PC_ZF + d * 256 + hd * 64 + lane];
      qq[s] = gptr(proj)[(size_t)(c * 32 + j) * PLD + PC_Q + hd * 64 + lane];
    }
#pragma unroll
    for (int s = 0; s < 32; ++s) {
      int j = d ? 31 - s : s;
      float z = zz[s], q = qq[s];
      float lf, kv; hg_gate_vals(z, lb, lf, kv);
      run += lf;
      Qt[j * 72 + lane] = f2bf(q * __expf(run));
      Kt[j * 72 + lane] = f2bf(kv * __expf(-run));
    }
    LDS_FENCE();
    f32x16 sT;
#pragma unroll
    for (int i = 0; i < 16; ++i) sT[i] = 0.f;
    bf16x8 qf[4];
#pragma unroll
    for (int ks = 0; ks < 4; ++ks) {
      bf16x8 a = *(const bf16x8*)(Kt + r * 72 + ks * 16 + h * 8);
      qf[ks] = *(const bf16x8*)(Qt + r * 72 + ks * 16 + h * 8);
      sT = __builtin_amdgcn_mfma_f32_32x32x16_bf16(a, qf[ks], sT, 0, 0, 0);
    }
#pragma unroll
    for (int i = 0; i < 16; ++i) {
      int ii = (i & 3) + 8 * (i >> 2) + 4 * h;
      bool valid = d ? (ii >= r) : (ii <= r);
      sT[i] = valid ? sT[i] : 0.f;
    }
#pragma unroll
    for (int s2 = 0; s2 < 2; ++s2) {
      bf16x8 pb = pack8(sT[8 * s2], sT[8 * s2 + 1], sT[8 * s2 + 2], sT[8 * s2 + 3], sT[8 * s2 + 4], sT[8 * s2 + 5], sT[8 * s2 + 6], sT[8 * s2 + 7]);
#pragma unroll
      for (int vt = 0; vt < 2; ++vt) {
        s16x4 lo = *(const s16x4*)(Vt + (vt * 32 + r) * 40 + 16 * s2 + 4 * h);
        s16x4 hi2 = *(const s16x4*)(Vt + (vt * 32 + r) * 40 + 16 * s2 + 8 + 4 * h);
        bf16x8 av = __builtin_shufflevector(lo, hi2, 0, 1, 2, 3, 4, 5, 6, 7);
        oT[vt] = __builtin_amdgcn_mfma_f32_32x32x16_bf16(av, pb, oT[vt], 0, 0, 0);
      }
    }
    const float* st = hgs + (size_t)((c * 2 + d) * 4 + hd) * 4096;
#pragma unroll
    for (int ks = 0; ks < 4; ++ks) {
#pragma unroll
      for (int vt = 0; vt < 2; ++vt) {
        const GAS f32x4* sp4 = gptr((const f32x4*)(st + (vt * 32 + r) * 64 + ks * 16 + h * 8));
        f32x4 s0 = sp4[0], s1 = sp4[1];
        bf16x8 a = pack8(s0[0], s0[1], s0[2], s0[3], s1[0], s1[1], s1[2], s1[3]);
        oT[vt] = __builtin_amdgcn_mfma_f32_32x32x16_bf16(a, qf[ks], oT[vt], 0, 0, 0);
      }
    }
  }
  float ss = 0.f;
#pragma unroll
  for (int vt = 0; vt < 2; ++vt)
#pragma unroll
    for (int i = 0; i < 16; ++i) ss += oT[vt][i] * oT[vt][i];
  ss += __shfl_xor(ss, 32, 64);
  const float rstd = rsqrtf(ss * (1.f / 64.f) + EPSF);
  const int tok = c * 32 + r;
  bf16_t* cat = (bf16_t*)(p.wsp() + OFF_H);
#pragma unroll
  for (int vt = 0; vt < 2; ++vt)
#pragma unroll
    for (int g4 = 0; g4 < 4; ++g4) {
      int v0 = vt * 32 + 8 * g4 + 4 * h;
      f32x4 gt = *gptr((const f32x4*)(proj + (size_t)tok * PLD + PC_GATE + hd * 64 + v0));
      f32x4 gn = *gptr((const f32x4*)(p.inp(I_GRPG) + l * 1024 + 256 + hd * 64 + v0));
      s16x4 o;
      o[0] = (short)f2bf(oT[vt][4 * g4 + 0] * rstd * gn[0] * silu_f(gt[0]));
      o[1] = (short)f2bf(oT[vt][4 * g4 + 1] * rstd * gn[1] * silu_f(gt[1]));
      o[2] = (short)f2bf(oT[vt][4 * g4 + 2] * rstd * gn[2] * silu_f(gt[2]));
      o[3] = (short)f2bf(oT[vt][4 * g4 + 3] * rstd * gn[3] * silu_f(gt[3]));
      *gptr((s16x4*)(cat + (size_t)tok * DM + 256 + hd * 64 + v0)) = o;
    }
}

DI void ph_mix_out(const Params& p, int l, char* smem) {
  const int b = obid(); const int nb = gridDim.x;
  if (nb >= 2) {
    if ((b & 1) == 0) { for (int c = b >> 1; c < 256; c += (nb + 1) >> 1) s5_out_task(p, l, c, smem); }
    else {
      const int w = otid() >> 6;
      for (int c = b >> 1; c < 256; c += nb >> 1) hg_out_task(p, l, c, w, smem + w * 14336);
    }
  } else {
    for (int c = 0; c < 256; ++c) s5_out_task(p, l, c, smem);
    const int w = otid() >> 6;
    for (int c = 0; c < 256; ++c) hg_out_task(p, l, c, w, smem + w * 14336);
  }
}

DI void gmlp_task(const Params& p, int l, int C, int half, char* smem) {
  const int tid = otid(), lane = tid & 63, w = tid >> 6, r = lane & 31, h = lane >> 5;
  const int hd = w;
  float* rstd = (float*)smem;
  float* part = rstd + 128;
  bf16_t* GvT = (bf16_t*)(smem + 2560 + w * 9216);
  const float* proj = (const float*)(p.wsp() + OFF_PROJ);
  const bf16_t* wsb = (const bf16_t*)(p.wsp() + OFF_WSB) + (size_t)(l * 4 + hd) * 128 * 128;
#pragma unroll 4
  for (int i = 0; i < 8; ++i) {
    int tl = w * 32 + i * 4 + (lane >> 4);
    const float* src = proj + (size_t)(C * 128 + tl) * PLD + PC_GV + (lane & 15) * 16;
    float ss = 0.f;
#pragma unroll
    for (int q = 0; q < 4; ++q) {
      f32x4 v = *gptr((const f32x4*)(src + q * 4));
      float a = gelu_t(v[0]), b = gelu_t(v[1]), cc = gelu_t(v[2]), dd = gelu_t(v[3]);
      ss += a * a + b * b + cc * cc + dd * dd;
    }
#pragma unroll
    for (int o = 8; o > 0; o >>= 1) ss += __shfl_xor(ss, o, 64);
    if ((lane & 15) == 0) rstd[tl] = rsqrtf(ss * (1.f / 256.f) + EPSF);
  }
  __syncthreads();
  const float gmg = p.inp(I_GMNG)[l * 256 + hd * 64 + lane];
  bf16_t* cat = (bf16_t*)(p.wsp() + OFF_H);
  f32x16 acc[2][2];
#pragma unroll
  for (int a = 0; a < 2; ++a)
#pragma unroll
    for (int b = 0; b < 2; ++b)
#pragma unroll
      for (int i = 0; i < 16; ++i) acc[a][b][i] = 0.f;
#pragma unroll 1
  for (int pass = 0; pass < 2; ++pass) {
    LDS_FENCE();
#pragma unroll 4
    for (int j0 = 0; j0 < 64; j0 += 8) {
      float v[8];
#pragma unroll
      for (int q = 0; q < 8; ++q) {
        int j = pass * 64 + j0 + q;
        v[q] = gelu_t(gptr(proj)[(size_t)(C * 128 + j) * PLD + PC_GV + hd * 64 + lane]) * rstd[j] * gmg;
      }
      *(bf16x8*)(GvT + lane * 72 + j0) = pack8(v[0], v[1], v[2], v[3], v[4], v[5], v[6], v[7]);
    }
    LDS_FENCE();
#pragma unroll
    for (int ks = 0; ks < 4; ++ks) {
      bf16x8 af[2];
#pragma unroll
      for (int mt = 0; mt < 2; ++mt) af[mt] = *(const bf16x8*)(GvT + (mt * 32 + r) * 72 + ks * 16 + h * 8);
#pragma unroll
      for (int nt = 0; nt < 2; ++nt) {
        bf16x8 b = *gptr((const bf16x8*)(wsb + (size_t)((half * 2 + nt) * 32 + r) * 128 + pass * 64 + ks * 16 + h * 8));
#pragma unroll
        for (int mt = 0; mt < 2; ++mt) acc[mt][nt] = __builtin_amdgcn_mfma_f32_32x32x16_bf16(af[mt], b, acc[mt][nt], 0, 0, 0);
      }
    }
  }
#pragma unroll
  for (int nt = 0; nt < 2; ++nt) {
    const int ti = (half * 2 + nt) * 32 + r; const int tok = C * 128 + ti;
    const float bsv = p.inp(I_GMBS)[(l * 4 + hd) * 128 + ti];
    float ss = 0.f;
#pragma unroll
    for (int mt = 0; mt < 2; ++mt)
#pragma unroll
      for (int g4 = 0; g4 < 4; ++g4) {
        int d0 = mt * 32 + 8 * g4 + 4 * h;
        f32x4 gu = *gptr((const f32x4*)(proj + (size_t)tok * PLD + PC_GU + hd * 64 + d0));
        float v0 = gelu_t(gu[0]) * (acc[mt][nt][4 * g4 + 0] + bsv);
        float v1 = gelu_t(gu[1]) * (acc[mt][nt][4 * g4 + 1] + bsv);
        float v2 = gelu_t(gu[2]) * (acc[mt][nt][4 * g4 + 2] + bsv);
        float v3 = gelu_t(gu[3]) * (acc[mt][nt][4 * g4 + 3] + bsv);
        acc[mt][nt][4 * g4 + 0] = v0; acc[mt][nt][4 * g4 + 1] = v1; acc[mt][nt][4 * g4 + 2] = v2; acc[mt][nt][4 * g4 + 3] = v3;
        ss += v0 * v0 + v1 * v1 + v2 * v2 + v3 * v3;
      }
    ss += __shfl_xor(ss, 32, 64);
    if (h == 0) part[w * 64 + nt * 32 + r] = ss;
  }
  __syncthreads();
#pragma unroll
  for (int nt = 0; nt < 2; ++nt) {
    const int ti = (half * 2 + nt) * 32 + r; const int tok = C * 128 + ti;
    const int pi = nt * 32 + r;
    float tot = part[pi] + part[64 + pi] + part[128 + pi] + part[192 + pi];
    float rs = rsqrtf(tot * (1.f / 256.f) + EPSF);
#pragma unroll
    for (int mt = 0; mt < 2; ++mt)
#pragma unroll
      for (int g4 = 0; g4 < 4; ++g4) {
        int d0 = mt * 32 + 8 * g4 + 4 * h;
        f32x4 gn = *gptr((const f32x4*)(p.inp(I_GRPG) + l * 1024 + 768 + hd * 64 + d0));
        s16x4 o;
        o[0] = (short)f2bf(acc[mt][nt][4 * g4 + 0] * rs * gn[0]); o[1] = (short)f2bf(acc[mt][nt][4 * g4 + 1] * rs * gn[1]);
        o[2] = (short)f2bf(acc[mt][nt][4 * g4 + 2] * rs * gn[2]); o[3] = (short)f2bf(acc[mt][nt][4 * g4 + 3] * rs * gn[3]);
        *gptr((s16x4*)(cat + (size_t)tok * DM + 768 + hd * 64 + d0)) = o;
      }
  }
  __syncthreads();
}

DI void ph_c_norm(const Params& p, int l) {
  const int tid_ = otid(); const int lane = tid_ & 63, w = tid_ >> 6;
  bf16_t* cat = (bf16_t*)(p.wsp() + OFF_H);
  const float* g0 = (const float*)(p.wsp() + OFF_GCP0); const float* g1 = (const float*)(p.wsp() + OFF_GCP1);
  for (int tok = obid() * 4 + w; tok < NTOK; tok += gridDim.x * 4) {
    float4 v = ldg4(g0 + (size_t)tok * 256 + lane * 4);
    if (tok >= 4096) {
#pragma unroll
      for (int q = 0; q < 3; ++q) {
        float4 u = ldg4(g1 + ((size_t)q * 4096 + (tok - 4096)) * 256 + lane * 4);
        v.x += u.x; v.y += u.y; v.z += u.z; v.w += u.w;
      }
    }
    float ss = wave_sum(v.x * v.x + v.y * v.y + v.z * v.z + v.w * v.w);
    float rstd = rsqrtf(ss * (1.f / 256.f) + EPSF);
    float4 g = ldg4(p.inp(I_GRPG) + l * 1024 + 512 + lane * 4);
    ushort4 o; o.x = f2bf(v.x * rstd * g.x); o.y = f2bf(v.y * rstd * g.y); o.z = f2bf(v.z * rstd * g.z); o.w = f2bf(v.w * rstd * g.w);
    stg_us4(cat + (size_t)tok * DM + 512 + lane * 4, o);
  }
}

DI void ph_local(const Params& p, int l, char* smem) {
  for (int it = obid(); it < 448; it += gridDim.x) {
    if (it < 320) {
      int seq, mt, nt, ks, T, start, klen;
      if (it < 256) { ks = it & 3; nt = (it >> 2) & 1; mt = (it >> 3) & 15; seq = 16 + (it >> 7); klen = 1024; }
      else { int j = it - 256; ks = 0; nt = j & 1; mt = (j >> 1) & 1; seq = j >> 2; klen = 512; }
      seq_info(seq, start, T);
      const bf16_t* A = (const bf16_t*)(p.wsp() + (T == 256 ? OFF_DFTC : OFF_DFTL)) + (size_t)mt * 128 * 2 * T + ks * 1024;
      const bf16_t* Bt = (const bf16_t*)(p.wsp() + OFF_UVT) + (size_t)512 * start + (size_t)nt * 128 * 2 * T + ks * 1024;
      float* dst = (ks == 0) ? (float*)(p.wsp() + OFF_GCP0) + (size_t)(start + mt * 128) * 256 + nt * 128
                             : (float*)(p.wsp() + OFF_GCP1) + ((size_t)(ks - 1) * 4096 + (start - 4096) + mt * 128) * 256 + nt * 128;
      EpiStoreF epi{dst, 256};
      gemm_tile64_pf2(A, 2 * T, Bt, 2 * T, klen, smem, epi);
    } else {
      gmlp_task(p, l, (it - 320) >> 1, (it - 320) & 1, smem);
    }
  }
  ph_hg_local(p, l, smem);
  ph_s5_local(p, l, smem);
}

DI void ph_conv_gate(const Params& p, int l) {
  const int gtid = obid() * 256 + otid(), gsz = gridDim.x * 256;
  const bf16_t* z = (const bf16_t*)(p.wsp() + OFF_Z); bf16_t* act = (bf16_t*)(p.wsp() + OFF_ACT);
  const float* cw = p.inp(I_CONVW) + (size_t)l * 3 * DUP; const float* cb = p.inp(I_CONVB) + (size_t)l * DUP;
  for (int e = gtid; e < NTOK * (DFF / 8); e += gsz) {
    int tok = e / (DFF / 8), j0 = (e % (DFF / 8)) * 8;
    int seg = tok < 4096 ? 256 : 64; int tt = tok & (seg - 1);
    bool hp = tt > 0, hn = tt < seg - 1;
    float res[8];
    float za[2][8];
#pragma unroll
    for (int half = 0; half < 2; ++half) {
      int ch = half * DFF + j0;
      uint4 zc = *(const uint4*)(z + (size_t)tok * DUP + ch);
      uint4 zp = hp ? *(const uint4*)(z + (size_t)(tok - 1) * DUP + ch) : make_uint4(0, 0, 0, 0);
      uint4 zn = hn ? *(const uint4*)(z + (size_t)(tok + 1) * DUP + ch) : make_uint4(0, 0, 0, 0);
      const unsigned* pc = (const unsigned*)&zc; const unsigned* pp = (const unsigned*)&zp; const unsigned* pn = (const unsigned*)&zn;
#pragma unroll
      for (int q = 0; q < 8; ++q) {
        float vc = bf2f((bf16_t)((pc[q >> 1] >> ((q & 1) * 16)) & 0xffff));
        float vp = bf2f((bf16_t)((pp[q >> 1] >> ((q & 1) * 16)) & 0xffff));
        float vn = bf2f((bf16_t)((pn[q >> 1] >> ((q & 1) * 16)) & 0xffff));
        za[half][q] = cb[ch + q] + cw[ch + q] * vp + cw[DUP + ch + q] * vc + cw[2 * DUP + ch + q] * vn;
      }
    }
#pragma unroll
    for (int q = 0; q < 8; ++q) res[q] = gelu_t(za[0][q]) * za[1][q];
    uint4 o;
    o.x = (unsigned)f2bf(res[0]) | ((unsigned)f2bf(res[1]) << 16);
    o.y = (unsigned)f2bf(res[2]) | ((unsigned)f2bf(res[3]) << 16);
    o.z = (unsigned)f2bf(res[4]) | ((unsigned)f2bf(res[5]) << 16);
    o.w = (unsigned)f2bf(res[6]) | ((unsigned)f2bf(res[7]) << 16);
    *(uint4*)(act + (size_t)tok * DFF + j0) = o;
  }
}

#define EXP 0
#define GSYNC() xcd_barrier(xb)
#define XS(n) if (EXP == n) { GSYNC(); }
__global__ void __launch_bounds__(256, 2) mega_kernel(Params pk) {
  __shared__ __attribute__((aligned(16))) char smem[SMEM_BYTES];
  cg::grid_group grid = cg::this_grid();
  __shared__ uint4 xb_words;
  __shared__ Params sp;
  if (threadIdx.x == 0) { xb_words = make_uint4(0u, 0u, 0u, 0u); sp = pk; }
  __syncthreads();
  const Params& p = sp;
  XcdBarrier xb = xcd_barrier_post((unsigned*)(pk.ws + OFF_BAR), (volatile LAS unsigned*)&xb_words);
  if (p.wsp() == nullptr) grid.sync();
  ph_mu(p, smem);
  ph_prep(p, smem);
  GSYNC();
  ph_fold(p, smem);
  ph_mod_reduce(p);
  GSYNC();
  ph_fold_copy(p, 0);
  for (int l = 0; l < 2; ++l) {
    if (l > 0) ph_convert_weights(p, l, smem);
    ph_norm_mod(p, l, p.inp(I_N1G) + l * 1024, 0, 1024, l == 0);
    GSYNC();
    ph_gemm_in(p, smem);
    GSYNC();
    ph_local(p, l, smem);
    if (EXP == 11) ph_local(p, l, smem);
    GSYNC();
    ph_scans(p, l);
    ph_c_norm(p, l);
    GSYNC();
    ph_mix_out(p, l, smem);
    if (EXP == 12) ph_mix_out(p, l, smem);
    GSYNC();
    ph_gemm_out(p, l, smem);
    GSYNC();
    ph_norm_mod(p, l, p.inp(I_N2G) + l * 1024, 3072, 4096);
    GSYNC();
    ph_gemm_up(p, l, smem);
    GSYNC();
    ph_gemm_down(p, l, smem);
    GSYNC();
  }
  ph_final_norm(p);
}

extern "C" void kernel_launch(void* const* d_in, const int* in_sizes, int n_in, void* d_out, int out_size, void* d_ws, size_t ws_size,
                              hipStream_t stream) {
  static int grid_blocks = 0;
  if (!grid_blocks) {
    int dev = 0, cus = 0, per_cu = 0;
    hipGetDevice(&dev);
    hipDeviceGetAttribute(&cus, hipDeviceAttributeMultiprocessorCount, dev);
    hipOccupancyMaxActiveBlocksPerMultiprocessor(&per_cu, mega_kernel, 256, 0);
    if (per_cu > 2) per_cu = 2;
    if (per_cu < 1) per_cu = 1;
    grid_blocks = cus * per_cu;
  }
  if (ws_size < WS_NEEDED) fprintf(stderr, "workspace too small: %zu < %zu\n", ws_size, (size_t)WS_NEEDED);
  Params p{};
  for (int i = 0; i < 33; ++i) p.in[i] = (const float*)d_in[i];
  p.out = (float*)d_out;
  p.ws = (char*)d_ws;
  void* args[] = {&p};
  hipMemsetAsync((char*)d_ws + OFF_BAR, 0, XCD_BAR_WORDS_C * 4, stream);
  hipError_t e = hipLaunchCooperativeKernel((void*)mega_kernel, dim3(grid_blocks), dim3(256), args, 0, stream);
  if (e != hipSuccess) fprintf(stderr, "cooperative launch failed: %s (grid %d)\n", hipGetErrorString(e), grid_blocks);
}
```

```cpp
#include <hip/hip_runtime.h>
#include <hip/hip_cooperative_groups.h>
#include <cstdio>
namespace cg = cooperative_groups;

typedef unsigned short bf16_t;
using bf16x8 = __attribute__((ext_vector_type(8))) short;
using f32x16 = __attribute__((ext_vector_type(16))) float;
using u32x4 = __attribute__((ext_vector_type(4))) unsigned;
using s16x4 = __attribute__((ext_vector_type(4))) short;
using f32x4 = __attribute__((ext_vector_type(4))) float;
#define LDS_FENCE() asm volatile("" ::: "memory")

#define DI __device__ __forceinline__
#define GAS __attribute__((address_space(1)))
template <class T> DI const GAS T* gptr(const T* p) { return (const GAS T*)p; }
template <class T> DI GAS T* gptr(T* p) { return (GAS T*)p; }
DI float4 ldg4(const float* p) { f32x4 v = *gptr((const f32x4*)p); return make_float4(v[0], v[1], v[2], v[3]); }
DI void stg4(float* p, float4 v) { f32x4 t; t[0] = v.x; t[1] = v.y; t[2] = v.z; t[3] = v.w; *gptr((f32x4*)p) = t; }
DI void stg_us4(unsigned short* p, ushort4 v) { s16x4 t; t[0] = (short)v.x; t[1] = (short)v.y; t[2] = (short)v.z; t[3] = (short)v.w; *gptr((s16x4*)p) = t; }

constexpr int NTOK = 8192;
constexpr int DM = 1024;
constexpr int NWIN = 2560;
constexpr int PLD = 2048;
constexpr int DFF = 2816;
constexpr int DUP = 5632;
constexpr float EPSF = 1e-6f;

constexpr int PC_XA = 0, PC_Q = 256, PC_ZF = 512, PC_V = 1024, PC_GATE = 1280, PC_GU = 1536, PC_GV = 1792;

constexpr size_t SZ_WIN = (size_t)NWIN * 1024 * 2;
constexpr size_t SZ_WOUT = (size_t)1024 * 1024 * 2;
constexpr size_t SZ_WUP = (size_t)DUP * 1024 * 2;
constexpr size_t SZ_WDN = (size_t)1024 * DFF * 2;
constexpr size_t SZ_W256 = (size_t)256 * 256 * 2;
constexpr size_t OFF_WIN = 0;
constexpr size_t OFF_WOUT = OFF_WIN + SZ_WIN;
constexpr size_t OFF_WUP = OFF_WOUT + SZ_WOUT;
constexpr size_t OFF_WDN = OFF_WUP + SZ_WUP;
constexpr size_t OFF_WGLU = OFF_WDN + SZ_WDN;
constexpr size_t OFF_DFTL = OFF_WGLU + SZ_W256;
constexpr size_t OFF_DFTC = OFF_DFTL + (size_t)2048 * 4096 * 2;
constexpr int NKC = 16;
constexpr size_t OFF_ADAP = OFF_DFTC + (size_t)256 * 512 * 2;
constexpr size_t OFF_MOD = OFF_ADAP + (size_t)NKC * 2 * 3 * 6144 * 4;
constexpr size_t OFF_S5A = OFF_MOD + (size_t)2 * 3 * 6144 * 4;
constexpr size_t OFF_S5AL = OFF_S5A + 4096 * 2 * 4;
constexpr size_t OFF_S5BBR = OFF_S5AL + 4096 * 2 * 4;
constexpr size_t OFF_S5BBI = OFF_S5BBR + 4096 * 16 * 4;
constexpr size_t OFF_X = OFF_S5BBI + 4096 * 16 * 4;
constexpr size_t OFF_H = OFF_X + (size_t)NTOK * DM * 4;
constexpr size_t OFF_R1 = OFF_H + (size_t)NTOK * DM * 2;
constexpr size_t OFF_PROJ = OFF_R1;
constexpr size_t OFF_UVT = OFF_PROJ + (size_t)NTOK * PLD * 4;
constexpr size_t OFF_YLOC = OFF_UVT + (size_t)NTOK * 512 * 2;
constexpr size_t OFF_Z = OFF_R1;
constexpr size_t SZ_R1 = (size_t)NTOK * DUP * 2;
constexpr size_t OFF_R2 = OFF_R1 + SZ_R1;
constexpr size_t OFF_HGS = OFF_R2;
constexpr size_t OFF_GCP0 = OFF_HGS + (size_t)2048 * 4096 * 4;
constexpr size_t OFF_GCP1 = OFF_GCP0 + (size_t)NTOK * 256 * 4;
constexpr size_t OFF_HGG = OFF_GCP1 + (size_t)3 * 4096 * 256 * 4;
constexpr size_t OFF_S5E = OFF_HGG + (size_t)2048 * 64 * 4;
constexpr size_t OFF_S5H = OFF_S5E + (size_t)256 * 2 * 16 * 64 * 2 * 4;
constexpr size_t OFF_CMT = OFF_S5H + (size_t)256 * 2 * 16 * 64 * 2 * 4;
constexpr size_t OFF_WSB = OFF_CMT + (size_t)2 * 2 * 16 * 16 * 128 * 2;
constexpr size_t OFF_ACT = OFF_R2;
constexpr int XCD_BAR_WORDS_C = 3456;
constexpr size_t OFF_MU = OFF_WSB + (size_t)2 * 4 * 128 * 128 * 2;
constexpr size_t OFF_WFOLD = OFF_MU + (size_t)2 * 2 * 256 * 256 * 4;
constexpr size_t OFF_BAR = OFF_WFOLD + (size_t)2 * 512 * 1024 * 2;
constexpr size_t WS_NEEDED = OFF_BAR + XCD_BAR_WORDS_C * 4;

constexpr size_t OUT_S5RE = (size_t)NTOK * DM;
constexpr size_t OUT_S5IM = OUT_S5RE + 65536;
constexpr size_t OUT_HG = OUT_S5IM + 65536;

constexpr int SMEM_BYTES = 63488;

struct Params {
  const float* in[33];
  float* out;
  char* ws;
  DI char* wsp() const { return *(char* const volatile __attribute__((address_space(3)))*)(&ws); }
  DI const float* inp(int i) const { return *(const float* const __attribute__((address_space(3)))*)(&in[i]); }
  DI float* outp() const { return *(float* const __attribute__((address_space(3)))*)(&out); }
};

enum { I_XP = 0, I_XS, I_S5RE, I_S5IM, I_HGST, I_C, I_CCTX, I_WADA, I_BADA, I_N1G, I_N2G, I_WIN, I_LAMRE, I_LAMIM, I_LOGDT,
       I_BRE, I_BIM, I_CRE, I_CIM, I_S5D, I_WGLU, I_LBLOG, I_FNW, I_GMNG, I_GMWS, I_GMBS, I_GRPG, I_WOUT, I_WUP, I_CONVW,
       I_CONVB, I_WDN, I_FING };

DI bf16_t f2bf(float x) { unsigned u = __float_as_uint(x); u += 0x7fffu + ((u >> 16) & 1u); return (bf16_t)(u >> 16); }
DI float bf2f(bf16_t b) { return __uint_as_float(((unsigned)b) << 16); }
DI float frcp(float x) { return __builtin_amdgcn_rcpf(x); }
DI float gelu_t(float x) { float u2 = 1.5957691216057308f * (x + 0.044715f * x * x * x); return x * frcp(1.f + __expf(-u2)); }
DI float sigm(float x) { return frcp(1.f + __expf(-x)); }
DI float silu_f(float x) { return x * sigm(x); }
DI int otid() { int t = threadIdx.x; asm volatile("" : "+v"(t)); return t; }
DI int obid() { int b = blockIdx.x; asm volatile("" : "+s"(b)); return b; }
DI unsigned pack_bf2(float a, float b) { return (unsigned)f2bf(a) | ((unsigned)f2bf(b) << 16); }
DI bf16x8 pack8(float a0, float a1, float a2, float a3, float a4, float a5, float a6, float a7) {
  u32x4 v; v[0] = pack_bf2(a0, a1); v[1] = pack_bf2(a2, a3); v[2] = pack_bf2(a4, a5); v[3] = pack_bf2(a6, a7);
  return __builtin_bit_cast(bf16x8, v);
}
DI float wave_sum(float v) {
#pragma unroll
  for (int o = 32; o > 0; o >>= 1) v += __shfl_xor(v, o, 64);
  return v;
}
DI void seq_of_tok(int tok, int& start, int& T) {
  if (tok < 4096) { start = tok & ~255; T = 256; } else { start = 4096 + ((tok - 4096) & ~2047); T = 2048; }
}
DI int cv_of_tok(int tok) { return tok < 4096 ? 0 : 1 + ((tok - 4096) >> 11); }
DI void seq_info(int seq, int& start, int& T) {
  if (seq < 16) { start = seq * 256; T = 256; } else { start = 4096 + (seq - 16) * 2048; T = 2048; }
}


#define XB_TMO      128
#define XB_XCNT(j)  (256  + 64 * (j))
#define XB_XSUB(j)  (1280 + 64 * (j))
#define XB_XGEN(j)  (2304 + 64 * (j))
#define XB_TOP      3328
#define XB_TOPGEN   3392
#define XCD_BAR_WORDS 3456
#define XB_SPIN_CAP (1u << 18)
#define LAS __attribute__((address_space(3)))
DI unsigned xb_ld(unsigned* p) { return __hip_atomic_load((GAS unsigned*)p, __ATOMIC_RELAXED, __HIP_MEMORY_SCOPE_AGENT); }
DI unsigned xb_add(unsigned* p, unsigned v) { return __hip_atomic_fetch_add((GAS unsigned*)p, v, __ATOMIC_RELAXED, __HIP_MEMORY_SCOPE_AGENT); }
DI unsigned xb_xcc_id() { return (unsigned)__builtin_amdgcn_s_getreg((3 << 11) | 20) & 0xFu; }
#define XB_SPIN(cond, bar) do { unsigned _sp = 0; while (cond) { __builtin_amdgcn_s_sleep(1); \
    if ((++_sp & 255u) == 0u) { if (xb_ld(&(bar)[XB_TMO])) break; if (_sp > XB_SPIN_CAP) { atomicAdd(&(bar)[XB_TMO], 1u); break; } } } } while (0)
struct XcdBarrier { unsigned* bar; volatile LAS unsigned* st; };
DI XcdBarrier xcd_barrier_post(unsigned* bar, volatile LAS unsigned* st) {
  XcdBarrier b; b.bar = bar; b.st = st;
  if (threadIdx.x == 0) { unsigned x = xb_xcc_id(); st[2] = x; (void)xb_add(&bar[XB_XCNT(x)], 1u); }
  return b;
}
DI void xcd_barrier_complete(unsigned* bar, unsigned x, unsigned& nloc, unsigned& nx) {
  const unsigned G = gridDim.x * gridDim.y * gridDim.z;
  unsigned sum, cnt, mine, sp = 0u;
  for (;;) {
    sum = 0u; cnt = 0u; mine = 0u;
#pragma unroll
    for (unsigned j = 0; j < 16; ++j) { const unsigned c = xb_ld(&bar[XB_XCNT(j)]); sum += c; cnt += (c > 0u) ? 1u : 0u; mine = (j == x) ? c : mine; }
    if (sum == G) break;
    __builtin_amdgcn_s_sleep(1);
    if ((++sp & 255u) == 0u) { if (xb_ld(&bar[XB_TMO])) break; if (sp > XB_SPIN_CAP) { atomicAdd(&bar[XB_TMO], 1u); break; } }
  }
  nloc = mine > 0u ? mine : 1u; nx = cnt > 0u ? cnt : 1u;
}
DI void xcd_barrier(const XcdBarrier& b) {
  asm volatile("s_waitcnt vmcnt(0)" ::: "memory");
  __syncthreads();
  if (threadIdx.x == 0) {
    unsigned* bar = b.bar;
    asm volatile("" : "+s"(bar));
    __builtin_amdgcn_s_waitcnt(0);
    unsigned nloc = b.st[0], nx = b.st[1]; const unsigned bx = b.st[2];
    if (nloc == 0u) { xcd_barrier_complete(bar, bx, nloc, nx); b.st[0] = nloc; b.st[1] = nx; }
    const unsigned old = xb_add(&bar[XB_XSUB(bx)], 1u);
    const unsigned gen = old / nloc;
    if (old + 1u == (gen + 1u) * nloc) {
      __builtin_amdgcn_fence(__ATOMIC_RELEASE, "agent");
      asm volatile("s_waitcnt vmcnt(0)" ::: "memory");
      const unsigned og = xb_add(&bar[XB_TOP], 1u);
      const unsigned tg = og / nx;
      if (og + 1u == (tg + 1u) * nx) xb_add(&bar[XB_TOPGEN], 1u);
      else XB_SPIN(xb_ld(&bar[XB_TOPGEN]) == tg, bar);
      __builtin_amdgcn_fence(__ATOMIC_ACQUIRE, "agent");
      xb_add(&bar[XB_XGEN(bx)], 1u);
      asm volatile("s_waitcnt vmcnt(0)" ::: "memory");
    } else {
      XB_SPIN(xb_ld(&bar[XB_XGEN(bx)]) == gen, bar);
      __builtin_amdgcn_fence(__ATOMIC_ACQUIRE, "agent");
      asm volatile("s_waitcnt vmcnt(0)" ::: "memory");
    }
  }
  __syncthreads();
}

template <int BM, int BN, class Epi>
DI void gemm_tile(const bf16_t* __restrict__ A, int lda, const bf16_t* __restrict__ Bt, int ldb, int K, char* smem, const Epi& epi) {
  constexpr int LS = 40;
  constexpr int MI = BM / 64, NI = BN / 64;
  constexpr int A_CH = BM * 4 / 256, B_CH = BN * 4 / 256;
  bf16_t* sbase = (bf16_t*)smem;
  const int tid = otid(), lane = tid & 63, w = tid >> 6, wm = w >> 1, wn = w & 1, r = lane & 31, h = lane >> 5;
  f32x16 acc[MI][NI];
#pragma unroll
  for (int mi = 0; mi < MI; ++mi)
#pragma unroll
    for (int ni = 0; ni < NI; ++ni)
#pragma unroll
      for (int i = 0; i < 16; ++i) acc[mi][ni][i] = 0.f;
  u32x4 ra[A_CH], rb[B_CH];
  const int KT = K / 32;
#define GLOAD(kt)                                                                                   \
  {                                                                                                 \
    _Pragma("unroll") for (int i = 0; i < A_CH; ++i) {                                              \
      int c = tid + i * 256; int row = c >> 2, kc = c & 3;                                          \
      ra[i] = *(const u32x4*)(A + (size_t)row * lda + (kt) * 32 + kc * 8);                          \
    }                                                                                               \
    _Pragma("unroll") for (int i = 0; i < B_CH; ++i) {                                              \
      int c = tid + i * 256; int row = c >> 2, kc = c & 3;                                          \
      rb[i] = *(const u32x4*)(Bt + (size_t)row * ldb + (kt) * 32 + kc * 8);                         \
    }                                                                                               \
  }
#define SSTORE(s)                                                                                   \
  {                                                                                                 \
    bf16_t* sa = sbase + (s) * (BM + BN) * LS; bf16_t* sb = sa + BM * LS;                           \
    _Pragma("unroll") for (int i = 0; i < A_CH; ++i) {                                              \
      int c = tid + i * 256; int row = c >> 2, kc = c & 3;                                          \
      *(u32x4*)(sa + row * LS + kc * 8) = ra[i];                                                    \
    }                                                                                               \
    _Pragma("unroll") for (int i = 0; i < B_CH; ++i) {                                              \
      int c = tid + i * 256; int row = c >> 2, kc = c & 3;                                          \
      *(u32x4*)(sb + row * LS + kc * 8) = rb[i];                                                    \
    }                                                                                               \
  }
  GLOAD(0);
  SSTORE(0);
  __syncthreads();
  for (int kt = 0; kt < KT; ++kt) {
    if (kt + 1 < KT) GLOAD(kt + 1);
    const bf16_t* sa = sbase + (kt & 1) * (BM + BN) * LS;
    const bf16_t* sb = sa + BM * LS;
    const bf16_t* a_s = sa + (wm * (BM / 2) + r) * LS + h * 8;
    const bf16_t* b_s = sb + (wn * (BN / 2) + r) * LS + h * 8;
#pragma unroll
    for (int ks = 0; ks < 2; ++ks) {
      bf16x8 af[MI], bfr[NI];
#pragma unroll
      for (int mi = 0; mi < MI; ++mi) af[mi] = *(const bf16x8*)(a_s + mi * 32 * LS + ks * 16);
#pragma unroll
      for (int ni = 0; ni < NI; ++ni) bfr[ni] = *(const bf16x8*)(b_s + ni * 32 * LS + ks * 16);
#pragma unroll
      for (int mi = 0; mi < MI; ++mi)
#pragma unroll
        for (int ni = 0; ni < NI; ++ni) acc[mi][ni] = __builtin_amdgcn_mfma_f32_32x32x16_bf16(af[mi], bfr[ni], acc[mi][ni], 0, 0, 0);
    }
    if (kt + 1 < KT) SSTORE((kt + 1) & 1);
    __syncthreads();
  }
#undef GLOAD
#undef SSTORE
#pragma unroll
  for (int mi = 0; mi < MI; ++mi)
#pragma unroll
    for (int ni = 0; ni < NI; ++ni) {
#pragma unroll
      for (int i = 0; i < 16; ++i) {
        int rr = wm * (BM / 2) + mi * 32 + (i & 3) + 8 * (i >> 2) + 4 * h;
        int cc = wn * (BN / 2) + ni * 32 + r;
        epi(rr, cc, acc[mi][ni][i]);
        if ((i & 3) == 3) __builtin_amdgcn_sched_barrier(0);
      }
    }
}

template <int BM, int BN, class Epi, bool TILE_EPI = false>
DI void gemm_tile64(const bf16_t* __restrict__ A, int lda, const bf16_t* __restrict__ Bt, int ldb, int K, char* smem, const Epi& epi) {
  constexpr int LS = 72;
  constexpr int MI = BM / 64, NI = BN / 64;
  constexpr int A_CH = BM * 8 / 256, B_CH = BN * 8 / 256;
  bf16_t* sa = (bf16_t*)smem;
  bf16_t* sb = sa + BM * LS;
  const int tid = otid(), lane = tid & 63, w = tid >> 6, wm = w >> 1, wn = w & 1, r = lane & 31, h = lane >> 5;
  f32x16 acc[MI][NI];
#pragma unroll
  for (int mi = 0; mi < MI; ++mi)
#pragma unroll
    for (int ni = 0; ni < NI; ++ni)
#pragma unroll
      for (int i = 0; i < 16; ++i) acc[mi][ni][i] = 0.f;
  u32x4 ra[A_CH], rb[B_CH];
  const int KT = K / 64;
  const bf16_t* ag = A + (size_t)(tid >> 3) * lda + (tid & 7) * 8;
  const bf16_t* bg = Bt + (size_t)(tid >> 3) * ldb + (tid & 7) * 8;
  bf16_t* sa_w = sa + (tid >> 3) * LS + (tid & 7) * 8;
  bf16_t* sb_w = sb + (tid >> 3) * LS + (tid & 7) * 8;
#pragma unroll
  for (int i = 0; i < A_CH; ++i) ra[i] = *gptr((const u32x4*)(ag + (size_t)i * 32 * lda));
#pragma unroll
  for (int i = 0; i < B_CH; ++i) rb[i] = *gptr((const u32x4*)(bg + (size_t)i * 32 * ldb));
  const bf16_t* a_s = sa + (wm * (BM / 2) + r) * LS + h * 8;
  const bf16_t* b_s = sb + (wn * (BN / 2) + r) * LS + h * 8;
#pragma unroll 1
  for (int kt = 0; kt < KT; ++kt) {
    __syncthreads();
#pragma unroll
    for (int i = 0; i < A_CH; ++i) *(u32x4*)(sa_w + i * 32 * LS) = ra[i];
#pragma unroll
    for (int i = 0; i < B_CH; ++i) *(u32x4*)(sb_w + i * 32 * LS) = rb[i];
    __syncthreads();
    if (kt + 1 < KT) {
#pragma unroll
      for (int i = 0; i < A_CH; ++i) ra[i] = *gptr((const u32x4*)(ag + (size_t)i * 32 * lda + (kt + 1) * 64));
#pragma unroll
      for (int i = 0; i < B_CH; ++i) rb[i] = *gptr((const u32x4*)(bg + (size_t)i * 32 * ldb + (kt + 1) * 64));
    }
    {
      bf16x8 af[2][MI], bfr[2][NI];
#define LDFRAG(buf, ks)                                                                               \
      { _Pragma("unroll") for (int mi = 0; mi < MI; ++mi) af[buf][mi] = *(const bf16x8*)(a_s + mi * 32 * LS + (ks) * 16);   \
        _Pragma("unroll") for (int ni = 0; ni < NI; ++ni) bfr[buf][ni] = *(const bf16x8*)(b_s + ni * 32 * LS + (ks) * 16); }
#define DOMFMA(buf)                                                                                   \
      { _Pragma("unroll") for (int mi = 0; mi < MI; ++mi)                                             \
          _Pragma("unroll") for (int ni = 0; ni < NI; ++ni)                                           \
            acc[mi][ni] = __builtin_amdgcn_mfma_f32_32x32x16_bf16(af[buf][mi], bfr[buf][ni], acc[mi][ni], 0, 0, 0); }
      LDFRAG(0, 0); LDFRAG(1, 1);
      __builtin_amdgcn_sched_barrier(0);
      DOMFMA(0);
      __builtin_amdgcn_sched_barrier(0);
      LDFRAG(0, 2);
      __builtin_amdgcn_sched_barrier(0);
      DOMFMA(1);
      __builtin_amdgcn_sched_barrier(0);
      LDFRAG(1, 3);
      __builtin_amdgcn_sched_barrier(0);
      DOMFMA(0);
      __builtin_amdgcn_sched_barrier(0);
      DOMFMA(1);
      __builtin_amdgcn_sched_barrier(0);
#undef LDFRAG
#undef DOMFMA
    }
  }
  if constexpr (TILE_EPI) {
    epi.tile(acc, wm, wn, r, h, smem);
  } else {
#pragma unroll
    for (int mi = 0; mi < MI; ++mi)
#pragma unroll
      for (int ni = 0; ni < NI; ++ni) {
#pragma unroll
        for (int i = 0; i < 16; ++i) {
          int rr = wm * (BM / 2) + mi * 32 + (i & 3) + 8 * (i >> 2) + 4 * h;
          int cc = wn * (BN / 2) + ni * 32 + r;
          epi(rr, cc, acc[mi][ni][i]);
          if ((i & 3) == 3) __builtin_amdgcn_sched_barrier(0);
        }
      }
  }
  __syncthreads();
}

template <class Epi>
DI void gemm_tile64_pf2(const bf16_t* __restrict__ A, int lda, const bf16_t* __restrict__ Bt, int ldb, int K, char* smem, const Epi& epi) {
  constexpr int BM = 128, BN = 128, LS = 72, MI = 2, NI = 2, CH = 4;
  bf16_t* sa = (bf16_t*)smem;
  bf16_t* sb = sa + BM * LS;
  const int tid = otid(), lane = tid & 63, w = tid >> 6, wm = w >> 1, wn = w & 1, r = lane & 31, h = lane >> 5;
  f32x16 acc[MI][NI];
#pragma unroll
  for (int mi = 0; mi < MI; ++mi)
#pragma unroll
    for (int ni = 0; ni < NI; ++ni)
#pragma unroll
      for (int i = 0; i < 16; ++i) acc[mi][ni][i] = 0.f;
  u32x4 ra0[CH], rb0[CH], ra1[CH], rb1[CH];
  const int KT = K / 64;
  const bf16_t* ag = A + (size_t)(tid >> 3) * lda + (tid & 7) * 8;
  const bf16_t* bg = Bt + (size_t)(tid >> 3) * ldb + (tid & 7) * 8;
  bf16_t* sa_w = sa + (tid >> 3) * LS + (tid & 7) * 8;
  bf16_t* sb_w = sb + (tid >> 3) * LS + (tid & 7) * 8;
#pragma unroll
  for (int i = 0; i < CH; ++i) { ra0[i] = *gptr((const u32x4*)(ag + (size_t)i * 32 * lda)); rb0[i] = *gptr((const u32x4*)(bg + (size_t)i * 32 * ldb)); }
#pragma unroll
  for (int i = 0; i < CH; ++i) { ra1[i] = *gptr((const u32x4*)(ag + (size_t)i * 32 * lda + 64)); rb1[i] = *gptr((const u32x4*)(bg + (size_t)i * 32 * ldb + 64)); }
  const bf16_t* a_s = sa + (wm * (BM / 2) + r) * LS + h * 8;
  const bf16_t* b_s = sb + (wn * (BN / 2) + r) * LS + h * 8;
#define PF2_COMPUTE()                                                                                  \
  {                                                                                                    \
    bf16x8 af[4][MI], bfr[4][NI];                                                                      \
    _Pragma("unroll") for (int ks = 0; ks < 4; ++ks) {                                                 \
      _Pragma("unroll") for (int mi = 0; mi < MI; ++mi) af[ks][mi] = *(const bf16x8*)(a_s + mi * 32 * LS + ks * 16);   \
      _Pragma("unroll") for (int ni = 0; ni < NI; ++ni) bfr[ks][ni] = *(const bf16x8*)(b_s + ni * 32 * LS + ks * 16);  \
    }                                                                                                  \
    __builtin_amdgcn_sched_barrier(0);     \
    _Pragma("unroll") for (int ks = 0; ks < 4; ++ks)                                                   \
      _Pragma("unroll") for (int mi = 0; mi < MI; ++mi)                                                \
        _Pragma("unroll") for (int ni = 0; ni < NI; ++ni)                                              \
          acc[mi][ni] = __builtin_amdgcn_mfma_f32_32x32x16_bf16(af[ks][mi], bfr[ks][ni], acc[mi][ni], 0, 0, 0);  \
    __builtin_amdgcn_sched_barrier(0);                                                                 \
  }
#pragma unroll 1
  for (int kt = 0; kt < KT; kt += 2) {
    __syncthreads();
#pragma unroll
    for (int i = 0; i < CH; ++i) { *(u32x4*)(sa_w + i * 32 * LS) = ra0[i]; *(u32x4*)(sb_w + i * 32 * LS) = rb0[i]; }
    __syncthreads();
    if (kt + 2 < KT) {
#pragma unroll
      for (int i = 0; i < CH; ++i) { ra0[i] = *gptr((const u32x4*)(ag + (size_t)i * 32 * lda + (kt + 2) * 64)); rb0[i] = *gptr((const u32x4*)(bg + (size_t)i * 32 * ldb + (kt + 2) * 64)); }
    }
    PF2_COMPUTE();
    __syncthreads();
#pragma unroll
    for (int i = 0; i < CH; ++i) { *(u32x4*)(sa_w + i * 32 * LS) = ra1[i]; *(u32x4*)(sb_w + i * 32 * LS) = rb1[i]; }
    __syncthreads();
    if (kt + 3 < KT) {
#pragma unroll
      for (int i = 0; i < CH; ++i) { ra1[i] = *gptr((const u32x4*)(ag + (size_t)i * 32 * lda + (kt + 3) * 64)); rb1[i] = *gptr((const u32x4*)(bg + (size_t)i * 32 * ldb + (kt + 3) * 64)); }
    }
    PF2_COMPUTE();
  }
#undef PF2_COMPUTE
#pragma unroll
  for (int mi = 0; mi < MI; ++mi)
#pragma unroll
    for (int ni = 0; ni < NI; ++ni) {
#pragma unroll
      for (int i = 0; i < 16; ++i) {
        int rr = wm * (BM / 2) + mi * 32 + (i & 3) + 8 * (i >> 2) + 4 * h;
        int cc = wn * (BN / 2) + ni * 32 + r;
        epi(rr, cc, acc[mi][ni][i]);
        if ((i & 3) == 3) __builtin_amdgcn_sched_barrier(0);
      }
    }
  __syncthreads();
}

DI bool xcd_tile(int k, int MT, int NT, int& mt, int& nt) {
  const int b = obid(), G = gridDim.x;
  if ((G & 7) == 0) {
    int xcd = b & 7, local = b >> 3, per = (MT >> 3) * NT, idx = local + k * (G >> 3);
    if (idx >= per) return false;
    mt = (idx / NT) * 8 + xcd; nt = idx % NT; return true;
  }
  int idx = b + k * G; if (idx >= MT * NT) return false;
  mt = idx / NT; nt = idx % NT; return true;
}

struct EpiG1 {
  float* proj; bf16_t* uvt; int m0, n0;
  DI void operator()(int r, int c, float v) const {
    int tok = m0 + r, n = n0 + c;
    if (n < 1536) gptr(proj)[(size_t)tok * PLD + n] = v;
    else if (n >= 2048) gptr(proj)[(size_t)tok * PLD + n - 512] = v;
    else {
      int cc = n - 1536; int part = cc >> 8, ch = cc & 255; int start, T; seq_of_tok(tok, start, T);
      gptr(uvt)[(size_t)512 * start + (size_t)ch * 2 * T + part * T + (tok - start)] = f2bf(v);
    }
  }
};
struct EpiStoreBf { bf16_t* dst; int ld; DI void operator()(int r, int c, float v) const { dst[(size_t)r * ld + c] = f2bf(v); } };
struct EpiStoreF { float* dst; int ld; DI void operator()(int r, int c, float v) const { gptr(dst)[(size_t)r * ld + c] = v; } };
struct EpiResid {
  float* x; const float* gate; int m0, n0;
  const float* xp; const float* xs;
  DI void operator()(int r, int c, float v) const {
    int tok = m0 + r, col = n0 + c; size_t i = (size_t)tok * DM + col;
    float xin = xp ? (tok < 4096 ? gptr(xp)[i] : gptr(xs)[i - (size_t)4096 * DM]) : gptr(x)[i];
    gptr(x)[i] = xin + gptr(gate)[cv_of_tok(tok) * 6144 + col] * v;
  }
};

struct EpiConvGate {
  bf16_t* act; const float* cw; const float* cb; int m0; int nt; bool ctx;
  DI void tile(f32x16 (&acc)[4][2], int wm, int wn, int r, int h, char* smem) const {
    const int j = nt * 64 + wn * 32 + r;
    float w0[2], w1[2], w2[2], bs[2];
#pragma unroll
    for (int ni = 0; ni < 2; ++ni) {
      int ch = ni * DFF + j;
      w0[ni] = gptr(cw)[ch]; w1[ni] = gptr(cw)[DUP + ch]; w2[ni] = gptr(cw)[2 * DUP + ch]; bs[ni] = gptr(cb)[ch];
    }
    float* edge = (float*)smem;
    __syncthreads();
#pragma unroll
    for (int ni = 0; ni < 2; ++ni) {
      if (h == 0) edge[((((wm * 2 + wn) * 2 + ni) * 2) + 0) * 32 + r] = acc[0][ni][0];
      else        edge[((((wm * 2 + wn) * 2 + ni) * 2) + 1) * 32 + r] = acc[3][ni][15];
    }
    __syncthreads();
    float up_edge[2], dn_edge[2];
#pragma unroll
    for (int ni = 0; ni < 2; ++ni) {
      float ue = edge[((((0 * 2 + wn) * 2 + ni) * 2) + 1) * 32 + r];
      float de = edge[((((1 * 2 + wn) * 2 + ni) * 2) + 0) * 32 + r];
      up_edge[ni] = (ctx && wm == 1) ? ue : 0.f;
      dn_edge[ni] = (ctx && wm == 0) ? de : 0.f;
    }
    float Bp[2][4], Tp[2][4];
#pragma unroll
    for (int ni = 0; ni < 2; ++ni)
#pragma unroll
      for (int mi = 0; mi < 4; ++mi) {
        Bp[ni][mi] = __shfl_xor(acc[mi][ni][15], 32, 64);
        Tp[ni][mi] = __shfl_xor(acc[mi][ni][0], 32, 64);
      }
#pragma unroll
    for (int mi = 0; mi < 4; ++mi) {
      float zc[2][16];
#pragma unroll
      for (int ni = 0; ni < 2; ++ni) {
        float prev_in = (mi == 0) ? up_edge[ni] : ((mi == 2 && !ctx) ? 0.f : Bp[ni][mi > 0 ? mi - 1 : 0]);
        float next_in = (mi == 3) ? dn_edge[ni] : ((mi == 1 && !ctx) ? 0.f : Tp[ni][mi < 3 ? mi + 1 : 3]);
        float rp[4], rn[4];
#pragma unroll
        for (int g = 0; g < 4; ++g) {
          float sp_ = (h == 0) ? acc[mi][ni][4 * g + 3] : acc[mi][ni][g > 0 ? 4 * g - 1 : 0];
          float sn_ = (h == 1) ? acc[mi][ni][4 * g] : acc[mi][ni][g < 3 ? 4 * g + 4 : 15];
          rp[g] = __shfl_xor(sp_, 32, 64);
          rn[g] = __shfl_xor(sn_, 32, 64);
        }
#pragma unroll
        for (int e = 0; e < 16; ++e) {
          const int g = e >> 2;
          float pv, nx;
          if ((e & 3) != 0) pv = acc[mi][ni][e - 1];
          else pv = (h == 1) ? rp[g] : (g > 0 ? rp[g] : prev_in);
          if ((e & 3) != 3) nx = acc[mi][ni][e + 1];
          else nx = (h == 0) ? rn[g] : (g < 3 ? rn[g] : next_in);
          zc[ni][e] = bs[ni] + w0[ni] * pv + w1[ni] * acc[mi][ni][e] + w2[ni] * nx;
        }
      }
#pragma unroll
      for (int e = 0; e < 16; ++e) {
        int row = m0 + wm * 128 + mi * 32 + (e & 3) + 8 * (e >> 2) + 4 * h;
        gptr(act)[(size_t)row * DFF + j] = f2bf(gelu_t(zc[0][e]) * zc[1][e]);
        if ((e & 3) == 3) __builtin_amdgcn_sched_barrier(0);
      }
    }
  }
};

DI void ph_convert_weights(const Params& p, int l, char* smem, bool skip_fold = false) {
  float(*tile)[65] = (float(*)[65])smem;
  float(*t1)[65] = (float(*)[65])(smem + 64 * 65 * 4);
  float(*t2)[65] = (float(*)[65])(smem + 2 * 64 * 65 * 4);
  float* tw = (float*)(smem + 3 * 64 * 65 * 4);
  const int tid = otid();
  constexpr int N_IT = 640 + 256 + 1408 + 704 + 16;
  for (int it = obid(); it < N_IT; it += gridDim.x) {
    const float* src; bf16_t* dst; int K, Nsrc, n0, k0, sc0, fold = -1; bool wup_perm = false;
    int j = it;
    if (j < 640) {
      int nt = j / 16, kt = j % 16; src = p.inp(I_WIN) + (size_t)l * 1024 * 2304; K = 1024; Nsrc = 2304; n0 = nt * 64; k0 = kt * 64;
      dst = (bf16_t*)(p.wsp() + OFF_WIN);
      if (n0 < 1536) sc0 = n0;
      else if (n0 < 2048) { int cc = n0 - 1536; fold = cc >> 8; sc0 = cc & 255; }
      else sc0 = n0 - 256;
    } else if ((j -= 640) < 256) {
      int nt = j / 16, kt = j % 16; src = p.inp(I_WOUT) + (size_t)l * 1024 * 1024; K = 1024; Nsrc = 1024; n0 = nt * 64; k0 = kt * 64; sc0 = n0;
      dst = (bf16_t*)(p.wsp() + OFF_WOUT);
    } else if ((j -= 256) < 1408) {
      int nt = j / 16, kt = j % 16; src = p.inp(I_WUP) + (size_t)l * 1024 * DUP; K = 1024; Nsrc = DUP; n0 = nt * 64; k0 = kt * 64; sc0 = n0;
      dst = (bf16_t*)(p.wsp() + OFF_WUP); wup_perm = true;
    } else if ((j -= 1408) < 704) {
      int nt = j / 44, kt = j % 44; src = p.inp(I_WDN) + (size_t)l * DFF * 1024; K = DFF; Nsrc = 1024; n0 = nt * 64; k0 = kt * 64; sc0 = n0;
      dst = (bf16_t*)(p.wsp() + OFF_WDN);
    } else {
      j -= 704; int nt = j / 4, kt = j % 4; src = p.inp(I_WGLU) + (size_t)l * 65536; K = 256; Nsrc = 256; n0 = nt * 64; k0 = kt * 64; sc0 = n0;
      dst = (bf16_t*)(p.wsp() + OFF_WGLU);
    }
    if (fold < 0) {
#pragma unroll
      for (int i = 0; i < 16; ++i) {
        int kk = (tid >> 6) + 4 * i, nn = tid & 63;
        int sc = sc0 + nn;
        if (wup_perm) sc = ((nn & 32) ? DFF : 0) + (n0 >> 7) * 64 + ((n0 >> 6) & 1) * 32 + (nn & 31);
        tile[kk][nn] = gptr(src)[(size_t)(k0 + kk) * Nsrc + sc];
      }
      __syncthreads();
#pragma unroll
      for (int i = 0; i < 16; ++i) {
        int kk = tid & 63, nn = (tid >> 6) + 4 * i;
        gptr(dst)[(size_t)(n0 + nn) * K + k0 + kk] = f2bf(tile[kk][nn]);
      }
      __syncthreads();
    } else if (!skip_fold) {
      const bf16_t* wf = (const bf16_t*)(p.wsp() + OFF_WFOLD) + (size_t)l * 512 * 1024;
#pragma unroll
      for (int i = 0; i < 16; ++i) {
        int kk = tid & 63, nn = (tid >> 6) + 4 * i;
        gptr(dst)[(size_t)(n0 + nn) * K + k0 + kk] = gptr(wf)[(size_t)(n0 - 1536 + nn) * 1024 + k0 + kk];
      }
      __syncthreads();
    }
  }
}

DI void ph_mu(const Params& p, char* smem) {
  float(*t1)[65] = (float(*)[65])smem;
  float* tw = (float*)(smem + 64 * 65 * 4);
  const int tid = otid();
  float* mu = (float*)(p.wsp() + OFF_MU);
  for (int it = obid(); it < 64; it += gridDim.x) {
    int ct = it & 3, hd = (it >> 2) & 3, part = (it >> 4) & 1, l = it >> 5;
    const float* fnw = p.inp(I_FNW) + (size_t)l * 65536;
    __syncthreads();
    if (tid < 64) tw[tid] = (part == 0) ? cospif((float)tid / 32.f) : sinpif((float)tid / 32.f);
#pragma unroll
    for (int i = 0; i < 16; ++i) { int rr = (tid >> 6) + 4 * i, cc = tid & 63; t1[rr][cc] = gptr(fnw)[(size_t)(hd * 64 + rr) * 256 + ct * 64 + cc]; }
    __syncthreads();
#pragma unroll 1
    for (int i = 0; i < 16; ++i) {
      int jj = (tid >> 6) + 4 * i, cc = tid & 63;
      float sacc = 0.f;
#pragma unroll 8
      for (int kk = 0; kk < 64; ++kk) sacc += tw[(jj * kk) & 63] * t1[kk][cc];
      gptr(mu)[((size_t)(l * 2 + part) * 256 + hd * 64 + jj) * 256 + ct * 64 + cc] = 0.125f * sacc;
    }
  }
  __syncthreads();
}
DI void ph_fold(const Params& p, char* smem) {
  float(*t0)[65] = (float(*)[65])smem;
  float(*t2)[65] = (float(*)[65])(smem + 64 * 65 * 4);
  const int tid = otid();
  const float* mu = (const float*)(p.wsp() + OFF_MU);
  bf16_t* wf = (bf16_t*)(p.wsp() + OFF_WFOLD);
  for (int it = obid(); it < 256; it += gridDim.x) {
    int ct = it & 3, kt = (it >> 2) & 15, part = (it >> 6) & 1, l = it >> 7;
    const float* src = p.inp(I_WIN) + (size_t)l * 1024 * 2304;
    float acc[16];
#pragma unroll
    for (int i = 0; i < 16; ++i) acc[i] = 0.f;
#pragma unroll 1
    for (int hd = 0; hd < 4; ++hd) {
      __syncthreads();
#pragma unroll
      for (int i = 0; i < 16; ++i) {
        int rr = (tid >> 6) + 4 * i, cc = tid & 63;
        t0[rr][cc] = gptr(src)[(size_t)(kt * 64 + rr) * 2304 + 1536 + hd * 64 + cc];
        t2[rr][cc] = gptr(mu)[((size_t)(l * 2 + part) * 256 + hd * 64 + rr) * 256 + ct * 64 + cc];
      }
      __syncthreads();
      const int kk = tid & 63;
#pragma unroll 2
      for (int jj = 0; jj < 64; ++jj) {
        float a = t0[kk][jj];
#pragma unroll
        for (int i = 0; i < 16; ++i) acc[i] += a * t2[jj][(tid >> 6) + 4 * i];
      }
    }
#pragma unroll
    for (int i = 0; i < 16; ++i) {
      int kk = tid & 63, nn = (tid >> 6) + 4 * i;
      gptr(wf)[((size_t)l * 512 + part * 256 + ct * 64 + nn) * 1024 + kt * 64 + kk] = f2bf(acc[i]);
    }
  }
  __syncthreads();
}

DI void ph_fold_copy(const Params& p, int l) {
  const int gtid = obid() * 256 + otid(), gsz = gridDim.x * 256;
  const u32x4* src = (const u32x4*)(p.wsp() + OFF_WFOLD + (size_t)l * 512 * 1024 * 2);
  u32x4* dst = (u32x4*)(p.wsp() + OFF_WIN + (size_t)1536 * 1024 * 2);
  for (int e = gtid; e < 512 * 1024 / 8; e += gsz) dst[e] = src[e];
}

DI void ph_prep(const Params& p, char* smem) {
  const int tid = otid();
  ph_convert_weights(p, 0, smem, true);
  {
    float* sl = (float*)smem;
    float* red = sl + 192;
    float* adap = (float*)(p.wsp() + OFF_ADAP);
    for (int it = obid(); it < 2 * 24 * NKC; it += gridDim.x) {
      int kc = it % NKC, nc = (it / NKC) % 24, l = it / (NKC * 24);
      if (tid < 192) {
        int cv = tid >> 6, kk = tid & 63; int k = kc * 64 + kk;
        float cval = (cv == 0) ? p.inp(I_CCTX)[k] : p.inp(I_C)[(cv - 1) * 1024 + k];
        sl[tid] = silu_f(cval);
      }
      __syncthreads();
      int rg = tid >> 6, lane = tid & 63;
      float a0[4] = {0, 0, 0, 0}, a1[4] = {0, 0, 0, 0}, a2[4] = {0, 0, 0, 0};
      const float* wsrc = p.inp(I_WADA) + (size_t)l * 1024 * 6144 + nc * 256 + lane * 4;
#pragma unroll 4
      for (int i = 0; i < 16; ++i) {
        int kk = rg * 16 + i;
        float4 wv = ldg4(wsrc + (size_t)(kc * 64 + kk) * 6144);
        float s0 = sl[kk], s1 = sl[64 + kk], s2 = sl[128 + kk];
        a0[0] += s0 * wv.x; a0[1] += s0 * wv.y; a0[2] += s0 * wv.z; a0[3] += s0 * wv.w;
        a1[0] += s1 * wv.x; a1[1] += s1 * wv.y; a1[2] += s1 * wv.z; a1[3] += s1 * wv.w;
        a2[0] += s2 * wv.x; a2[1] += s2 * wv.y; a2[2] += s2 * wv.z; a2[3] += s2 * wv.w;
      }
#pragma unroll
      for (int q = 0; q < 4; ++q) {
        red[(rg * 3 + 0) * 256 + lane * 4 + q] = a0[q];
        red[(rg * 3 + 1) * 256 + lane * 4 + q] = a1[q];
        red[(rg * 3 + 2) * 256 + lane * 4 + q] = a2[q];
      }
      __syncthreads();
#pragma unroll
      for (int cv = 0; cv < 3; ++cv) {
        float s = red[(0 * 3 + cv) * 256 + tid] + red[(1 * 3 + cv) * 256 + tid] + red[(2 * 3 + cv) * 256 + tid] + red[(3 * 3 + cv) * 256 + tid];
        adap[((size_t)(kc * 2 + l) * 3 + cv) * 6144 + nc * 256 + tid] = s;
      }
      __syncthreads();
    }
  }
  const int gtid = obid() * 256 + tid, gsz = gridDim.x * 256;
  {
    float* s5a = (float*)(p.wsp() + OFF_S5A); float* s5al = (float*)(p.wsp() + OFF_S5AL);
    float* bbr = (float*)(p.wsp() + OFF_S5BBR); float* bbi = (float*)(p.wsp() + OFF_S5BBI);
    for (int e = gtid; e < 4096 * 16; e += gsz) {
      int idx = e >> 4, pp = e & 15;
      float lr = fminf(p.inp(I_LAMRE)[idx], -1e-4f), li = p.inp(I_LAMIM)[idx];
      float dt = expf(p.inp(I_LOGDT)[idx >> 6]);
      float mag = expf(lr * dt), ang = li * dt;
      float are = mag * cosf(ang), aim = mag * sinf(ang);
      float den = lr * lr + li * li, xr = are - 1.f;
      float zre = (xr * lr + aim * li) / den, zim = (aim * lr - xr * li) / den;
      float br = p.inp(I_BRE)[e], bi = p.inp(I_BIM)[e];
      bbr[e] = zre * br - zim * bi;
      bbi[e] = zre * bi + zim * br;
      if (pp == 0) {
        s5a[idx * 2] = are; s5a[idx * 2 + 1] = aim;
        float pr = are, pi = aim;
#pragma unroll
        for (int q = 0; q < 5; ++q) { float nr = pr * pr - pi * pi, ni = 2.f * pr * pi; pr = nr; pi = ni; }
        s5al[idx * 2] = pr; s5al[idx * 2 + 1] = pi;
      }
    }
  }
  {
    bf16_t* cmt = (bf16_t*)(p.wsp() + OFF_CMT);
    for (int e = gtid; e < 2 * 2 * 16 * 16 * 128; e += gsz) {
      int k = e & 127, row = e >> 7; int n = k >> 1;
      float v = (k & 1) ? -p.inp(I_CIM)[(size_t)row * 64 + n] : p.inp(I_CRE)[(size_t)row * 64 + n];
      cmt[e] = f2bf(v);
    }
    bf16_t* wsb = (bf16_t*)(p.wsp() + OFF_WSB);
    for (int e = gtid; e < 2 * 4 * 128 * 128; e += gsz) wsb[e] = f2bf(p.inp(I_GMWS)[e]);
  }
  {
    float* ctab = (float*)smem; float* stab = ctab + 2048;
    __syncthreads();
    for (int m = tid; m < 2048; m += 256) { float a = (float)m / 1024.f; ctab[m] = cospif(a) * 0.02209708691207961f; stab[m] = -sinpif(a) * 0.02209708691207961f; }
    __syncthreads();
    bf16_t* dl = (bf16_t*)(p.wsp() + OFF_DFTL);
    for (int e = gtid; e < 2048 * 256; e += gsz) {
      int t = e >> 8, s0 = (e & 255) * 8;
      float c[8], sn[8];
#pragma unroll
      for (int q = 0; q < 8; ++q) { int m = (t * (s0 + q)) & 2047; c[q] = ctab[m]; sn[q] = stab[m]; }
      *(bf16x8*)(dl + (size_t)t * 4096 + s0) = pack8(c[0], c[1], c[2], c[3], c[4], c[5], c[6], c[7]);
      *(bf16x8*)(dl + (size_t)t * 4096 + 2048 + s0) = pack8(sn[0], sn[1], sn[2], sn[3], sn[4], sn[5], sn[6], sn[7]);
    }
    bf16_t* dc = (bf16_t*)(p.wsp() + OFF_DFTC);
    const float rs = 0.0625f / 0.02209708691207961f;
    for (int e = gtid; e < 256 * 256; e += gsz) {
      int t = e >> 8, s2 = e & 255; int m = ((t * s2) & 255) * 8;
      dc[t * 512 + s2] = f2bf(ctab[m] * rs);
      dc[t * 512 + 256 + s2] = f2bf(stab[m] * rs);
    }
    __syncthreads();
  }
}

DI void ph_mod_reduce(const Params& p) {
  const int gtid = obid() * 256 + otid(), gsz = gridDim.x * 256;
  const float* adap = (const float*)(p.wsp() + OFF_ADAP); float* mod = (float*)(p.wsp() + OFF_MOD);
  for (int e = gtid; e < 2 * 3 * 6144; e += gsz) {
    int n = e % 6144, l = e / (3 * 6144);
    float s = p.inp(I_BADA)[l * 6144 + n];
    for (int kc = 0; kc < NKC; ++kc) s += gptr(adap)[(size_t)kc * 2 * 3 * 6144 + e];
    mod[e] = s;
  }
}

DI void ph_norm_mod(const Params& p, int l, const float* gnorm, int sh_off, int sc_off, bool from_input = false) {
  const int tid_ = otid(); const int lane = tid_ & 63, w = tid_ >> 6;
  const float* x = (const float*)(p.wsp() + OFF_X); bf16_t* hb = (bf16_t*)(p.wsp() + OFF_H);
  const float* mod = (const float*)(p.wsp() + OFF_MOD) + (size_t)l * 3 * 6144;
  for (int tok = obid() * 4 + w; tok < NTOK; tok += gridDim.x * 4) {
    const float* xr = from_input ? (tok < 4096 ? p.inp(I_XP) + (size_t)tok * DM : p.inp(I_XS) + (size_t)(tok - 4096) * DM) : x + (size_t)tok * DM;
    float4 v[4]; float ss = 0.f;
#pragma unroll
    for (int i = 0; i < 4; ++i) { v[i] = ldg4(xr + i * 256 + lane * 4); ss += v[i].x * v[i].x + v[i].y * v[i].y + v[i].z * v[i].z + v[i].w * v[i].w; }
    ss = wave_sum(ss);
    float rstd = rsqrtf(ss * (1.f / 1024.f) + EPSF);
    const float* mm = mod + cv_of_tok(tok) * 6144;
#pragma unroll
    for (int i = 0; i < 4; ++i) {
      int col = i * 256 + lane * 4;
      float4 g = ldg4(gnorm + col); float4 sc = ldg4(mm + sc_off + col); float4 sh = ldg4(mm + sh_off + col);
      ushort4 o;
      o.x = f2bf(v[i].x * rstd * g.x * (1.f + sc.x) + sh.x);
      o.y = f2bf(v[i].y * rstd * g.y * (1.f + sc.y) + sh.y);
      o.z = f2bf(v[i].z * rstd * g.z * (1.f + sc.z) + sh.z);
      o.w = f2bf(v[i].w * rstd * g.w * (1.f + sc.w) + sh.w);
      stg_us4(hb + (size_t)tok * DM + col, o);
    }
  }
}

DI void ph_final_norm(const Params& p) {
  const int tid_ = otid(); const int lane = tid_ & 63, w = tid_ >> 6;
  const float* x = (const float*)(p.wsp() + OFF_X);
  const float* g = p.inp(I_FING);
  for (int tok = obid() * 4 + w; tok < NTOK; tok += gridDim.x * 4) {
    const float* xr = x + (size_t)tok * DM;
    float4 v[4]; float ss = 0.f;
#pragma unroll
    for (int i = 0; i < 4; ++i) { v[i] = ldg4(xr + i * 256 + lane * 4); ss += v[i].x * v[i].x + v[i].y * v[i].y + v[i].z * v[i].z + v[i].w * v[i].w; }
    ss = wave_sum(ss);
    float rstd = rsqrtf(ss * (1.f / 1024.f) + EPSF);
#pragma unroll
    for (int i = 0; i < 4; ++i) {
      int col = i * 256 + lane * 4; float4 gg = ldg4(g + col);
      float4 o; o.x = v[i].x * rstd * gg.x; o.y = v[i].y * rstd * gg.y; o.z = v[i].z * rstd * gg.z; o.w = v[i].w * rstd * gg.w;
      stg4(p.outp() + (size_t)tok * DM + col, o);
    }
  }
}

DI void ph_gemm_in(const Params& p, char* smem) {
  const bf16_t* A = (const bf16_t*)(p.wsp() + OFF_H); const bf16_t* Bt = (const bf16_t*)(p.wsp() + OFF_WIN);
  int mt, nt;
  for (int k = 0; xcd_tile(k, 64, 20, mt, nt); ++k) {
    EpiG1 epi{(float*)(p.wsp() + OFF_PROJ), (bf16_t*)(p.wsp() + OFF_UVT), mt * 128, nt * 128};
    gemm_tile64_pf2(A + (size_t)mt * 128 * 1024, 1024, Bt + (size_t)nt * 128 * 1024, 1024, 1024, smem, epi);
  }
}
DI void ph_gemm_out(const Params& p, int l, char* smem) {
  int mt, nt;
  for (int k = 0; xcd_tile(k, 64, 8, mt, nt); ++k) {
    EpiResid epi{(float*)(p.wsp() + OFF_X), (const float*)(p.wsp() + OFF_MOD) + (size_t)l * 3 * 6144 + 2048, mt * 128, nt * 128, l == 0 ? p.inp(I_XP) : nullptr, l == 0 ? p.inp(I_XS) : nullptr};
    gemm_tile64_pf2((const bf16_t*)(p.wsp() + OFF_H) + (size_t)mt * 128 * 1024, 1024, (const bf16_t*)(p.wsp() + OFF_WOUT) + (size_t)nt * 128 * 1024, 1024, 1024, smem, epi);
  }
}
DI void ph_gemm_up(const Params& p, int l, char* smem) {
  int mt, nt;
  for (int k = 0; xcd_tile(k, 32, 44, mt, nt); ++k) {
    EpiConvGate epi{(bf16_t*)(p.wsp() + OFF_ACT), p.inp(I_CONVW) + (size_t)l * 3 * DUP, p.inp(I_CONVB) + (size_t)l * DUP, mt * 256, nt, mt < 16};
    gemm_tile64<256, 128, EpiConvGate, true>((const bf16_t*)(p.wsp() + OFF_H) + (size_t)mt * 256 * 1024, 1024, (const bf16_t*)(p.wsp() + OFF_WUP) + (size_t)nt * 128 * 1024, 1024, 1024, smem, epi);
  }
}
DI void ph_gemm_down(const Params& p, int l, char* smem) {
  int mt, nt;
  for (int k = 0; xcd_tile(k, 64, 8, mt, nt); ++k) {
    EpiResid epi{(float*)(p.wsp() + OFF_X), (const float*)(p.wsp() + OFF_MOD) + (size_t)l * 3 * 6144 + 5120, mt * 128, nt * 128, nullptr, nullptr};
    gemm_tile64_pf2((const bf16_t*)(p.wsp() + OFF_ACT) + (size_t)mt * 128 * DFF, DFF, (const bf16_t*)(p.wsp() + OFF_WDN) + (size_t)nt * 128 * DFF, DFF, DFF, smem, epi);
  }
}

DI void ph_scans(const Params& p, int l) {
  const int gtid = obid() * 256 + otid(), gsz = gridDim.x * 256;
  {
    float* hgs = (float*)(p.wsp() + OFF_HGS); const float* hgg = (const float*)(p.wsp() + OFF_HGG);
    for (int e = gtid; e < 18 * 2 * 4 * 4096; e += gsz) {
      int k = e & 63, v = (e >> 6) & 63, hd = (e >> 12) & 3, d = (e >> 14) & 1, seq = e >> 15;
      int start, T; seq_info(seq, start, T);
      int nc = T >> 5, cb = start >> 5;
      float S = 0.f;
      if (seq >= 16) S = p.inp(I_HGST)[((((size_t)(seq - 16) * 2 + l) * 2 + d) * 4 + hd) * 4096 + k * 64 + v];
      for (int s0 = 0; s0 < nc; s0 += 8) {
        float tv[8], gv[8];
#pragma unroll
        for (int u = 0; u < 8; ++u) {
          int s = s0 + u; int cc = d ? nc - 1 - s : s; size_t idx = (size_t)((cb + cc) * 2 + d) * 4 + hd;
          tv[u] = gptr(hgs)[idx * 4096 + v * 64 + k]; gv[u] = gptr(hgg)[idx * 64 + k];
        }
#pragma unroll
        for (int u = 0; u < 8; ++u) {
          int s = s0 + u; int cc = d ? nc - 1 - s : s; size_t idx = (size_t)((cb + cc) * 2 + d) * 4 + hd;
          gptr(hgs)[idx * 4096 + v * 64 + k] = S;
          S = gv[u] * S + tv[u];
        }
      }
      if (seq < 16) p.outp()[OUT_HG + ((((size_t)seq * 2 + l) * 2 + d) * 4 + hd) * 4096 + k * 64 + v] = S;
    }
  }
  {
    const float* s5e = (const float*)(p.wsp() + OFF_S5E); float* s5h = (float*)(p.wsp() + OFF_S5H);
    const float* s5al = (const float*)(p.wsp() + OFF_S5AL);
    for (int e = gtid; e < 18 * 2 * 16 * 64; e += gsz) {
      int n = e & 63, g = (e >> 6) & 15, d = (e >> 10) & 1, seq = e >> 11;
      int start, T; seq_info(seq, start, T);
      int nc = T >> 5, cb = start >> 5;
      int pidx = ((l * 2 + d) * 16 + g) * 64 + n;
      float ar = s5al[pidx * 2], ai = s5al[pidx * 2 + 1];
      float hr = 0.f, hi = 0.f;
      if (seq >= 16) {
        size_t si = ((((size_t)(seq - 16) * 2 + l) * 2 + d) * 16 + g) * 64 + n;
        hr = p.inp(I_S5RE)[si]; hi = p.inp(I_S5IM)[si];
      }
      for (int s0 = 0; s0 < nc; s0 += 8) {
        float er[8], ei[8];
#pragma unroll
        for (int u = 0; u < 8; ++u) {
          int s = s0 + u; int cc = d ? nc - 1 - s : s; size_t idx = ((size_t)(((cb + cc) * 2 + d) * 16 + g) * 64 + n) * 2;
          er[u] = gptr(s5e)[idx]; ei[u] = gptr(s5e)[idx + 1];
        }
#pragma unroll
        for (int u = 0; u < 8; ++u) {
          int s = s0 + u; int cc = d ? nc - 1 - s : s; size_t idx = ((size_t)(((cb + cc) * 2 + d) * 16 + g) * 64 + n) * 2;
          gptr(s5h)[idx] = hr; gptr(s5h)[idx + 1] = hi;
          float nr = ar * hr - ai * hi + er[u], ni = ar * hi + ai * hr + ei[u];
          hr = nr; hi = ni;
        }
      }
      if (seq < 16) {
        size_t oi = ((((size_t)seq * 2 + l) * 2 + d) * 16 + g) * 64 + n;
        p.outp()[OUT_S5RE + oi] = hr; p.outp()[OUT_S5IM + oi] = hi;
      }
    }
  }
}

constexpr int HS5 = 136;
DI void s5_stage_u(const float* up, int lane, float* ub) {
  const float* src = up + (size_t)(lane >> 1) * PLD + (lane & 1) * 8;
  f32x4 a = *gptr((const f32x4*)src), b = *gptr((const f32x4*)(src + 4));
  *(f32x4*)(ub + lane * 8) = a; *(f32x4*)(ub + lane * 8 + 4) = b;
}
template <bool WRITE_H>
DI void s5_scan(const float* ub, float are, float aim, const float (&br)[16], const float (&bi)[16], int d, int lane, float& hr, float& hi, bf16_t* HB) {
#pragma unroll 4
  for (int s = 0; s < 32; ++s) {
    const int j = d ? 31 - s : s;
    const float4* u4 = (const float4*)(ub + j * 16);
    float4 u0 = u4[0], u1 = u4[1], u2 = u4[2], u3 = u4[3];
    float ur0 = br[0] * u0.x, ur1 = br[4] * u1.x, ur2 = br[8] * u2.x, ur3 = br[12] * u3.x;
    float ui0 = bi[0] * u0.x, ui1 = bi[4] * u1.x, ui2 = bi[8] * u2.x, ui3 = bi[12] * u3.x;
    ur0 += br[1] * u0.y; ur1 += br[5] * u1.y; ur2 += br[9] * u2.y; ur3 += br[13] * u3.y;
    ui0 += bi[1] * u0.y; ui1 += bi[5] * u1.y; ui2 += bi[9] * u2.y; ui3 += bi[13] * u3.y;
    ur0 += br[2] * u0.z; ur1 += br[6] * u1.z; ur2 += br[10] * u2.z; ur3 += br[14] * u3.z;
    ui0 += bi[2] * u0.z; ui1 += bi[6] * u1.z; ui2 += bi[10] * u2.z; ui3 += bi[14] * u3.z;
    ur0 += br[3] * u0.w; ur1 += br[7] * u1.w; ur2 += br[11] * u2.w; ur3 += br[15] * u3.w;
    ui0 += bi[3] * u0.w; ui1 += bi[7] * u1.w; ui2 += bi[11] * u2.w; ui3 += bi[15] * u3.w;
    float ur = (ur0 + ur1) + (ur2 + ur3), ui = (ui0 + ui1) + (ui2 + ui3);
    float nr = are * hr - aim * hi + ur, ni = are * hi + aim * hr + ui;
    hr = nr; hi = ni;
    if (WRITE_H) *(unsigned*)(HB + j * HS5 + lane * 2) = pack_bf2(hr, hi);
  }
}

DI void ph_s5_local(const Params& p, int l, char* smem) {
  const int tid = otid(), lane = tid & 63, w = tid >> 6;
  float* ub = (float*)(smem + w * 11264);
  bf16_t* HB = (bf16_t*)(smem + w * 11264 + 2048);
  const float* proj = (const float*)(p.wsp() + OFF_PROJ);
  const float* s5a = (const float*)(p.wsp() + OFF_S5A); const float* bbr = (const float*)(p.wsp() + OFF_S5BBR); const float* bbi = (const float*)(p.wsp() + OFF_S5BBI);
  float* s5e = (float*)(p.wsp() + OFF_S5E);
  float* yloc = (float*)(p.wsp() + OFF_YLOC);
  const bf16_t* cmt = (const bf16_t*)(p.wsp() + OFF_CMT);
  const int row16 = lane & 15, quad = lane >> 4;
  for (int wi = obid() * 4 + w; wi < 8192; wi += gridDim.x * 4) {
    int g = wi & 15, d = (wi >> 4) & 1, c = wi >> 5;
    int pidx = ((l * 2 + d) * 16 + g) * 64 + lane;
    float hr = 0.f, hi = 0.f;
    const float are = gptr(s5a)[pidx * 2], aim = gptr(s5a)[pidx * 2 + 1];
    float br[16], bi[16];
#pragma unroll
    for (int q = 0; q < 4; ++q) {
      f32x4 t = *gptr((const f32x4*)(bbr + (size_t)pidx * 16 + q * 4)); br[q * 4] = t[0]; br[q * 4 + 1] = t[1]; br[q * 4 + 2] = t[2]; br[q * 4 + 3] = t[3];
      f32x4 u = *gptr((const f32x4*)(bbi + (size_t)pidx * 16 + q * 4)); bi[q * 4] = u[0]; bi[q * 4 + 1] = u[1]; bi[q * 4 + 2] = u[2]; bi[q * 4 + 3] = u[3];
    }
    const bf16_t* cb = cmt + ((size_t)(((l * 2 + d) * 16 + g) * 16 + row16)) * 128 + quad * 8;
    bf16x8 bbv[4];
#pragma unroll
    for (int ks = 0; ks < 4; ++ks) bbv[ks] = *gptr((const bf16x8*)(cb + ks * 32));
    LDS_FENCE();
    s5_stage_u(proj + (size_t)(c * 32) * PLD + PC_XA + g * 16, lane, ub);
    LDS_FENCE();
    s5_scan<true>(ub, are, aim, br, bi, d, lane, hr, hi, HB);
    size_t eo = ((size_t)((c * 2 + d) * 16 + g) * 64 + lane) * 2;
    gptr(s5e)[eo] = hr; gptr(s5e)[eo + 1] = hi;
    LDS_FENCE();
    f32x4 yacc[2];
#pragma unroll
    for (int mt = 0; mt < 2; ++mt) { yacc[mt][0] = 0.f; yacc[mt][1] = 0.f; yacc[mt][2] = 0.f; yacc[mt][3] = 0.f; }
#pragma unroll
    for (int ks = 0; ks < 4; ++ks) {
#pragma unroll
      for (int mt = 0; mt < 2; ++mt) {
        bf16x8 a = *(const bf16x8*)(HB + (mt * 16 + row16) * HS5 + ks * 32 + quad * 8);
        yacc[mt] = __builtin_amdgcn_mfma_f32_16x16x32_bf16(a, bbv[ks], yacc[mt], 0, 0, 0);
      }
    }
#pragma unroll
    for (int mt = 0; mt < 2; ++mt)
#pragma unroll
      for (int i = 0; i < 4; ++i)
        gptr(yloc)[((size_t)d * NTOK + c * 32 + mt * 16 + quad * 4 + i) * 256 + g * 16 + row16] = yacc[mt][i];
  }
}

DI void s5_out_task(const Params& p, int l, int c, char* smem) {
  const int tid = otid(), lane = tid & 63, w = tid >> 6;
  bf16_t* HB = (bf16_t*)(smem + w * 8704);
  bf16_t* Y5 = (bf16_t*)(smem + 4 * 8704);
  float* red = (float*)(smem + 4 * 8704 + 32 * 264 * 2);
  const float* proj = (const float*)(p.wsp() + OFF_PROJ);
  const float* s5a = (const float*)(p.wsp() + OFF_S5A);
  const float* s5h = (const float*)(p.wsp() + OFF_S5H);
  const bf16_t* cmt = (const bf16_t*)(p.wsp() + OFF_CMT);
  const float* yloc = (const float*)(p.wsp() + OFF_YLOC);
  const int row16 = lane & 15, quad = lane >> 4;
  float are[8], aim[8], hr0[8], hi0[8];
#pragma unroll
  for (int q = 0; q < 8; ++q) {
    const int g = w * 4 + (q >> 1), d = q & 1;
    const int pidx = ((l * 2 + d) * 16 + g) * 64 + lane;
    const size_t ho = ((size_t)((c * 2 + d) * 16 + g) * 64 + lane) * 2;
    are[q] = gptr(s5a)[pidx * 2]; aim[q] = gptr(s5a)[pidx * 2 + 1];
    hr0[q] = gptr(s5h)[ho]; hi0[q] = gptr(s5h)[ho + 1];
  }
#pragma unroll
  for (int gq = 0; gq < 4; ++gq) {
    const int g = w * 4 + gq;
    float yl[8], xav[8];
#pragma unroll
    for (int mt = 0; mt < 2; ++mt)
#pragma unroll
      for (int i = 0; i < 4; ++i) {
        const int tl = mt * 16 + quad * 4 + i;
        const size_t yo = (size_t)(c * 32 + tl) * 256 + g * 16 + row16;
        yl[mt * 4 + i] = gptr(yloc)[yo] + gptr(yloc)[(size_t)NTOK * 256 + yo];
        xav[mt * 4 + i] = gptr(proj)[(size_t)(c * 32 + tl) * PLD + PC_XA + g * 16 + row16];
      }
    const float dsk = gptr(p.inp(I_S5D))[l * 256 + g * 16 + row16];
    f32x4 yacc[2];
#pragma unroll
    for (int mt = 0; mt < 2; ++mt) { yacc[mt][0] = 0.f; yacc[mt][1] = 0.f; yacc[mt][2] = 0.f; yacc[mt][3] = 0.f; }
#pragma unroll
    for (int d = 0; d < 2; ++d) {
      const bf16_t* cb = cmt + ((size_t)(((l * 2 + d) * 16 + g) * 16 + row16)) * 128 + quad * 8;
      bf16x8 bb[4];
#pragma unroll
      for (int ks = 0; ks < 4; ++ks) bb[ks] = *gptr((const bf16x8*)(cb + ks * 32));
      const float ar = are[gq * 2 + d], ai = aim[gq * 2 + d];
      float pr = hr0[gq * 2 + d], pi = hi0[gq * 2 + d];
      LDS_FENCE();
#pragma unroll 8
      for (int sft = 0; sft < 32; ++sft) {
        const int j = d ? 31 - sft : sft;
        float nr = ar * pr - ai * pi, ni = ar * pi + ai * pr;
        pr = nr; pi = ni;
        *(unsigned*)(HB + j * HS5 + lane * 2) = pack_bf2(pr, pi);
      }
      LDS_FENCE();
#pragma unroll
      for (int ks = 0; ks < 4; ++ks) {
#pragma unroll
        for (int mt = 0; mt < 2; ++mt) {
          bf16x8 a = *(const bf16x8*)(HB + (mt * 16 + row16) * HS5 + ks * 32 + quad * 8);
          yacc[mt] = __builtin_amdgcn_mfma_f32_16x16x32_bf16(a, bb[ks], yacc[mt], 0, 0, 0);
        }
      }
    }
    LDS_FENCE();
#pragma unroll
    for (int mt = 0; mt < 2; ++mt)
#pragma unroll
      for (int i = 0; i < 4; ++i) {
        int tl = mt * 16 + quad * 4 + i;
        float y = gelu_t(yacc[mt][i] + yl[mt * 4 + i] + dsk * xav[mt * 4 + i]);
        Y5[tl * 264 + g * 16 + row16] = f2bf(y);
      }
  }
  __syncthreads();
  const int r = lane & 31, h = lane >> 5;
  f32x16 acc[2];
#pragma unroll
  for (int nt = 0; nt < 2; ++nt)
#pragma unroll
    for (int i = 0; i < 16; ++i) acc[nt][i] = 0.f;
  const bf16_t* wg = (const bf16_t*)(p.wsp() + OFF_WGLU);
#pragma unroll 8
  for (int ks = 0; ks < 16; ++ks) {
    bf16x8 a = *(const bf16x8*)(Y5 + r * 264 + ks * 16 + h * 8);
#pragma unroll
    for (int nt = 0; nt < 2; ++nt) {
      bf16x8 b = *gptr((const bf16x8*)(wg + (size_t)(w * 64 + nt * 32 + r) * 256 + ks * 16 + h * 8));
      acc[nt] = __builtin_amdgcn_mfma_f32_32x32x16_bf16(a, b, acc[nt], 0, 0, 0);
    }
  }
#pragma unroll
  for (int i = 0; i < 16; ++i) {
    int tl = (i & 3) + 8 * (i >> 2) + 4 * h;
    float s = 0.f;
#pragma unroll
    for (int nt = 0; nt < 2; ++nt) { float v = bf2f(Y5[tl * 264 + w * 64 + nt * 32 + r]) * sigm(acc[nt][i]); acc[nt][i] = v; s += v * v; }
#pragma unroll
    for (int o = 16; o > 0; o >>= 1) s += __shfl_xor(s, o, 64);
    if (r == 0) red[w * 32 + tl] = s;
  }
  __syncthreads();
  bf16_t* cat = (bf16_t*)(p.wsp() + OFF_H);
#pragma unroll
  for (int i = 0; i < 16; ++i) {
    int tl = (i & 3) + 8 * (i >> 2) + 4 * h;
    float tot = red[tl] + red[32 + tl] + red[64 + tl] + red[96 + tl];
    float rstd = rsqrtf(tot * (1.f / 256.f) + EPSF);
#pragma unroll
    for (int nt = 0; nt < 2; ++nt) {
      int ch = w * 64 + nt * 32 + r;
      gptr(cat)[(size_t)(c * 32 + tl) * DM + ch] = f2bf(acc[nt][i] * rstd * gptr(p.inp(I_GRPG))[l * 1024 + ch]);
    }
  }
  __syncthreads();
}

DI void hg_gate_vals(float z, float lb, float& lf, float& kv) {
  float e = __expf(-fabsf(z));
  float inv = frcp(1.f + e);
  float sg = (z >= 0.f) ? inv : e * inv;
  float sn = (z >= 0.f) ? e * inv : inv;
  lf = (lb == 0.f) ? (fminf(z, 0.f) - __logf(1.f + e)) : __logf(lb + (1.f - lb) * sg);
  kv = (1.f - lb) * sn;
}
DI float hg_lb(const Params& p, int l, int d, int ch) {
  if (l == 0) return 0.f;
  float x0 = p.inp(I_LBLOG)[(0 * 2 + d) * 256 + ch], x1 = p.inp(I_LBLOG)[(1 * 2 + d) * 256 + ch];
  return 1.f / (1.f + expf(x0 - x1));
}
DI void hg_build_vt(const float* proj, int c, int hd, int lane, bf16_t* Vt) {
#pragma unroll
  for (int j0 = 0; j0 < 32; j0 += 8) {
    float v[8];
#pragma unroll
    for (int q = 0; q < 8; ++q) v[q] = gptr(proj)[(size_t)(c * 32 + j0 + q) * PLD + PC_V + hd * 64 + lane];
    *(bf16x8*)(Vt + lane * 40 + j0) = pack8(v[0], v[1], v[2], v[3], v[4], v[5], v[6], v[7]);
  }
}

DI void ph_hg_local(const Params& p, int l, char* smem) {
  const int tid = otid(), lane = tid & 63, w = tid >> 6, r = lane & 31, h = lane >> 5;
  bf16_t* Vt = (bf16_t*)(smem + w * 11264);
  bf16_t* KhT = Vt + 64 * 40;
  const float* proj = (const float*)(p.wsp() + OFF_PROJ);
  float* hgs = (float*)(p.wsp() + OFF_HGS); float* hgg = (float*)(p.wsp() + OFF_HGG);
  for (int wi = obid() * 4 + w; wi < 2048; wi += gridDim.x * 4) {
    int hd = wi & 3, d = (wi >> 2) & 1, c = wi >> 3;
    hg_build_vt(proj, c, hd, lane, Vt);
    const float lb = hg_lb(p, l, d, hd * 64 + lane);
    float bcs[32], kvs[32];
    float run = 0.f;
#pragma unroll
    for (int s = 0; s < 32; ++s) {
      int j = d ? 31 - s : s;
      float z = gptr(proj)[(size_t)(c * 32 + j) * PLD + PC_ZF + d * 256 + hd * 64 + lane];
      float lf, kv; hg_gate_vals(z, lb, lf, kv);
      run += lf; bcs[s] = run; kvs[s] = kv;
    }
    const float blast = run;
#pragma unroll
    for (int j0 = 0; j0 < 32; j0 += 8) {
      float kh[8];
#pragma unroll
      for (int q = 0; q < 8; ++q) {
        int j = j0 + q;
        float b = d ? bcs[31 - j] : bcs[j];
        float kk = d ? kvs[31 - j] : kvs[j];
        kh[q] = kk * __expf(blast - b);
      }
      *(bf16x8*)(KhT + lane * 40 + j0) = pack8(kh[0], kh[1], kh[2], kh[3], kh[4], kh[5], kh[6], kh[7]);
    }
    hgg[(size_t)wi * 64 + lane] = __expf(blast);
    LDS_FENCE();
    f32x16 acc[2][2];
#pragma unroll
    for (int a = 0; a < 2; ++a)
#pragma unroll
      for (int b = 0; b < 2; ++b)
#pragma unroll
        for (int i = 0; i < 16; ++i) acc[a][b][i] = 0.f;
#pragma unroll
    for (int ks = 0; ks < 2; ++ks) {
      bf16x8 af[2], bf[2];
#pragma unroll
      for (int t = 0; t < 2; ++t) { af[t] = *(const bf16x8*)(Vt + (t * 32 + r) * 40 + ks * 16 + h * 8); bf[t] = *(const bf16x8*)(KhT + (t * 32 + r) * 40 + ks * 16 + h * 8); }
#pragma unroll
      for (int vt = 0; vt < 2; ++vt)
#pragma unroll
        for (int kt = 0; kt < 2; ++kt) acc[vt][kt] = __builtin_amdgcn_mfma_f32_32x32x16_bf16(af[vt], bf[kt], acc[vt][kt], 0, 0, 0);
    }
    float* dst = hgs + (size_t)wi * 4096;
#pragma unroll
    for (int vt = 0; vt < 2; ++vt)
#pragma unroll
      for (int kt = 0; kt < 2; ++kt)
#pragma unroll
        for (int i = 0; i < 16; ++i) gptr(dst)[(vt * 32 + (i & 3) + 8 * (i >> 2) + 4 * h) * 64 + kt * 32 + r] = acc[vt][kt][i];
  }
}

DI void hg_out_task(const Params& p, int l, int c, int hd, char* smem_w) {
  const int tid = otid(), lane = tid & 63, r = lane & 31, h = lane >> 5;
  bf16_t* Qt = (bf16_t*)smem_w;
  bf16_t* Kt = Qt + 32 * 72;
  bf16_t* Vt = Kt + 32 * 72;
  const float* proj = (const float*)(p.wsp() + OFF_PROJ);
  const float* hgs = (const float*)(p.wsp() + OFF_HGS);
  hg_build_vt(proj, c, hd, lane, Vt);
  f32x16 oT[2];
#pragma unroll
  for (int vt = 0; vt < 2; ++vt)
#pragma unroll
    for (int i = 0; i < 16; ++i) oT[vt][i] = 0.f;
#pragma unroll 1
  for (int d = 0; d < 2; ++d) {
    LDS_FENCE();
    const float lb = hg_lb(p, l, d, hd * 64 + lane);
    float run = 0.f;
    float zz[32], qq[32];
#pragma unroll
    for (int s = 0; s < 32; ++s) {
      int j = d ? 31 - s : s;
      zz[s] = gptr(proj)[(size_t)(c * 32 + j) * PLD + PC_ZF + d * 256 + hd * 64 + lane];
      qq[s] = gptr(proj)[(size_t)(c * 32 + j) * PLD + PC_Q + hd * 64 + lane];
    }
#pragma unroll
    for (int s = 0; s < 32; ++s) {
      int j = d ? 31 - s : s;
      float z = zz[s], q = qq[s];
      float lf, kv; hg_gate_vals(z, lb, lf, kv);
      run += lf;
      Qt[j * 72 + lane] = f2bf(q * __expf(run));
      Kt[j * 72 + lane] = f2bf(kv * __expf(-run));
    }
    LDS_FENCE();
    f32x16 sT;
#pragma unroll
    for (int i = 0; i < 16; ++i) sT[i] = 0.f;
    bf16x8 qf[4];
#pragma unroll
    for (int ks = 0; ks < 4; ++ks) {
      bf16x8 a = *(const bf16x8*)(Kt + r * 72 + ks * 16 + h * 8);
      qf[ks] = *(const bf16x8*)(Qt + r * 72 + ks * 16 + h * 8);
      sT = __builtin_amdgcn_mfma_f32_32x32x16_bf16(a, qf[ks], sT, 0, 0, 0);
    }
#pragma unroll
    for (int i = 0; i < 16; ++i) {
      int ii = (i & 3) + 8 * (i >> 2) + 4 * h;
      bool valid = d ? (ii >= r) : (ii <= r);
      sT[i] = valid ? sT[i] : 0.f;
    }
#pragma unroll
    for (int s2 = 0; s2 < 2; ++s2) {
      bf16x8 pb = pack8(sT[8 * s2], sT[8 * s2 + 1], sT[8 * s2 + 2], sT[8 * s2 + 3], sT[8 * s2 + 4], sT[8 * s2 + 5], sT[8 * s2 + 6], sT[8 * s2 + 7]);
#pragma unroll
      for (int vt = 0; vt < 2; ++vt) {
        s16x4 lo = *(const s16x4*)(Vt + (vt * 32 + r) * 40 + 16 * s2 + 4 * h);
        s16x4 hi2 = *(const s16x4*)(Vt + (vt * 32 + r) * 40 + 16 * s2 + 8 + 4 * h);
        bf16x8 av = __builtin_shufflevector(lo, hi2, 0, 1, 2, 3, 4, 5, 6, 7);
        oT[vt] = __builtin_amdgcn_mfma_f32_32x32x16_bf16(av, pb, oT[vt], 0, 0, 0);
      }
    }
    const float* st = hgs + (size_t)((c * 2 + d) * 4 + hd) * 4096;
#pragma unroll
    for (int ks = 0; ks < 4; ++ks) {
#pragma unroll
      for (int vt = 0; vt < 2; ++vt) {
        const GAS f32x4* sp4 = gptr((const f32x4*)(st + (vt * 32 + r) * 64 + ks * 16 + h * 8));
        f32x4 s0 = sp4[0], s1 = sp4[1];
        bf16x8 a = pack8(s0[0], s0[1], s0[2], s0[3], s1[0], s1[1], s1[2], s1[3]);
        oT[vt] = __builtin_amdgcn_mfma_f32_32x32x16_bf16(a, qf[ks], oT[vt], 0, 0, 0);
      }
    }
  }
  float ss = 0.f;
#pragma unroll
  for (int vt = 0; vt < 2; ++vt)
#pragma unroll
    for (int i = 0; i < 16; ++i) ss += oT[vt][i] * oT[vt][i];
  ss += __shfl_xor(ss, 32, 64);
  const float rstd = rsqrtf(ss * (1.f / 64.f) + EPSF);
  const int tok = c * 32 + r;
  bf16_t* cat = (bf16_t*)(p.wsp() + OFF_H);
#pragma unroll
  for (int vt = 0; vt < 2; ++vt)
#pragma unroll
    for (int g4 = 0; g4 < 4; ++g4) {
      int v0 = vt * 32 + 8 * g4 + 4 * h;
      f32x4 gt = *gptr((const f32x4*)(proj + (size_t)tok * PLD + PC_GATE + hd * 64 + v0));
      f32x4 gn = *gptr((const f32x4*)(p.inp(I_GRPG) + l * 1024 + 256 + hd * 64 + v0));
      s16x4 o;
      o[0] = (short)f2bf(oT[vt][4 * g4 + 0] * rstd * gn[0] * silu_f(gt[0]));
      o[1] = (short)f2bf(oT[vt][4 * g4 + 1] * rstd * gn[1] * silu_f(gt[1]));
      o[2] = (short)f2bf(oT[vt][4 * g4 + 2] * rstd * gn[2] * silu_f(gt[2]));
      o[3] = (short)f2bf(oT[vt][4 * g4 + 3] * rstd * gn[3] * silu_f(gt[3]));
      *gptr((s16x4*)(cat + (size_t)tok * DM + 256 + hd * 64 + v0)) = o;
    }
}

DI void ph_mix_out(const Params& p, int l, char* smem) {
  const int b = obid(); const int nb = gridDim.x;
  if (nb >= 2) {
    if ((b & 1) == 0) { for (int c = b >> 1; c < 256; c += (nb + 1) >> 1) s5_out_task(p, l, c, smem); }
    else {
      const int w = otid() >> 6;
      for (int c = b >> 1; c < 256; c += nb >> 1) hg_out_task(p, l, c, w, smem + w * 14336);
    }
  } else {
    for (int c = 0; c < 256; ++c) s5_out_task(p, l, c, smem);
    const int w = otid() >> 6;
    for (int c = 0; c < 256; ++c) hg_out_task(p, l, c, w, smem + w * 14336);
  }
}

DI void gmlp_task(const Params& p, int l, int C, int half, char* smem) {
  const int tid = otid(), lane = tid & 63, w = tid >> 6, r = lane & 31, h = lane >> 5;
  const int hd = w;
  float* rstd = (float*)smem;
  float* part = rstd + 128;
  bf16_t* GvT = (bf16_t*)(smem + 2560 + w * 9216);
  const float* proj = (const float*)(p.wsp() + OFF_PROJ);
  const bf16_t* wsb = (const bf16_t*)(p.wsp() + OFF_WSB) + (size_t)(l * 4 + hd) * 128 * 128;
#pragma unroll 4
  for (int i = 0; i < 8; ++i) {
    int tl = w * 32 + i * 4 + (lane >> 4);
    const float* src = proj + (size_t)(C * 128 + tl) * PLD + PC_GV + (lane & 15) * 16;
    float ss = 0.f;
#pragma unroll
    for (int q = 0; q < 4; ++q) {
      f32x4 v = *gptr((const f32x4*)(src + q * 4));
      float a = gelu_t(v[0]), b = gelu_t(v[1]), cc = gelu_t(v[2]), dd = gelu_t(v[3]);
      ss += a * a + b * b + cc * cc + dd * dd;
    }
#pragma unroll
    for (int o = 8; o > 0; o >>= 1) ss += __shfl_xor(ss, o, 64);
    if ((lane & 15) == 0) rstd[tl] = rsqrtf(ss * (1.f / 256.f) + EPSF);
  }
  __syncthreads();
  const float gmg = p.inp(I_GMNG)[l * 256 + hd * 64 + lane];
  bf16_t* cat = (bf16_t*)(p.wsp() + OFF_H);
  f32x16 acc[2][2];
#pragma unroll
  for (int a = 0; a < 2; ++a)
#pragma unroll
    for (int b = 0; b < 2; ++b)
#pragma unroll
      for (int i = 0; i < 16; ++i) acc[a][b][i] = 0.f;
#pragma unroll 1
  for (int pass = 0; pass < 2; ++pass) {
    LDS_FENCE();
#pragma unroll 4
    for (int j0 = 0; j0 < 64; j0 += 8) {
      float v[8];
#pragma unroll
      for (int q = 0; q < 8; ++q) {
        int j = pass * 64 + j0 + q;
        v[q] = gelu_t(gptr(proj)[(size_t)(C * 128 + j) * PLD + PC_GV + hd * 64 + lane]) * rstd[j] * gmg;
      }
      *(bf16x8*)(GvT + lane * 72 + j0) = pack8(v[0], v[1], v[2], v[3], v[4], v[5], v[6], v[7]);
    }
    LDS_FENCE();
#pragma unroll
    for (int ks = 0; ks < 4; ++ks) {
      bf16x8 af[2];
#pragma unroll
      for (int mt = 0; mt < 2; ++mt) af[mt] = *(const bf16x8*)(GvT + (mt * 32 + r) * 72 + ks * 16 + h * 8);
#pragma unroll
      for (int nt = 0; nt < 2; ++nt) {
        bf16x8 b = *gptr((const bf16x8*)(wsb + (size_t)((half * 2 + nt) * 32 + r) * 128 + pass * 64 + ks * 16 + h * 8));
#pragma unroll
        for (int mt = 0; mt < 2; ++mt) acc[mt][nt] = __builtin_amdgcn_mfma_f32_32x32x16_bf16(af[mt], b, acc[mt][nt], 0, 0, 0);
      }
    }
  }
#pragma unroll
  for (int nt = 0; nt < 2; ++nt) {
    const int ti = (half * 2 + nt) * 32 + r; const int tok = C * 128 + ti;
    const float bsv = p.inp(I_GMBS)[(l * 4 + hd) * 128 + ti];
    float ss = 0.f;
#pragma unroll
    for (int mt = 0; mt < 2; ++mt)
#pragma unroll
      for (int g4 = 0; g4 < 4; ++g4) {
        int d0 = mt * 32 + 8 * g4 + 4 * h;
        f32x4 gu = *gptr((const f32x4*)(proj + (size_t)tok * PLD + PC_GU + hd * 64 + d0));
        float v0 = gelu_t(gu[0]) * (acc[mt][nt][4 * g4 + 0] + bsv);
        float v1 = gelu_t(gu[1]) * (acc[mt][nt][4 * g4 + 1] + bsv);
        float v2 = gelu_t(gu[2]) * (acc[mt][nt][4 * g4 + 2] + bsv);
        float v3 = gelu_t(gu[3]) * (acc[mt][nt][4 * g4 + 3] + bsv);
        acc[mt][nt][4 * g4 + 0] = v0; acc[mt][nt][4 * g4 + 1] = v1; acc[mt][nt][4 * g4 + 2] = v2; acc[mt][nt][4 * g4 + 3] = v3;
        ss += v0 * v0 + v1 * v1 + v2 * v2 + v3 * v3;
      }
    ss += __shfl_xor(ss, 32, 64);
    if (h == 0) part[w * 64 + nt * 32 + r] = ss;
  }
  __syncthreads();
#pragma unroll
  for (int nt = 0; nt < 2; ++nt) {
    const int ti = (half * 2 + nt) * 32 + r; const int tok = C * 128 + ti;
    const int pi = nt * 32 + r;
    float tot = part[pi] + part[64 + pi] + part[128 + pi] + part[192 + pi];
    float rs = rsqrtf(tot * (1.f / 256.f) + EPSF);
#pragma unroll
    for (int mt = 0; mt < 2; ++mt)
#pragma unroll
      for (int g4 = 0; g4 < 4; ++g4) {
        int d0 = mt * 32 + 8 * g4 + 4 * h;
        f32x4 gn = *gptr((const f32x4*)(p.inp(I_GRPG) + l * 1024 + 768 + hd * 64 + d0));
        s16x4 o;
        o[0] = (short)f2bf(acc[mt][nt][4 * g4 + 0] * rs * gn[0]); o[1] = (short)f2bf(acc[mt][nt][4 * g4 + 1] * rs * gn[1]);
        o[2] = (short)f2bf(acc[mt][nt][4 * g4 + 2] * rs * gn[2]); o[3] = (short)f2bf(acc[mt][nt][4 * g4 + 3] * rs * gn[3]);
        *gptr((s16x4*)(cat + (size_t)tok * DM + 768 + hd * 64 + d0)) = o;
      }
  }
  __syncthreads();
}

DI void ph_c_norm(const Params& p, int l) {
  const int tid_ = otid(); const int lane = tid_ & 63, w = tid_ >> 6;
  bf16_t* cat = (bf16_t*)(p.wsp() + OFF_H);
  const float* g0 = (const float*)(p.wsp() + OFF_GCP0); const float* g1 = (const float*)(p.wsp() + OFF_GCP1);
  for (int tok = obid() * 4 + w; tok < NTOK; tok += gridDim.x * 4) {
    float4 v = ldg4(g0 + (size_t)tok * 256 + lane * 4);
    if (tok >= 4096) {
#pragma unroll
      for (int q = 0; q < 3; ++q) {
        float4 u = ldg4(g1 + ((size_t)q * 4096 + (tok - 4096)) * 256 + lane * 4);
        v.x += u.x; v.y += u.y; v.z += u.z; v.w += u.w;
      }
    }
    float ss = wave_sum(v.x * v.x + v.y * v.y + v.z * v.z + v.w * v.w);
    float rstd = rsqrtf(ss * (1.f / 256.f) + EPSF);
    float4 g = ldg4(p.inp(I_GRPG) + l * 1024 + 512 + lane * 4);
    ushort4 o; o.x = f2bf(v.x * rstd * g.x); o.y = f2bf(v.y * rstd * g.y); o.z = f2bf(v.z * rstd * g.z); o.w = f2bf(v.w * rstd * g.w);
    stg_us4(cat + (size_t)tok * DM + 512 + lane * 4, o);
  }
}

DI void ph_local(const Params& p, int l, char* smem) {
  for (int it = obid(); it < 448; it += gridDim.x) {
    if (it < 320) {
      int seq, mt, nt, ks, T, start, klen;
      if (it < 256) { ks = it & 3; nt = (it >> 2) & 1; mt = (it >> 3) & 15; seq = 16 + (it >> 7); klen = 1024; }
      else { int j = it - 256; ks = 0; nt = j & 1; mt = (j >> 1) & 1; seq = j >> 2; klen = 512; }
      seq_info(seq, start, T);
      const bf16_t* A = (const bf16_t*)(p.wsp() + (T == 256 ? OFF_DFTC : OFF_DFTL)) + (size_t)mt * 128 * 2 * T + ks * 1024;
      const bf16_t* Bt = (const bf16_t*)(p.wsp() + OFF_UVT) + (size_t)512 * start + (size_t)nt * 128 * 2 * T + ks * 1024;
      float* dst = (ks == 0) ? (float*)(p.wsp() + OFF_GCP0) + (size_t)(start + mt * 128) * 256 + nt * 128
                             : (float*)(p.wsp() + OFF_GCP1) + ((size_t)(ks - 1) * 4096 + (start - 4096) + mt * 128) * 256 + nt * 128;
      EpiStoreF epi{dst, 256};
      gemm_tile64_pf2(A, 2 * T, Bt, 2 * T, klen, smem, epi);
    } else {
      gmlp_task(p, l, (it - 320) >> 1, (it - 320) & 1, smem);
    }
  }
  ph_hg_local(p, l, smem);
  ph_s5_local(p, l, smem);
}

DI void ph_conv_gate(const Params& p, int l) {
  const int gtid = obid() * 256 + otid(), gsz = gridDim.x * 256;
  const bf16_t* z = (const bf16_t*)(p.wsp() + OFF_Z); bf16_t* act = (bf16_t*)(p.wsp() + OFF_ACT);
  const float* cw = p.inp(I_CONVW) + (size_t)l * 3 * DUP; const float* cb = p.inp(I_CONVB) + (size_t)l * DUP;
  for (int e = gtid; e < NTOK * (DFF / 8); e += gsz) {
    int tok = e / (DFF / 8), j0 = (e % (DFF / 8)) * 8;
    int seg = tok < 4096 ? 256 : 64; int tt = tok & (seg - 1);
    bool hp = tt > 0, hn = tt < seg - 1;
    float res[8];
    float za[2][8];
#pragma unroll
    for (int half = 0; half < 2; ++half) {
      int ch = half * DFF + j0;
      uint4 zc = *(const uint4*)(z + (size_t)tok * DUP + ch);
      uint4 zp = hp ? *(const uint4*)(z + (size_t)(tok - 1) * DUP + ch) : make_uint4(0, 0, 0, 0);
      uint4 zn = hn ? *(const uint4*)(z + (size_t)(tok + 1) * DUP + ch) : make_uint4(0, 0, 0, 0);
      const unsigned* pc = (const unsigned*)&zc; const unsigned* pp = (const unsigned*)&zp; const unsigned* pn = (const unsigned*)&zn;
#pragma unroll
      for (int q = 0; q < 8; ++q) {
        float vc = bf2f((bf16_t)((pc[q >> 1] >> ((q & 1) * 16)) & 0xffff));
        float vp = bf2f((bf16_t)((pp[q >> 1] >> ((q & 1) * 16)) & 0xffff));
        float vn = bf2f((bf16_t)((pn[q >> 1] >> ((q & 1) * 16)) & 0xffff));
        za[half][q] = cb[ch + q] + cw[ch + q] * vp + cw[DUP + ch + q] * vc + cw[2 * DUP + ch + q] * vn;
      }
    }
#pragma unroll
    for (int q = 0; q < 8; ++q) res[q] = gelu_t(za[0][q]) * za[1][q];
    uint4 o;
    o.x = (unsigned)f2bf(res[0]) | ((unsigned)f2bf(res[1]) << 16);
    o.y = (unsigned)f2bf(res[2]) | ((unsigned)f2bf(res[3]) << 16);
    o.z = (unsigned)f2bf(res[4]) | ((unsigned)f2bf(res[5]) << 16);
    o.w = (unsigned)f2bf(res[6]) | ((unsigned)f2bf(res[7]) << 16);
    *(uint4*)(act + (size_t)tok * DFF + j0) = o;
  }
}

#define EXP 0
#define GSYNC() xcd_barrier(xb)
#define XS(n) if (EXP == n) { GSYNC(); }
__global__ void __launch_bounds__(256, 2) mega_kernel(Params pk) {
  __shared__ __attribute__((aligned(16))) char smem[SMEM_BYTES];
  cg::grid_group grid = cg::this_grid();
  __shared__ uint4 xb_words;
  __shared__ Params sp;
  if (threadIdx.x == 0) { xb_words = make_uint4(0u, 0u, 0u, 0u); sp = pk; }
  __syncthreads();
  const Params& p = sp;
  XcdBarrier xb = xcd_barrier_post((unsigned*)(pk.ws + OFF_BAR), (volatile LAS unsigned*)&xb_words);
  if (p.wsp() == nullptr) grid.sync();
  ph_mu(p, smem);
  ph_prep(p, smem);
  GSYNC();
  ph_fold(p, smem);
  ph_mod_reduce(p);
  GSYNC();
  ph_fold_copy(p, 0);
  for (int l = 0; l < 2; ++l) {
    if (l > 0) ph_convert_weights(p, l, smem);
    ph_norm_mod(p, l, p.inp(I_N1G) + l * 1024, 0, 1024, l == 0);
    GSYNC();
    ph_gemm_in(p, smem);
    GSYNC();
    ph_local(p, l, smem);
    if (EXP == 11) ph_local(p, l, smem);
    GSYNC();
    ph_scans(p, l);
    ph_c_norm(p, l);
    GSYNC();
    ph_mix_out(p, l, smem);
    if (EXP == 12) ph_mix_out(p, l, smem);
    GSYNC();
    ph_gemm_out(p, l, smem);
    GSYNC();
    ph_norm_mod(p, l, p.inp(I_N2G) + l * 1024, 3072, 4096);
    GSYNC();
    ph_gemm_up(p, l, smem);
    GSYNC();
    ph_gemm_down(p, l, smem);
    GSYNC();
  }
  ph_final_norm(p);
}

extern "C" void kernel_launch(void* const* d_in, const int* in_sizes, int n_in, void* d_out, int out_size, void* d_ws, size_t ws_size,
                              hipStream_t stream) {
  static int grid_blocks = 0;
  if (!grid_blocks) {
    int dev = 0, cus = 0, per_cu = 0;
    hipGetDevice(&dev);
    hipDeviceGetAttribute(&cus, hipDeviceAttributeMultiprocessorCount, dev);
    hipOccupancyMaxActiveBlocksPerMultiprocessor(&per_cu, mega_kernel, 256, 0);
    if (per_cu > 2) per_cu = 2;
    if (per_cu < 1) per_cu = 1;
    grid_blocks = cus * per_cu;
  }
  if (ws_size < WS_NEEDED) fprintf(stderr, "workspace too small: %zu < %zu\n", ws_size, (size_t)WS_NEEDED);
  Params p{};
  for (int i = 0; i < 33; ++i) p.in[i] = (const float*)d_in[i];
  p.out = (float*)d_out;
  p.ws = (char*)d_ws;
  void* args[] = {&p};
  hipMemsetAsync((char*)d_ws + OFF_BAR, 0, XCD_BAR_WORDS_C * 4, stream);
  hipError_t e = hipLaunchCooperativeKernel((void*)mega_kernel, dim3(grid_blocks), dim3(256), args, 0, stream);
  if (e != hipSuccess) fprintf(stderr, "cooperative launch failed: %s (grid %d)\n", hipGetErrorString(e), grid_blocks);
}
```

```cpp
#include <hip/hip_runtime.h>
#include <hip/hip_cooperative_groups.h>
#include <cstdio>
namespace cg = cooperative_groups;

typedef unsigned short bf16_t;
using bf16x8 = __attribute__((ext_vector_type(8))) short;
using f32x16 = __attribute__((ext_vector_type(16))) float;
using u32x4 = __attribute__((ext_vector_type(4))) unsigned;
using s16x4 = __attribute__((ext_vector_type(4))) short;
using f32x4 = __attribute__((ext_vector_type(4))) float;
#define LDS_FENCE() asm volatile("" ::: "memory")

#define DI __device__ __forceinline__
#define GAS __attribute__((address_space(1)))
template <class T> DI const GAS T* gptr(const T* p) { return (const GAS T*)p; }
template <class T> DI GAS T* gptr(T* p) { return (GAS T*)p; }
DI float4 ldg4(const float* p) { f32x4 v = *gptr((const f32x4*)p); return make_float4(v[0], v[1], v[2], v[3]); }
DI void stg4(float* p, float4 v) { f32x4 t; t[0] = v.x; t[1] = v.y; t[2] = v.z; t[3] = v.w; *gptr((f32x4*)p) = t; }
DI void stg_us4(unsigned short* p, ushort4 v) { s16x4 t; t[0] = (short)v.x; t[1] = (short)v.y; t[2] = (short)v.z; t[3] = (short)v.w; *gptr((s16x4*)p) = t; }

constexpr int NTOK = 8192;
constexpr int DM = 1024;
constexpr int NWIN = 2560;
constexpr int PLD = 2048;
constexpr int DFF = 2816;
constexpr int DUP = 5632;
constexpr float EPSF = 1e-6f;

constexpr int PC_XA = 0, PC_Q = 256, PC_ZF = 512, PC_V = 1024, PC_GATE = 1280, PC_GU = 1536, PC_GV = 1792;

constexpr size_t SZ_WIN = (size_t)NWIN * 1024 * 2;
constexpr size_t SZ_WOUT = (size_t)1024 * 1024 * 2;
constexpr size_t SZ_WUP = (size_t)DUP * 1024 * 2;
constexpr size_t SZ_WDN = (size_t)1024 * DFF * 2;
constexpr size_t SZ_W256 = (size_t)256 * 256 * 2;
constexpr size_t OFF_WIN = 0;
constexpr size_t OFF_WOUT = OFF_WIN + SZ_WIN;
constexpr size_t OFF_WUP = OFF_WOUT + SZ_WOUT;
constexpr size_t OFF_WDN = OFF_WUP + SZ_WUP;
constexpr size_t OFF_WGLU = OFF_WDN + SZ_WDN;
constexpr size_t OFF_DFTL = OFF_WGLU + SZ_W256;
constexpr size_t OFF_DFTC = OFF_DFTL + (size_t)2048 * 4096 * 2;
constexpr int NKC = 16;
constexpr size_t OFF_ADAP = OFF_DFTC + (size_t)256 * 512 * 2;
constexpr size_t OFF_MOD = OFF_ADAP + (size_t)NKC * 2 * 3 * 6144 * 4;
constexpr size_t OFF_S5A = OFF_MOD + (size_t)2 * 3 * 6144 * 4;
constexpr size_t OFF_S5AL = OFF_S5A + 4096 * 2 * 4;
constexpr size_t OFF_S5BBR = OFF_S5AL + 4096 * 2 * 4;
constexpr size_t OFF_S5BBI = OFF_S5BBR + 4096 * 16 * 4;
constexpr size_t OFF_X = OFF_S5BBI + 4096 * 16 * 4;
constexpr size_t OFF_H = OFF_X + (size_t)NTOK * DM * 4;
constexpr size_t OFF_R1 = OFF_H + (size_t)NTOK * DM * 2;
constexpr size_t OFF_PROJ = OFF_R1;
constexpr size_t OFF_UVT = OFF_PROJ + (size_t)NTOK * PLD * 4;
constexpr size_t OFF_YLOC = OFF_UVT + (size_t)NTOK * 512 * 2;
constexpr size_t OFF_Z = OFF_R1;
constexpr size_t SZ_R1 = (size_t)NTOK * DUP * 2;
constexpr size_t OFF_R2 = OFF_R1 + SZ_R1;
constexpr size_t OFF_HGS = OFF_R2;
constexpr size_t OFF_GCP0 = OFF_HGS + (size_t)2048 * 4096 * 4;
constexpr size_t OFF_GCP1 = OFF_GCP0 + (size_t)NTOK * 256 * 4;
constexpr size_t OFF_HGG = OFF_GCP1 + (size_t)3 * 4096 * 256 * 4;
constexpr size_t OFF_S5E = OFF_HGG + (size_t)2048 * 64 * 4;
constexpr size_t OFF_S5H = OFF_S5E + (size_t)256 * 2 * 16 * 64 * 2 * 4;
constexpr size_t OFF_CMT = OFF_S5H + (size_t)256 * 2 * 16 * 64 * 2 * 4;
constexpr size_t OFF_WSB = OFF_CMT + (size_t)2 * 2 * 16 * 16 * 128 * 2;
constexpr size_t OFF_ACT = OFF_R2;
constexpr int XCD_BAR_WORDS_C = 3456;
constexpr size_t OFF_MU = OFF_WSB + (size_t)2 * 4 * 128 * 128 * 2;
constexpr size_t OFF_WFOLD = OFF_MU + (size_t)2 * 2 * 256 * 256 * 4;
constexpr size_t OFF_BAR = OFF_WFOLD + (size_t)2 * 512 * 1024 * 2;
constexpr size_t WS_NEEDED = OFF_BAR + XCD_BAR_WORDS_C * 4;

constexpr size_t OUT_S5RE = (size_t)NTOK * DM;
constexpr size_t OUT_S5IM = OUT_S5RE + 65536;
constexpr size_t OUT_HG = OUT_S5IM + 65536;

constexpr int SMEM_BYTES = 63488;

struct Params {
  const float* in[33];
  float* out;
  char* ws;
  DI char* wsp() const { return *(char* const volatile __attribute__((address_space(3)))*)(&ws); }
  DI const float* inp(int i) const { return *(const float* const __attribute__((address_space(3)))*)(&in[i]); }
  DI float* outp() const { return *(float* const __attribute__((address_space(3)))*)(&out); }
};

enum { I_XP = 0, I_XS, I_S5RE, I_S5IM, I_HGST, I_C, I_CCTX, I_WADA, I_BADA, I_N1G, I_N2G, I_WIN, I_LAMRE, I_LAMIM, I_LOGDT,
       I_BRE, I_BIM, I_CRE, I_CIM, I_S5D, I_WGLU, I_LBLOG, I_FNW, I_GMNG, I_GMWS, I_GMBS, I_GRPG, I_WOUT, I_WUP, I_CONVW,
       I_CONVB, I_WDN, I_FING };

DI bf16_t f2bf(float x) { unsigned u = __float_as_uint(x); u += 0x7fffu + ((u >> 16) & 1u); return (bf16_t)(u >> 16); }
DI float bf2f(bf16_t b) { return __uint_as_float(((unsigned)b) << 16); }
DI float frcp(float x) { return __builtin_amdgcn_rcpf(x); }
DI float gelu_t(float x) { float u2 = 1.5957691216057308f * (x + 0.044715f * x * x * x); return x * frcp(1.f + __expf(-u2)); }
DI float sigm(float x) { return frcp(1.f + __expf(-x)); }
DI float silu_f(float x) { return x * sigm(x); }
DI int otid() { int t = threadIdx.x; asm volatile("" : "+v"(t)); return t; }
DI int obid() { int b = blockIdx.x; asm volatile("" : "+s"(b)); return b; }
DI unsigned pack_bf2(float a, float b) { return (unsigned)f2bf(a) | ((unsigned)f2bf(b) << 16); }
DI bf16x8 pack8(float a0, float a1, float a2, float a3, float a4, float a5, float a6, float a7) {
  u32x4 v; v[0] = pack_bf2(a0, a1); v[1] = pack_bf2(a2, a3); v[2] = pack_bf2(a4, a5); v[3] = pack_bf2(a6, a7);
  return __builtin_bit_cast(bf16x8, v);
}
DI float wave_sum(float v) {
#pragma unroll
  for (int o = 32; o > 0; o >>= 1) v += __shfl_xor(v, o, 64);
  return v;
}
DI void seq_of_tok(int tok, int& start, int& T) {
  if (tok < 4096) { start = tok & ~255; T = 256; } else { start = 4096 + ((tok - 4096) & ~2047); T = 2048; }
}
DI int cv_of_tok(int tok) { return tok < 4096 ? 0 : 1 + ((tok - 4096) >> 11); }
DI void seq_info(int seq, int& start, int& T) {
  if (seq < 16) { start = seq * 256; T = 256; } else { start = 4096 + (seq - 16) * 2048; T = 2048; }
}


#define XB_TMO      128
#define XB_XCNT(j)  (256  + 64 * (j))
#define XB_XSUB(j)  (1280 + 64 * (j))
#define XB_XGEN(j)  (2304 + 64 * (j))
#define XB_TOP      3328
#define XB_TOPGEN   3392
#define XCD_BAR_WORDS 3456
#define XB_SPIN_CAP (1u << 18)
#define LAS __attribute__((address_space(3)))
DI unsigned xb_ld(unsigned* p) { return __hip_atomic_load((GAS unsigned*)p, __ATOMIC_RELAXED, __HIP_MEMORY_SCOPE_AGENT); }
DI unsigned xb_add(unsigned* p, unsigned v) { return __hip_atomic_fetch_add((GAS unsigned*)p, v, __ATOMIC_RELAXED, __HIP_MEMORY_SCOPE_AGENT); }
DI unsigned xb_xcc_id() { return (unsigned)__builtin_amdgcn_s_getreg((3 << 11) | 20) & 0xFu; }
#define XB_SPIN(cond, bar) do { unsigned _sp = 0; while (cond) { __builtin_amdgcn_s_sleep(1); \
    if ((++_sp & 255u) == 0u) { if (xb_ld(&(bar)[XB_TMO])) break; if (_sp > XB_SPIN_CAP) { atomicAdd(&(bar)[XB_TMO], 1u); break; } } } } while (0)
struct XcdBarrier { unsigned* bar; volatile LAS unsigned* st; };
DI XcdBarrier xcd_barrier_post(unsigned* bar, volatile LAS unsigned* st) {
  XcdBarrier b; b.bar = bar; b.st = st;
  if (threadIdx.x == 0) { unsigned x = xb_xcc_id(); st[2] = x; (void)xb_add(&bar[XB_XCNT(x)], 1u); }
  return b;
}
DI void xcd_barrier_complete(unsigned* bar, unsigned x, unsigned& nloc, unsigned& nx) {
  const unsigned G = gridDim.x * gridDim.y * gridDim.z;
  unsigned sum, cnt, mine, sp = 0u;
  for (;;) {
    sum = 0u; cnt = 0u; mine = 0u;
#pragma unroll
    for (unsigned j = 0; j < 16; ++j) { const unsigned c = xb_ld(&bar[XB_XCNT(j)]); sum += c; cnt += (c > 0u) ? 1u : 0u; mine = (j == x) ? c : mine; }
    if (sum == G) break;
    __builtin_amdgcn_s_sleep(1);
    if ((++sp & 255u) == 0u) { if (xb_ld(&bar[XB_TMO])) break; if (sp > XB_SPIN_CAP) { atomicAdd(&bar[XB_TMO], 1u); break; } }
  }
  nloc = mine > 0u ? mine : 1u; nx = cnt > 0u ? cnt : 1u;
}
DI void xcd_barrier(const XcdBarrier& b) {
  asm volatile("s_waitcnt vmcnt(0)" ::: "memory");
  __syncthreads();
  if (threadIdx.x == 0) {
    unsigned* bar = b.bar;
    asm volatile("" : "+s"(bar));
    __builtin_amdgcn_s_waitcnt(0);
    unsigned nloc = b.st[0], nx = b.st[1]; const unsigned bx = b.st[2];
    if (nloc == 0u) { xcd_barrier_complete(bar, bx, nloc, nx); b.st[0] = nloc; b.st[1] = nx; }
    const unsigned old = xb_add(&bar[XB_XSUB(bx)], 1u);
    const unsigned gen = old / nloc;
    if (old + 1u == (gen + 1u) * nloc) {
      __builtin_amdgcn_fence(__ATOMIC_RELEASE, "agent");
      asm volatile("s_waitcnt vmcnt(0)" ::: "memory");
      const unsigned og = xb_add(&bar[XB_TOP], 1u);
      const unsigned tg = og / nx;
      if (og + 1u == (tg + 1u) * nx) xb_add(&bar[XB_TOPGEN], 1u);
      else XB_SPIN(xb_ld(&bar[XB_TOPGEN]) == tg, bar);
      __builtin_amdgcn_fence(__ATOMIC_ACQUIRE, "agent");
      xb_add(&bar[XB_XGEN(bx)], 1u);
      asm volatile("s_waitcnt vmcnt(0)" ::: "memory");
    } else {
      XB_SPIN(xb_ld(&bar[XB_XGEN(bx)]) == gen, bar);
      __builtin_amdgcn_fence(__ATOMIC_ACQUIRE, "agent");
      asm volatile("s_waitcnt vmcnt(0)" ::: "memory");
    }
  }
  __syncthreads();
}

template <int BM, int BN, class Epi>
DI void gemm_tile(const bf16_t* __restrict__ A, int lda, const bf16_t* __restrict__ Bt, int ldb, int K, char* smem, const Epi& epi) {
  constexpr int LS = 40;
  constexpr int MI = BM / 64, NI = BN / 64;
  constexpr int A_CH = BM * 4 / 256, B_CH = BN * 4 / 256;
  bf16_t* sbase = (bf16_t*)smem;
  const int tid = otid(), lane = tid & 63, w = tid >> 6, wm = w >> 1, wn = w & 1, r = lane & 31, h = lane >> 5;
  f32x16 acc[MI][NI];
#pragma unroll
  for (int mi = 0; mi < MI; ++mi)
#pragma unroll
    for (int ni = 0; ni < NI; ++ni)
#pragma unroll
      for (int i = 0; i < 16; ++i) acc[mi][ni][i] = 0.f;
  u32x4 ra[A_CH], rb[B_CH];
  const int KT = K / 32;
#define GLOAD(kt)                                                                                   \
  {                                                                                                 \
    _Pragma("unroll") for (int i = 0; i < A_CH; ++i) {                                              \
      int c = tid + i * 256; int row = c >> 2, kc = c & 3;                                          \
      ra[i] = *(const u32x4*)(A + (size_t)row * lda + (kt) * 32 + kc * 8);                          \
    }                                                                                               \
    _Pragma("unroll") for (int i = 0; i < B_CH; ++i) {                                              \
      int c = tid + i * 256; int row = c >> 2, kc = c & 3;                                          \
      rb[i] = *(const u32x4*)(Bt + (size_t)row * ldb + (kt) * 32 + kc * 8);                         \
    }                                                                                               \
  }
#define SSTORE(s)                                                                                   \
  {                                                                                                 \
    bf16_t* sa = sbase + (s) * (BM + BN) * LS; bf16_t* sb = sa + BM * LS;                           \
    _Pragma("unroll") for (int i = 0; i < A_CH; ++i) {                                              \
      int c = tid + i * 256; int row = c >> 2, kc = c & 3;                                          \
      *(u32x4*)(sa + row * LS + kc * 8) = ra[i];                                                    \
    }                                                                                               \
    _Pragma("unroll") for (int i = 0; i < B_CH; ++i) {                                              \
      int c = tid + i * 256; int row = c >> 2, kc = c & 3;                                          \
      *(u32x4*)(sb + row * LS + kc * 8) = rb[i];                                                    \
    }                                                                                               \
  }
  GLOAD(0);
  SSTORE(0);
  __syncthreads();
  for (int kt = 0; kt < KT; ++kt) {
    if (kt + 1 < KT) GLOAD(kt + 1);
    const bf16_t* sa = sbase + (kt & 1) * (BM + BN) * LS;
    const bf16_t* sb = sa + BM * LS;
    const bf16_t* a_s = sa + (wm * (BM / 2) + r) * LS + h * 8;
    const bf16_t* b_s = sb + (wn * (BN / 2) + r) * LS + h * 8;
#pragma unroll
    for (int ks = 0; ks < 2; ++ks) {
      bf16x8 af[MI], bfr[NI];
#pragma unroll
      for (int mi = 0; mi < MI; ++mi) af[mi] = *(const bf16x8*)(a_s + mi * 32 * LS + ks * 16);
#pragma unroll
      for (int ni = 0; ni < NI; ++ni) bfr[ni] = *(const bf16x8*)(b_s + ni * 32 * LS + ks * 16);
#pragma unroll
      for (int mi = 0; mi < MI; ++mi)
#pragma unroll
        for (int ni = 0; ni < NI; ++ni) acc[mi][ni] = __builtin_amdgcn_mfma_f32_32x32x16_bf16(af[mi], bfr[ni], acc[mi][ni], 0, 0, 0);
    }
    if (kt + 1 < KT) SSTORE((kt + 1) & 1);
    __syncthreads();
  }
#undef GLOAD
#undef SSTORE
#pragma unroll
  for (int mi = 0; mi < MI; ++mi)
#pragma unroll
    for (int ni = 0; ni < NI; ++ni) {
#pragma unroll
      for (int i = 0; i < 16; ++i) {
        int rr = wm * (BM / 2) + mi * 32 + (i & 3) + 8 * (i >> 2) + 4 * h;
        int cc = wn * (BN / 2) + ni * 32 + r;
        epi(rr, cc, acc[mi][ni][i]);
        if ((i & 3) == 3) __builtin_amdgcn_sched_barrier(0);
      }
    }
}

template <int BM, int BN, class Epi, bool TILE_EPI = false>
DI void gemm_tile64(const bf16_t* __restrict__ A, int lda, const bf16_t* __restrict__ Bt, int ldb, int K, char* smem, const Epi& epi) {
  constexpr int LS = 72;
  constexpr int MI = BM / 64, NI = BN / 64;
  constexpr int A_CH = BM * 8 / 256, B_CH = BN * 8 / 256;
  bf16_t* sa = (bf16_t*)smem;
  bf16_t* sb = sa + BM * LS;
  const int tid = otid(), lane = tid & 63, w = tid >> 6, wm = w >> 1, wn = w & 1, r = lane & 31, h = lane >> 5;
  f32x16 acc[MI][NI];
#pragma unroll
  for (int mi = 0; mi < MI; ++mi)
#pragma unroll
    for (int ni = 0; ni < NI; ++ni)
#pragma unroll
      for (int i = 0; i < 16; ++i) acc[mi][ni][i] = 0.f;
  u32x4 ra[A_CH], rb[B_CH];
  const int KT = K / 64;
  const bf16_t* ag = A + (size_t)(tid >> 3) * lda + (tid & 7) * 8;
  const bf16_t* bg = Bt + (size_t)(tid >> 3) * ldb + (tid & 7) * 8;
  bf16_t* sa_w = sa + (tid >> 3) * LS + (tid & 7) * 8;
  bf16_t* sb_w = sb + (tid >> 3) * LS + (tid & 7) * 8;
#pragma unroll
  for (int i = 0; i < A_CH; ++i) ra[i] = *gptr((const u32x4*)(ag + (size_t)i * 32 * lda));
#pragma unroll
  for (int i = 0; i < B_CH; ++i) rb[i] = *gptr((const u32x4*)(bg + (size_t)i * 32 * ldb));
  const bf16_t* a_s = sa + (wm * (BM / 2) + r) * LS + h * 8;
  const bf16_t* b_s = sb + (wn * (BN / 2) + r) * LS + h * 8;
#pragma unroll 1
  for (int kt = 0; kt < KT; ++kt) {
    __syncthreads();
#pragma unroll
    for (int i = 0; i < A_CH; ++i) *(u32x4*)(sa_w + i * 32 * LS) = ra[i];
#pragma unroll
    for (int i = 0; i < B_CH; ++i) *(u32x4*)(sb_w + i * 32 * LS) = rb[i];
    __syncthreads();
    {
      bf16x8 af[2][MI], bfr[2][NI];
#define LDFRAG(buf, ks)                                                                               \
      { _Pragma("unroll") for (int mi = 0; mi < MI; ++mi) af[buf][mi] = *(const bf16x8*)(a_s + mi * 32 * LS + (ks) * 16);   \
        _Pragma("unroll") for (int ni = 0; ni < NI; ++ni) bfr[buf][ni] = *(const bf16x8*)(b_s + ni * 32 * LS + (ks) * 16); }
#define DOMFMA(buf)                                                                                   \
      { _Pragma("unroll") for (int mi = 0; mi < MI; ++mi)                                             \
          _Pragma("unroll") for (int ni = 0; ni < NI; ++ni)                                           \
            acc[mi][ni] = __builtin_amdgcn_mfma_f32_32x32x16_bf16(af[buf][mi], bfr[buf][ni], acc[mi][ni], 0, 0, 0); }
      LDFRAG(0, 0); LDFRAG(1, 1);
      __builtin_amdgcn_sched_barrier(0);
      if (kt + 1 < KT) {
#pragma unroll
        for (int i = 0; i < A_CH; ++i) ra[i] = *gptr((const u32x4*)(ag + (size_t)i * 32 * lda + (kt + 1) * 64));
#pragma unroll
        for (int i = 0; i < B_CH; ++i) rb[i] = *gptr((const u32x4*)(bg + (size_t)i * 32 * ldb + (kt + 1) * 64));
      }
      __builtin_amdgcn_sched_barrier(0);
      DOMFMA(0);
      __builtin_amdgcn_sched_barrier(0);
      LDFRAG(0, 2);
      __builtin_amdgcn_sched_barrier(0);
      DOMFMA(1);
      __builtin_amdgcn_sched_barrier(0);
      LDFRAG(1, 3);
      __builtin_amdgcn_sched_barrier(0);
      DOMFMA(0);
      __builtin_amdgcn_sched_barrier(0);
      DOMFMA(1);
      __builtin_amdgcn_sched_barrier(0);
#undef LDFRAG
#undef DOMFMA
    }
  }
  if constexpr (TILE_EPI) {
    epi.tile(acc, wm, wn, r, h, smem);
  } else {
#pragma unroll
    for (int mi = 0; mi < MI; ++mi)
#pragma unroll
      for (int ni = 0; ni < NI; ++ni) {
#pragma unroll
        for (int i = 0; i < 16; ++i) {
          int rr = wm * (BM / 2) + mi * 32 + (i & 3) + 8 * (i >> 2) + 4 * h;
          int cc = wn * (BN / 2) + ni * 32 + r;
          epi(rr, cc, acc[mi][ni][i]);
          if ((i & 3) == 3) __builtin_amdgcn_sched_barrier(0);
        }
      }
  }
  __syncthreads();
}

template <class Epi>
DI void gemm_tile64_pf2(const bf16_t* __restrict__ A, int lda, const bf16_t* __restrict__ Bt, int ldb, int K, char* smem, const Epi& epi) {
  constexpr int BM = 128, BN = 128, LS = 72, MI = 2, NI = 2, CH = 4;
  bf16_t* sa = (bf16_t*)smem;
  bf16_t* sb = sa + BM * LS;
  const int tid = otid(), lane = tid & 63, w = tid >> 6, wm = w >> 1, wn = w & 1, r = lane & 31, h = lane >> 5;
  f32x16 acc[MI][NI];
#pragma unroll
  for (int mi = 0; mi < MI; ++mi)
#pragma unroll
    for (int ni = 0; ni < NI; ++ni)
#pragma unroll
      for (int i = 0; i < 16; ++i) acc[mi][ni][i] = 0.f;
  u32x4 ra0[CH], rb0[CH], ra1[CH], rb1[CH];
  const int KT = K / 64;
  const bf16_t* ag = A + (size_t)(tid >> 3) * lda + (tid & 7) * 8;
  const bf16_t* bg = Bt + (size_t)(tid >> 3) * ldb + (tid & 7) * 8;
  bf16_t* sa_w = sa + (tid >> 3) * LS + (tid & 7) * 8;
  bf16_t* sb_w = sb + (tid >> 3) * LS + (tid & 7) * 8;
#pragma unroll
  for (int i = 0; i < CH; ++i) { ra0[i] = *gptr((const u32x4*)(ag + (size_t)i * 32 * lda)); rb0[i] = *gptr((const u32x4*)(bg + (size_t)i * 32 * ldb)); }
#pragma unroll
  for (int i = 0; i < CH; ++i) { ra1[i] = *gptr((const u32x4*)(ag + (size_t)i * 32 * lda + 64)); rb1[i] = *gptr((const u32x4*)(bg + (size_t)i * 32 * ldb + 64)); }
  const bf16_t* a_s = sa + (wm * (BM / 2) + r) * LS + h * 8;
  const bf16_t* b_s = sb + (wn * (BN / 2) + r) * LS + h * 8;
#define PF2_COMPUTE()                                                                                  \
  {                                                                                                    \
    bf16x8 af[4][MI], bfr[4][NI];                                                                      \
    _Pragma("unroll") for (int ks = 0; ks < 4; ++ks) {                                                 \
      _Pragma("unroll") for (int mi = 0; mi < MI; ++mi) af[ks][mi] = *(const bf16x8*)(a_s + mi * 32 * LS + ks * 16);   \
      _Pragma("unroll") for (int ni = 0; ni < NI; ++ni) bfr[ks][ni] = *(const bf16x8*)(b_s + ni * 32 * LS + ks * 16);  \
    }                                                                                                  \
    __builtin_amdgcn_sched_barrier(0);     \
    _Pragma("unroll") for (int ks = 0; ks < 4; ++ks)                                                   \
      _Pragma("unroll") for (int mi = 0; mi < MI; ++mi)                                                \
        _Pragma("unroll") for (int ni = 0; ni < NI; ++ni)                                              \
          acc[mi][ni] = __builtin_amdgcn_mfma_f32_32x32x16_bf16(af[ks][mi], bfr[ks][ni], acc[mi][ni], 0, 0, 0);  \
    __builtin_amdgcn_sched_barrier(0);                                                                 \
  }
#pragma unroll 1
  for (int kt = 0; kt < KT; kt += 2) {
    __syncthreads();
#pragma unroll
    for (int i = 0; i < CH; ++i) { *(u32x4*)(sa_w + i * 32 * LS) = ra0[i]; *(u32x4*)(sb_w + i * 32 * LS) = rb0[i]; }
    __syncthreads();
    if (kt + 2 < KT) {
#pragma unroll
      for (int i = 0; i < CH; ++i) { ra0[i] = *gptr((const u32x4*)(ag + (size_t)i * 32 * lda + (kt + 2) * 64)); rb0[i] = *gptr((const u32x4*)(bg + (size_t)i * 32 * ldb + (kt + 2) * 64)); }
    }
    PF2_COMPUTE();
    __syncthreads();
#pragma unroll
    for (int i = 0; i < CH; ++i) { *(u32x4*)(sa_w + i * 32 * LS) = ra1[i]; *(u32x4*)(sb_w + i * 32 * LS) = rb1[i]; }
    __syncthreads();
    if (kt + 3 < KT) {
#pragma unroll
      for (int i = 0; i < CH; ++i) { ra1[i] = *gptr((const u32x4*)(ag + (size_t)i * 32 * lda + (kt + 3) * 64)); rb1[i] = *gptr((const u32x4*)(bg + (size_t)i * 32 * ldb + (kt + 3) * 64)); }
    }
    PF2_COMPUTE();
  }
#undef PF2_COMPUTE
#pragma unroll
  for (int mi = 0; mi < MI; ++mi)
#pragma unroll
    for (int ni = 0; ni < NI; ++ni) {
#pragma unroll
      for (int i = 0; i < 16; ++i) {
        int rr = wm * (BM / 2) + mi * 32 + (i & 3) + 8 * (i >> 2) + 4 * h;
        int cc = wn * (BN / 2) + ni * 32 + r;
        epi(rr, cc, acc[mi][ni][i]);
        if ((i & 3) == 3) __builtin_amdgcn_sched_barrier(0);
      }
    }
  __syncthreads();
}

DI bool xcd_tile(int k, int MT, int NT, int& mt, int& nt) {
  const int b = obid(), G = gridDim.x;
  if ((G & 7) == 0) {
    int xcd = b & 7, local = b >> 3, per = (MT >> 3) * NT, idx = local + k * (G >> 3);
    if (idx >= per) return false;
    mt = (idx / NT) * 8 + xcd; nt = idx % NT; return true;
  }
  int idx = b + k * G; if (idx >= MT * NT) return false;
  mt = idx / NT; nt = idx % NT; return true;
}

struct EpiG1 {
  float* proj; bf16_t* uvt; int m0, n0;
  DI void operator()(int r, int c, float v) const {
    int tok = m0 + r, n = n0 + c;
    if (n < 1536) gptr(proj)[(size_t)tok * PLD + n] = v;
    else if (n >= 2048) gptr(proj)[(size_t)tok * PLD + n - 512] = v;
    else {
      int cc = n - 1536; int part = cc >> 8, ch = cc & 255; int start, T; seq_of_tok(tok, start, T);
      gptr(uvt)[(size_t)512 * start + (size_t)ch * 2 * T + part * T + (tok - start)] = f2bf(v);
    }
  }
};
struct EpiStoreBf { bf16_t* dst; int ld; DI void operator()(int r, int c, float v) const { dst[(size_t)r * ld + c] = f2bf(v); } };
struct EpiStoreF { float* dst; int ld; DI void operator()(int r, int c, float v) const { gptr(dst)[(size_t)r * ld + c] = v; } };
struct EpiResid {
  float* x; const float* gate; int m0, n0;
  const float* xp; const float* xs;
  DI void operator()(int r, int c, float v) const {
    int tok = m0 + r, col = n0 + c; size_t i = (size_t)tok * DM + col;
    float xin = xp ? (tok < 4096 ? gptr(xp)[i] : gptr(xs)[i - (size_t)4096 * DM]) : gptr(x)[i];
    gptr(x)[i] = xin + gptr(gate)[cv_of_tok(tok) * 6144 + col] * v;
  }
};

struct EpiConvGate {
  bf16_t* act; const float* cw; const float* cb; int m0; int nt; bool ctx;
  DI void tile(f32x16 (&acc)[4][2], int wm, int wn, int r, int h, char* smem) const {
    const int j = nt * 64 + wn * 32 + r;
    float w0[2], w1[2], w2[2], bs[2];
#pragma unroll
    for (int ni = 0; ni < 2; ++ni) {
      int ch = ni * DFF + j;
      w0[ni] = gptr(cw)[ch]; w1[ni] = gptr(cw)[DUP + ch]; w2[ni] = gptr(cw)[2 * DUP + ch]; bs[ni] = gptr(cb)[ch];
    }
    float* edge = (float*)smem;
    __syncthreads();
#pragma unroll
    for (int ni = 0; ni < 2; ++ni) {
      if (h == 0) edge[((((wm * 2 + wn) * 2 + ni) * 2) + 0) * 32 + r] = acc[0][ni][0];
      else        edge[((((wm * 2 + wn) * 2 + ni) * 2) + 1) * 32 + r] = acc[3][ni][15];
    }
    __syncthreads();
    float up_edge[2], dn_edge[2];
#pragma unroll
    for (int ni = 0; ni < 2; ++ni) {
      float ue = edge[((((0 * 2 + wn) * 2 + ni) * 2) + 1) * 32 + r];
      float de = edge[((((1 * 2 + wn) * 2 + ni) * 2) + 0) * 32 + r];
      up_edge[ni] = (ctx && wm == 1) ? ue : 0.f;
      dn_edge[ni] = (ctx && wm == 0) ? de : 0.f;
    }
    float Bp[2][4], Tp[2][4];
#pragma unroll
    for (int ni = 0; ni < 2; ++ni)
#pragma unroll
      for (int mi = 0; mi < 4; ++mi) {
        Bp[ni][mi] = __shfl_xor(acc[mi][ni][15], 32, 64);
        Tp[ni][mi] = __shfl_xor(acc[mi][ni][0], 32, 64);
      }
#pragma unroll
    for (int mi = 0; mi < 4; ++mi) {
      float zc[2][16];
#pragma unroll
      for (int ni = 0; ni < 2; ++ni) {
        float prev_in = (mi == 0) ? up_edge[ni] : ((mi == 2 && !ctx) ? 0.f : Bp[ni][mi > 0 ? mi - 1 : 0]);
        float next_in = (mi == 3) ? dn_edge[ni] : ((mi == 1 && !ctx) ? 0.f : Tp[ni][mi < 3 ? mi + 1 : 3]);
        float rp[4], rn[4];
#pragma unroll
        for (int g = 0; g < 4; ++g) {
          float sp_ = (h == 0) ? acc[mi][ni][4 * g + 3] : acc[mi][ni][g > 0 ? 4 * g - 1 : 0];
          float sn_ = (h == 1) ? acc[mi][ni][4 * g] : acc[mi][ni][g < 3 ? 4 * g + 4 : 15];
          rp[g] = __shfl_xor(sp_, 32, 64);
          rn[g] = __shfl_xor(sn_, 32, 64);
        }
#pragma unroll
        for (int e = 0; e < 16; ++e) {
          const int g = e >> 2;
          float pv, nx;
          if ((e & 3) != 0) pv = acc[mi][ni][e - 1];
          else pv = (h == 1) ? rp[g] : (g > 0 ? rp[g] : prev_in);
          if ((e & 3) != 3) nx = acc[mi][ni][e + 1];
          else nx = (h == 0) ? rn[g] : (g < 3 ? rn[g] : next_in);
          zc[ni][e] = bs[ni] + w0[ni] * pv + w1[ni] * acc[mi][ni][e] + w2[ni] * nx;
        }
      }
#pragma unroll
      for (int e = 0; e < 16; ++e) {
        int row = m0 + wm * 128 + mi * 32 + (e & 3) + 8 * (e >> 2) + 4 * h;
        gptr(act)[(size_t)row * DFF + j] = f2bf(gelu_t(zc[0][e]) * zc[1][e]);
        if ((e & 3) == 3) __builtin_amdgcn_sched_barrier(0);
      }
    }
  }
};

DI void ph_convert_weights(const Params& p, int l, char* smem, bool skip_fold = false) {
  float(*tile)[65] = (float(*)[65])smem;
  float(*t1)[65] = (float(*)[65])(smem + 64 * 65 * 4);
  float(*t2)[65] = (float(*)[65])(smem + 2 * 64 * 65 * 4);
  float* tw = (float*)(smem + 3 * 64 * 65 * 4);
  const int tid = otid();
  constexpr int N_IT = 640 + 256 + 1408 + 704 + 16;
  for (int it = obid(); it < N_IT; it += gridDim.x) {
    const float* src; bf16_t* dst; int K, Nsrc, n0, k0, sc0, fold = -1; bool wup_perm = false;
    int j = it;
    if (j < 640) {
      int nt = j / 16, kt = j % 16; src = p.inp(I_WIN) + (size_t)l * 1024 * 2304; K = 1024; Nsrc = 2304; n0 = nt * 64; k0 = kt * 64;
      dst = (bf16_t*)(p.wsp() + OFF_WIN);
      if (n0 < 1536) sc0 = n0;
      else if (n0 < 2048) { int cc = n0 - 1536; fold = cc >> 8; sc0 = cc & 255; }
      else sc0 = n0 - 256;
    } else if ((j -= 640) < 256) {
      int nt = j / 16, kt = j % 16; src = p.inp(I_WOUT) + (size_t)l * 1024 * 1024; K = 1024; Nsrc = 1024; n0 = nt * 64; k0 = kt * 64; sc0 = n0;
      dst = (bf16_t*)(p.wsp() + OFF_WOUT);
    } else if ((j -= 256) < 1408) {
      int nt = j / 16, kt = j % 16; src = p.inp(I_WUP) + (size_t)l * 1024 * DUP; K = 1024; Nsrc = DUP; n0 = nt * 64; k0 = kt * 64; sc0 = n0;
      dst = (bf16_t*)(p.wsp() + OFF_WUP); wup_perm = true;
    } else if ((j -= 1408) < 704) {
      int nt = j / 44, kt = j % 44; src = p.inp(I_WDN) + (size_t)l * DFF * 1024; K = DFF; Nsrc = 1024; n0 = nt * 64; k0 = kt * 64; sc0 = n0;
      dst = (bf16_t*)(p.wsp() + OFF_WDN);
    } else {
      j -= 704; int nt = j / 4, kt = j % 4; src = p.inp(I_WGLU) + (size_t)l * 65536; K = 256; Nsrc = 256; n0 = nt * 64; k0 = kt * 64; sc0 = n0;
      dst = (bf16_t*)(p.wsp() + OFF_WGLU);
    }
    if (fold < 0) {
#pragma unroll
      for (int i = 0; i < 16; ++i) {
        int kk = (tid >> 6) + 4 * i, nn = tid & 63;
        int sc = sc0 + nn;
        if (wup_perm) sc = ((nn & 32) ? DFF : 0) + (n0 >> 7) * 64 + ((n0 >> 6) & 1) * 32 + (nn & 31);
        tile[kk][nn] = gptr(src)[(size_t)(k0 + kk) * Nsrc + sc];
      }
      __syncthreads();
#pragma unroll
      for (int i = 0; i < 16; ++i) {
        int kk = tid & 63, nn = (tid >> 6) + 4 * i;
        gptr(dst)[(size_t)(n0 + nn) * K + k0 + kk] = f2bf(tile[kk][nn]);
      }
      __syncthreads();
    } else if (!skip_fold) {
      const bf16_t* wf = (const bf16_t*)(p.wsp() + OFF_WFOLD) + (size_t)l * 512 * 1024;
#pragma unroll
      for (int i = 0; i < 16; ++i) {
        int kk = tid & 63, nn = (tid >> 6) + 4 * i;
        gptr(dst)[(size_t)(n0 + nn) * K + k0 + kk] = gptr(wf)[(size_t)(n0 - 1536 + nn) * 1024 + k0 + kk];
      }
      __syncthreads();
    }
  }
}

DI void ph_mu(const Params& p, char* smem) {
  float(*t1)[65] = (float(*)[65])smem;
  float* tw = (float*)(smem + 64 * 65 * 4);
  const int tid = otid();
  float* mu = (float*)(p.wsp() + OFF_MU);
  for (int it = obid(); it < 64; it += gridDim.x) {
    int ct = it & 3, hd = (it >> 2) & 3, part = (it >> 4) & 1, l = it >> 5;
    const float* fnw = p.inp(I_FNW) + (size_t)l * 65536;
    __syncthreads();
    if (tid < 64) tw[tid] = (part == 0) ? cospif((float)tid / 32.f) : sinpif((float)tid / 32.f);
#pragma unroll
    for (int i = 0; i < 16; ++i) { int rr = (tid >> 6) + 4 * i, cc = tid & 63; t1[rr][cc] = gptr(fnw)[(size_t)(hd * 64 + rr) * 256 + ct * 64 + cc]; }
    __syncthreads();
#pragma unroll 1
    for (int i = 0; i < 16; ++i) {
      int jj = (tid >> 6) + 4 * i, cc = tid & 63;
      float sacc = 0.f;
#pragma unroll 8
      for (int kk = 0; kk < 64; ++kk) sacc += tw[(jj * kk) & 63] * t1[kk][cc];
      gptr(mu)[((size_t)(l * 2 + part) * 256 + hd * 64 + jj) * 256 + ct * 64 + cc] = 0.125f * sacc;
    }
  }
  __syncthreads();
}
DI void ph_fold(const Params& p, char* smem) {
  float(*t0)[65] = (float(*)[65])smem;
  float(*t2)[65] = (float(*)[65])(smem + 64 * 65 * 4);
  const int tid = otid();
  const float* mu = (const float*)(p.wsp() + OFF_MU);
  bf16_t* wf = (bf16_t*)(p.wsp() + OFF_WFOLD);
  for (int it = obid(); it < 256; it += gridDim.x) {
    int ct = it & 3, kt = (it >> 2) & 15, part = (it >> 6) & 1, l = it >> 7;
    const float* src = p.inp(I_WIN) + (size_t)l * 1024 * 2304;
    float acc[16];
#pragma unroll
    for (int i = 0; i < 16; ++i) acc[i] = 0.f;
#pragma unroll 1
    for (int hd = 0; hd < 4; ++hd) {
      __syncthreads();
#pragma unroll
      for (int i = 0; i < 16; ++i) {
        int rr = (tid >> 6) + 4 * i, cc = tid & 63;
        t0[rr][cc] = gptr(src)[(size_t)(kt * 64 + rr) * 2304 + 1536 + hd * 64 + cc];
        t2[rr][cc] = gptr(mu)[((size_t)(l * 2 + part) * 256 + hd * 64 + rr) * 256 + ct * 64 + cc];
      }
      __syncthreads();
      const int kk = tid & 63;
#pragma unroll 2
      for (int jj = 0; jj < 64; ++jj) {
        float a = t0[kk][jj];
#pragma unroll
        for (int i = 0; i < 16; ++i) acc[i] += a * t2[jj][(tid >> 6) + 4 * i];
      }
    }
#pragma unroll
    for (int i = 0; i < 16; ++i) {
      int kk = tid & 63, nn = (tid >> 6) + 4 * i;
      gptr(wf)[((size_t)l * 512 + part * 256 + ct * 64 + nn) * 1024 + kt * 64 + kk] = f2bf(acc[i]);
    }
  }
  __syncthreads();
}

DI void ph_fold_copy(const Params& p, int l) {
  const int gtid = obid() * 256 + otid(), gsz = gridDim.x * 256;
  const u32x4* src = (const u32x4*)(p.wsp() + OFF_WFOLD + (size_t)l * 512 * 1024 * 2);
  u32x4* dst = (u32x4*)(p.wsp() + OFF_WIN + (size_t)1536 * 1024 * 2);
  for (int e = gtid; e < 512 * 1024 / 8; e += gsz) dst[e] = src[e];
}

DI void ph_prep(const Params& p, char* smem) {
  const int tid = otid();
  ph_convert_weights(p, 0, smem, true);
  {
    float* sl = (float*)smem;
    float* red = sl + 192;
    float* adap = (float*)(p.wsp() + OFF_ADAP);
    for (int it = obid(); it < 2 * 24 * NKC; it += gridDim.x) {
      int kc = it % NKC, nc = (it / NKC) % 24, l = it / (NKC * 24);
      if (tid < 192) {
        int cv = tid >> 6, kk = tid & 63; int k = kc * 64 + kk;
        float cval = (cv == 0) ? p.inp(I_CCTX)[k] : p.inp(I_C)[(cv - 1) * 1024 + k];
        sl[tid] = silu_f(cval);
      }
      __syncthreads();
      int rg = tid >> 6, lane = tid & 63;
      float a0[4] = {0, 0, 0, 0}, a1[4] = {0, 0, 0, 0}, a2[4] = {0, 0, 0, 0};
      const float* wsrc = p.inp(I_WADA) + (size_t)l * 1024 * 6144 + nc * 256 + lane * 4;
#pragma unroll 4
      for (int i = 0; i < 16; ++i) {
        int kk = rg * 16 + i;
        float4 wv = ldg4(wsrc + (size_t)(kc * 64 + kk) * 6144);
        float s0 = sl[kk], s1 = sl[64 + kk], s2 = sl[128 + kk];
        a0[0] += s0 * wv.x; a0[1] += s0 * wv.y; a0[2] += s0 * wv.z; a0[3] += s0 * wv.w;
        a1[0] += s1 * wv.x; a1[1] += s1 * wv.y; a1[2] += s1 * wv.z; a1[3] += s1 * wv.w;
        a2[0] += s2 * wv.x; a2[1] += s2 * wv.y; a2[2] += s2 * wv.z; a2[3] += s2 * wv.w;
      }
#pragma unroll
      for (int q = 0; q < 4; ++q) {
        red[(rg * 3 + 0) * 256 + lane * 4 + q] = a0[q];
        red[(rg * 3 + 1) * 256 + lane * 4 + q] = a1[q];
        red[(rg * 3 + 2) * 256 + lane * 4 + q] = a2[q];
      }
      __syncthreads();
#pragma unroll
      for (int cv = 0; cv < 3; ++cv) {
        float s = red[(0 * 3 + cv) * 256 + tid] + red[(1 * 3 + cv) * 256 + tid] + red[(2 * 3 + cv) * 256 + tid] + red[(3 * 3 + cv) * 256 + tid];
        adap[((size_t)(kc * 2 + l) * 3 + cv) * 6144 + nc * 256 + tid] = s;
      }
      __syncthreads();
    }
  }
  const int gtid = obid() * 256 + tid, gsz = gridDim.x * 256;
  {
    float* s5a = (float*)(p.wsp() + OFF_S5A); float* s5al = (float*)(p.wsp() + OFF_S5AL);
    float* bbr = (float*)(p.wsp() + OFF_S5BBR); float* bbi = (float*)(p.wsp() + OFF_S5BBI);
    for (int e = gtid; e < 4096 * 16; e += gsz) {
      int idx = e >> 4, pp = e & 15;
      float lr = fminf(p.inp(I_LAMRE)[idx], -1e-4f), li = p.inp(I_LAMIM)[idx];
      float dt = expf(p.inp(I_LOGDT)[idx >> 6]);
      float mag = expf(lr * dt), ang = li * dt;
      float are = mag * cosf(ang), aim = mag * sinf(ang);
      float den = lr * lr + li * li, xr = are - 1.f;
      float zre = (xr * lr + aim * li) / den, zim = (aim * lr - xr * li) / den;
      float br = p.inp(I_BRE)[e], bi = p.inp(I_BIM)[e];
      bbr[e] = zre * br - zim * bi;
      bbi[e] = zre * bi + zim * br;
      if (pp == 0) {
        s5a[idx * 2] = are; s5a[idx * 2 + 1] = aim;
        float pr = are, pi = aim;
#pragma unroll
        for (int q = 0; q < 5; ++q) { float nr = pr * pr - pi * pi, ni = 2.f * pr * pi; pr = nr; pi = ni; }
        s5al[idx * 2] = pr; s5al[idx * 2 + 1] = pi;
      }
    }
  }
  {
    bf16_t* cmt = (bf16_t*)(p.wsp() + OFF_CMT);
    for (int e = gtid; e < 2 * 2 * 16 * 16 * 128; e += gsz) {
      int k = e & 127, row = e >> 7; int n = k >> 1;
      float v = (k & 1) ? -p.inp(I_CIM)[(size_t)row * 64 + n] : p.inp(I_CRE)[(size_t)row * 64 + n];
      cmt[e] = f2bf(v);
    }
    bf16_t* wsb = (bf16_t*)(p.wsp() + OFF_WSB);
    for (int e = gtid; e < 2 * 4 * 128 * 128; e += gsz) wsb[e] = f2bf(p.inp(I_GMWS)[e]);
  }
  {
    float* ctab = (float*)smem; float* stab = ctab + 2048;
    __syncthreads();
    for (int m = tid; m < 2048; m += 256) { float a = (float)m / 1024.f; ctab[m] = cospif(a) * 0.02209708691207961f; stab[m] = -sinpif(a) * 0.02209708691207961f; }
    __syncthreads();
    bf16_t* dl = (bf16_t*)(p.wsp() + OFF_DFTL);
    for (int e = gtid; e < 2048 * 256; e += gsz) {
      int t = e >> 8, s0 = (e & 255) * 8;
      float c[8], sn[8];
#pragma unroll
      for (int q = 0; q < 8; ++q) { int m = (t * (s0 + q)) & 2047; c[q] = ctab[m]; sn[q] = stab[m]; }
      *(bf16x8*)(dl + (size_t)t * 4096 + s0) = pack8(c[0], c[1], c[2], c[3], c[4], c[5], c[6], c[7]);
      *(bf16x8*)(dl + (size_t)t * 4096 + 2048 + s0) = pack8(sn[0], sn[1], sn[2], sn[3], sn[4], sn[5], sn[6], sn[7]);
    }
    bf16_t* dc = (bf16_t*)(p.wsp() + OFF_DFTC);
    const float rs = 0.0625f / 0.02209708691207961f;
    for (int e = gtid; e < 256 * 256; e += gsz) {
      int t = e >> 8, s2 = e & 255; int m = ((t * s2) & 255) * 8;
      dc[t * 512 + s2] = f2bf(ctab[m] * rs);
      dc[t * 512 + 256 + s2] = f2bf(stab[m] * rs);
    }
    __syncthreads();
  }
}

DI void ph_mod_reduce(const Params& p) {
  const int gtid = obid() * 256 + otid(), gsz = gridDim.x * 256;
  const float* adap = (const float*)(p.wsp() + OFF_ADAP); float* mod = (float*)(p.wsp() + OFF_MOD);
  for (int e = gtid; e < 2 * 3 * 6144; e += gsz) {
    int n = e % 6144, l = e / (3 * 6144);
    float s = p.inp(I_BADA)[l * 6144 + n];
    for (int kc = 0; kc < NKC; ++kc) s += gptr(adap)[(size_t)kc * 2 * 3 * 6144 + e];
    mod[e] = s;
  }
}

DI void ph_norm_mod(const Params& p, int l, const float* gnorm, int sh_off, int sc_off, bool from_input = false) {
  const int tid_ = otid(); const int lane = tid_ & 63, w = tid_ >> 6;
  const float* x = (const float*)(p.wsp() + OFF_X); bf16_t* hb = (bf16_t*)(p.wsp() + OFF_H);
  const float* mod = (const float*)(p.wsp() + OFF_MOD) + (size_t)l * 3 * 6144;
  for (int tok = obid() * 4 + w; tok < NTOK; tok += gridDim.x * 4) {
    const float* xr = from_input ? (tok < 4096 ? p.inp(I_XP) + (size_t)tok * DM : p.inp(I_XS) + (size_t)(tok - 4096) * DM) : x + (size_t)tok * DM;
    float4 v[4]; float ss = 0.f;
#pragma unroll
    for (int i = 0; i < 4; ++i) { v[i] = ldg4(xr + i * 256 + lane * 4); ss += v[i].x * v[i].x + v[i].y * v[i].y + v[i].z * v[i].z + v[i].w * v[i].w; }
    ss = wave_sum(ss);
    float rstd = rsqrtf(ss * (1.f / 1024.f) + EPSF);
    const float* mm = mod + cv_of_tok(tok) * 6144;
#pragma unroll
    for (int i = 0; i < 4; ++i) {
      int col = i * 256 + lane * 4;
      float4 g = ldg4(gnorm + col); float4 sc = ldg4(mm + sc_off + col); float4 sh = ldg4(mm + sh_off + col);
      ushort4 o;
      o.x = f2bf(v[i].x * rstd * g.x * (1.f + sc.x) + sh.x);
      o.y = f2bf(v[i].y * rstd * g.y * (1.f + sc.y) + sh.y);
      o.z = f2bf(v[i].z * rstd * g.z * (1.f + sc.z) + sh.z);
      o.w = f2bf(v[i].w * rstd * g.w * (1.f + sc.w) + sh.w);
      stg_us4(hb + (size_t)tok * DM + col, o);
    }
  }
}

DI void ph_final_norm(const Params& p) {
  const int tid_ = otid(); const int lane = tid_ & 63, w = tid_ >> 6;
  const float* x = (const float*)(p.wsp() + OFF_X);
  const float* g = p.inp(I_FING);
  for (int tok = obid() * 4 + w; tok < NTOK; tok += gridDim.x * 4) {
    const float* xr = x + (size_t)tok * DM;
    float4 v[4]; float ss = 0.f;
#pragma unroll
    for (int i = 0; i < 4; ++i) { v[i] = ldg4(xr + i * 256 + lane * 4); ss += v[i].x * v[i].x + v[i].y * v[i].y + v[i].z * v[i].z + v[i].w * v[i].w; }
    ss = wave_sum(ss);
    float rstd = rsqrtf(ss * (1.f / 1024.f) + EPSF);
#pragma unroll
    for (int i = 0; i < 4; ++i) {
      int col = i * 256 + lane * 4; float4 gg = ldg4(g + col);
      float4 o; o.x = v[i].x * rstd * gg.x; o.y = v[i].y * rstd * gg.y; o.z = v[i].z * rstd * gg.z; o.w = v[i].w * rstd * gg.w;
      stg4(p.outp() + (size_t)tok * DM + col, o);
    }
  }
}

DI void ph_gemm_in(const Params& p, char* smem) {
  const bf16_t* A = (const bf16_t*)(p.wsp() + OFF_H); const bf16_t* Bt = (const bf16_t*)(p.wsp() + OFF_WIN);
  int mt, nt;
  for (int k = 0; xcd_tile(k, 64, 20, mt, nt); ++k) {
    EpiG1 epi{(float*)(p.wsp() + OFF_PROJ), (bf16_t*)(p.wsp() + OFF_UVT), mt * 128, nt * 128};
    gemm_tile64_pf2(A + (size_t)mt * 128 * 1024, 1024, Bt + (size_t)nt * 128 * 1024, 1024, 1024, smem, epi);
  }
}
DI void ph_gemm_out(const Params& p, int l, char* smem) {
  int mt, nt;
  for (int k = 0; xcd_tile(k, 64, 8, mt, nt); ++k) {
    EpiResid epi{(float*)(p.wsp() + OFF_X), (const float*)(p.wsp() + OFF_MOD) + (size_t)l * 3 * 6144 + 2048, mt * 128, nt * 128, l == 0 ? p.inp(I_XP) : nullptr, l == 0 ? p.inp(I_XS) : nullptr};
    gemm_tile64_pf2((const bf16_t*)(p.wsp() + OFF_H) + (size_t)mt * 128 * 1024, 1024, (const bf16_t*)(p.wsp() + OFF_WOUT) + (size_t)nt * 128 * 1024, 1024, 1024, smem, epi);
  }
}
DI void ph_gemm_up(const Params& p, int l, char* smem) {
  int mt, nt;
  for (int k = 0; xcd_tile(k, 32, 44, mt, nt); ++k) {
    EpiConvGate epi{(bf16_t*)(p.wsp() + OFF_ACT), p.inp(I_CONVW) + (size_t)l * 3 * DUP, p.inp(I_CONVB) + (size_t)l * DUP, mt * 256, nt, mt < 16};
    gemm_tile64<256, 128, EpiConvGate, true>((const bf16_t*)(p.wsp() + OFF_H) + (size_t)mt * 256 * 1024, 1024, (const bf16_t*)(p.wsp() + OFF_WUP) + (size_t)nt * 128 * 1024, 1024, 1024, smem, epi);
  }
}
DI void ph_gemm_down(const Params& p, int l, char* smem) {
  int mt, nt;
  for (int k = 0; xcd_tile(k, 64, 8, mt, nt); ++k) {
    EpiResid epi{(float*)(p.wsp() + OFF_X), (const float*)(p.wsp() + OFF_MOD) + (size_t)l * 3 * 6144 + 5120, mt * 128, nt * 128, nullptr, nullptr};
    gemm_tile64_pf2((const bf16_t*)(p.wsp() + OFF_ACT) + (size_t)mt * 128 * DFF, DFF, (const bf16_t*)(p.wsp() + OFF_WDN) + (size_t)nt * 128 * DFF, DFF, DFF, smem, epi);
  }
}

DI void ph_scans(const Params& p, int l) {
  const int gtid = obid() * 256 + otid(), gsz = gridDim.x * 256;
  {
    float* hgs = (float*)(p.wsp() + OFF_HGS); const float* hgg = (const float*)(p.wsp() + OFF_HGG);
    for (int e = gtid; e < 18 * 2 * 4 * 4096; e += gsz) {
      int k = e & 63, v = (e >> 6) & 63, hd = (e >> 12) & 3, d = (e >> 14) & 1, seq = e >> 15;
      int start, T; seq_info(seq, start, T);
      int nc = T >> 5, cb = start >> 5;
      float S = 0.f;
      if (seq >= 16) S = p.inp(I_HGST)[((((size_t)(seq - 16) * 2 + l) * 2 + d) * 4 + hd) * 4096 + k * 64 + v];
      for (int s0 = 0; s0 < nc; s0 += 8) {
        float tv[8], gv[8];
#pragma unroll
        for (int u = 0; u < 8; ++u) {
          int s = s0 + u; int cc = d ? nc - 1 - s : s; size_t idx = (size_t)((cb + cc) * 2 + d) * 4 + hd;
          tv[u] = gptr(hgs)[idx * 4096 + v * 64 + k]; gv[u] = gptr(hgg)[idx * 64 + k];
        }
#pragma unroll
        for (int u = 0; u < 8; ++u) {
          int s = s0 + u; int cc = d ? nc - 1 - s : s; size_t idx = (size_t)((cb + cc) * 2 + d) * 4 + hd;
          gptr(hgs)[idx * 4096 + v * 64 + k] = S;
          S = gv[u] * S + tv[u];
        }
      }
      if (seq < 16) p.outp()[OUT_HG + ((((size_t)seq * 2 + l) * 2 + d) * 4 + hd) * 4096 + k * 64 + v] = S;
    }
  }
  {
    const float* s5e = (const float*)(p.wsp() + OFF_S5E); float* s5h = (float*)(p.wsp() + OFF_S5H);
    const float* s5al = (const float*)(p.wsp() + OFF_S5AL);
    for (int e = gtid; e < 18 * 2 * 16 * 64; e += gsz) {
      int n = e & 63, g = (e >> 6) & 15, d = (e >> 10) & 1, seq = e >> 11;
      int start, T; seq_info(seq, start, T);
      int nc = T >> 5, cb = start >> 5;
      int pidx = ((l * 2 + d) * 16 + g) * 64 + n;
      float ar = s5al[pidx * 2], ai = s5al[pidx * 2 + 1];
      float hr = 0.f, hi = 0.f;
      if (seq >= 16) {
        size_t si = ((((size_t)(seq - 16) * 2 + l) * 2 + d) * 16 + g) * 64 + n;
        hr = p.inp(I_S5RE)[si]; hi = p.inp(I_S5IM)[si];
      }
      for (int s0 = 0; s0 < nc; s0 += 8) {
        float er[8], ei[8];
#pragma unroll
        for (int u = 0; u < 8; ++u) {
          int s = s0 + u; int cc = d ? nc - 1 - s : s; size_t idx = ((size_t)(((cb + cc) * 2 + d) * 16 + g) * 64 + n) * 2;
          er[u] = gptr(s5e)[idx]; ei[u] = gptr(s5e)[idx + 1];
        }
#pragma unroll
        for (int u = 0; u < 8; ++u) {
          int s = s0 + u; int cc = d ? nc - 1 - s : s; size_t idx = ((size_t)(((cb + cc) * 2 + d) * 16 + g) * 64 + n) * 2;
          gptr(s5h)[idx] = hr; gptr(s5h)[idx + 1] = hi;
          float nr = ar * hr - ai * hi + er[u], ni = ar * hi + ai * hr + ei[u];
          hr = nr; hi = ni;
        }
      }
      if (seq < 16) {
        size_t oi = ((((size_t)seq * 2 + l) * 2 + d) * 16 + g) * 64 + n;
        p.outp()[OUT_S5RE + oi] = hr; p.outp()[OUT_S5IM + oi] = hi;
      }
    }
  }
}

constexpr int HS5 = 136;
DI void s5_stage_u(const float* up, int lane, float* ub) {
  const float* src = up + (size_t)(lane >> 1) * PLD + (lane & 1) * 8;
  f32x4 a = *gptr((const f32x4*)src), b = *gptr((const f32x4*)(src + 4));
  *(f32x4*)(ub + lane * 8) = a; *(f32x4*)(ub + lane * 8 + 4) = b;
}
template <bool WRITE_H>
DI void s5_scan(const float* ub, float are, float aim, const float (&br)[16], const float (&bi)[16], int d, int lane, float& hr, float& hi, bf16_t* HB) {
#pragma unroll 4
  for (int s = 0; s < 32; ++s) {
    const int j = d ? 31 - s : s;
    const float4* u4 = (const float4*)(ub + j * 16);
    float4 u0 = u4[0], u1 = u4[1], u2 = u4[2], u3 = u4[3];
    float ur0 = br[0] * u0.x, ur1 = br[4] * u1.x, ur2 = br[8] * u2.x, ur3 = br[12] * u3.x;
    float ui0 = bi[0] * u0.x, ui1 = bi[4] * u1.x, ui2 = bi[8] * u2.x, ui3 = bi[12] * u3.x;
    ur0 += br[1] * u0.y; ur1 += br[5] * u1.y; ur2 += br[9] * u2.y; ur3 += br[13] * u3.y;
    ui0 += bi[1] * u0.y; ui1 += bi[5] * u1.y; ui2 += bi[9] * u2.y; ui3 += bi[13] * u3.y;
    ur0 += br[2] * u0.z; ur1 += br[6] * u1.z; ur2 += br[10] * u2.z; ur3 += br[14] * u3.z;
    ui0 += bi[2] * u0.z; ui1 += bi[6] * u1.z; ui2 += bi[10] * u2.z; ui3 += bi[14] * u3.z;
    ur0 += br[3] * u0.w; ur1 += br[7] * u1.w; ur2 += br[11] * u2.w; ur3 += br[15] * u3.w;
    ui0 += bi[3] * u0.w; ui1 += bi[7] * u1.w; ui2 += bi[11] * u2.w; ui3 += bi[15] * u3.w;
    float ur = (ur0 + ur1) + (ur2 + ur3), ui = (ui0 + ui1) + (ui2 + ui3);
    float nr = are * hr - aim * hi + ur, ni = are * hi + aim * hr + ui;
    hr = nr; hi = ni;
    if (WRITE_H) *(unsigned*)(HB + j * HS5 + lane * 2) = pack_bf2(hr, hi);
  }
}

DI void ph_s5_local(const Params& p, int l, char* smem) {
  const int tid = otid(), lane = tid & 63, w = tid >> 6;
  float* ub = (float*)(smem + w * 11264);
  bf16_t* HB = (bf16_t*)(smem + w * 11264 + 2048);
  const float* proj = (const float*)(p.wsp() + OFF_PROJ);
  const float* s5a = (const float*)(p.wsp() + OFF_S5A); const float* bbr = (const float*)(p.wsp() + OFF_S5BBR); const float* bbi = (const float*)(p.wsp() + OFF_S5BBI);
  float* s5e = (float*)(p.wsp() + OFF_S5E);
  float* yloc = (float*)(p.wsp() + OFF_YLOC);
  const bf16_t* cmt = (const bf16_t*)(p.wsp() + OFF_CMT);
  const int row16 = lane & 15, quad = lane >> 4;
  for (int wi = obid() * 4 + w; wi < 8192; wi += gridDim.x * 4) {
    int g = wi & 15, d = (wi >> 4) & 1, c = wi >> 5;
    int pidx = ((l * 2 + d) * 16 + g) * 64 + lane;
    float hr = 0.f, hi = 0.f;
    const float are = gptr(s5a)[pidx * 2], aim = gptr(s5a)[pidx * 2 + 1];
    float br[16], bi[16];
#pragma unroll
    for (int q = 0; q < 4; ++q) {
      f32x4 t = *gptr((const f32x4*)(bbr + (size_t)pidx * 16 + q * 4)); br[q * 4] = t[0]; br[q * 4 + 1] = t[1]; br[q * 4 + 2] = t[2]; br[q * 4 + 3] = t[3];
      f32x4 u = *gptr((const f32x4*)(bbi + (size_t)pidx * 16 + q * 4)); bi[q * 4] = u[0]; bi[q * 4 + 1] = u[1]; bi[q * 4 + 2] = u[2]; bi[q * 4 + 3] = u[3];
    }
    const bf16_t* cb = cmt + ((size_t)(((l * 2 + d) * 16 + g) * 16 + row16)) * 128 + quad * 8;
    bf16x8 bbv[4];
#pragma unroll
    for (int ks = 0; ks < 4; ++ks) bbv[ks] = *gptr((const bf16x8*)(cb + ks * 32));
    LDS_FENCE();
    s5_stage_u(proj + (size_t)(c * 32) * PLD + PC_XA + g * 16, lane, ub);
    LDS_FENCE();
    s5_scan<true>(ub, are, aim, br, bi, d, lane, hr, hi, HB);
    size_t eo = ((size_t)((c * 2 + d) * 16 + g) * 64 + lane) * 2;
    gptr(s5e)[eo] = hr; gptr(s5e)[eo + 1] = hi;
    LDS_FENCE();
    f32x4 yacc[2];
#pragma unroll
    for (int mt = 0; mt < 2; ++mt) { yacc[mt][0] = 0.f; yacc[mt][1] = 0.f; yacc[mt][2] = 0.f; yacc[mt][3] = 0.f; }
#pragma unroll
    for (int ks = 0; ks < 4; ++ks) {
#pragma unroll
      for (int mt = 0; mt < 2; ++mt) {
        bf16x8 a = *(const bf16x8*)(HB + (mt * 16 + row16) * HS5 + ks * 32 + quad * 8);
        yacc[mt] = __builtin_amdgcn_mfma_f32_16x16x32_bf16(a, bbv[ks], yacc[mt], 0, 0, 0);
      }
    }
#pragma unroll
    for (int mt = 0; mt < 2; ++mt)
#pragma unroll
      for (int i = 0; i < 4; ++i)
        gptr(yloc)[((size_t)d * NTOK + c * 32 + mt * 16 + quad * 4 + i) * 256 + g * 16 + row16] = yacc[mt][i];
  }
}

DI void s5_out_task(const Params& p, int l, int c, char* smem) {
  const int tid = otid(), lane = tid & 63, w = tid >> 6;
  bf16_t* HB = (bf16_t*)(smem + w * 8704);
  bf16_t* Y5 = (bf16_t*)(smem + 4 * 8704);
  float* red = (float*)(smem + 4 * 8704 + 32 * 264 * 2);
  const float* proj = (const float*)(p.wsp() + OFF_PROJ);
  const float* s5a = (const float*)(p.wsp() + OFF_S5A);
  const float* s5h = (const float*)(p.wsp() + OFF_S5H);
  const bf16_t* cmt = (const bf16_t*)(p.wsp() + OFF_CMT);
  const float* yloc = (const float*)(p.wsp() + OFF_YLOC);
  const int row16 = lane & 15, quad = lane >> 4;
  float are[8], aim[8], hr0[8], hi0[8];
#pragma unroll
  for (int q = 0; q < 8; ++q) {
    const int g = w * 4 + (q >> 1), d = q & 1;
    const int pidx = ((l * 2 + d) * 16 + g) * 64 + lane;
    const size_t ho = ((size_t)((c * 2 + d) * 16 + g) * 64 + lane) * 2;
    are[q] = gptr(s5a)[pidx * 2]; aim[q] = gptr(s5a)[pidx * 2 + 1];
    hr0[q] = gptr(s5h)[ho]; hi0[q] = gptr(s5h)[ho + 1];
  }
#pragma unroll
  for (int gq = 0; gq < 4; ++gq) {
    const int g = w * 4 + gq;
    float yl[8], xav[8];
#pragma unroll
    for (int mt = 0; mt < 2; ++mt)
#pragma unroll
      for (int i = 0; i < 4; ++i) {
        const int tl = mt * 16 + quad * 4 + i;
        const size_t yo = (size_t)(c * 32 + tl) * 256 + g * 16 + row16;
        yl[mt * 4 + i] = gptr(yloc)[yo] + gptr(yloc)[(size_t)NTOK * 256 + yo];
        xav[mt * 4 + i] = gptr(proj)[(size_t)(c * 32 + tl) * PLD + PC_XA + g * 16 + row16];
      }
    const float dsk = gptr(p.inp(I_S5D))[l * 256 + g * 16 + row16];
    f32x4 yacc[2];
#pragma unroll
    for (int mt = 0; mt < 2; ++mt) { yacc[mt][0] = 0.f; yacc[mt][1] = 0.f; yacc[mt][2] = 0.f; yacc[mt][3] = 0.f; }
#pragma unroll
    for (int d = 0; d < 2; ++d) {
      const bf16_t* cb = cmt + ((size_t)(((l * 2 + d) * 16 + g) * 16 + row16)) * 128 + quad * 8;
      bf16x8 bb[4];
#pragma unroll
      for (int ks = 0; ks < 4; ++ks) bb[ks] = *gptr((const bf16x8*)(cb + ks * 32));
      const float ar = are[gq * 2 + d], ai = aim[gq * 2 + d];
      float pr = hr0[gq * 2 + d], pi = hi0[gq * 2 + d];
      LDS_FENCE();
#pragma unroll 8
      for (int sft = 0; sft < 32; ++sft) {
        const int j = d ? 31 - sft : sft;
        float nr = ar * pr - ai * pi, ni = ar * pi + ai * pr;
        pr = nr; pi = ni;
        *(unsigned*)(HB + j * HS5 + lane * 2) = pack_bf2(pr, pi);
      }
      LDS_FENCE();
#pragma unroll
      for (int ks = 0; ks < 4; ++ks) {
#pragma unroll
        for (int mt = 0; mt < 2; ++mt) {
          bf16x8 a = *(const bf16x8*)(HB + (mt * 16 + row16) * HS5 + ks * 32 + quad * 8);
          yacc[mt] = __builtin_amdgcn_mfma_f32_16x16x32_bf16(a, bb[ks], yacc[mt], 0, 0, 0);
        }
      }
    }
    LDS_FENCE();
#pragma unroll
    for (int mt = 0; mt < 2; ++mt)
#pragma unroll
      for (int i = 0; i < 4; ++i) {
        int tl = mt * 16 + quad * 4 + i;
        float y = gelu_t(yacc[mt][i] + yl[mt * 4 + i] + dsk * xav[mt * 4 + i]);
        Y5[tl * 264 + g * 16 + row16] = f2bf(y);
      }
  }
  __syncthreads();
  const int r = lane & 31, h = lane >> 5;
  f32x16 acc[2];
#pragma unroll
  for (int nt = 0; nt < 2; ++nt)
#pragma unroll
    for (int i = 0; i < 16; ++i) acc[nt][i] = 0.f;
  const bf16_t* wg = (const bf16_t*)(p.wsp() + OFF_WGLU);
#pragma unroll 8
  for (int ks = 0; ks < 16; ++ks) {
    bf16x8 a = *(const bf16x8*)(Y5 + r * 264 + ks * 16 + h * 8);
#pragma unroll
    for (int nt = 0; nt < 2; ++nt) {
      bf16x8 b = *gptr((const bf16x8*)(wg + (size_t)(w * 64 + nt * 32 + r) * 256 + ks * 16 + h * 8));
      acc[nt] = __builtin_amdgcn_mfma_f32_32x32x16_bf16(a, b, acc[nt], 0, 0, 0);
    }
  }
#pragma unroll
  for (int i = 0; i < 16; ++i) {
    int tl = (i & 3) + 8 * (i >> 2) + 4 * h;
    float s = 0.f;
#pragma unroll
    for (int nt = 0; nt < 2; ++nt) { float v = bf2f(Y5[tl * 264 + w * 64 + nt * 32 + r]) * sigm(acc[nt][i]); acc[nt][i] = v; s += v * v; }
#pragma unroll
    for (int o = 16; o > 0; o >>= 1) s += __shfl_xor(s, o, 64);
    if (r == 0) red[w * 32 + tl] = s;
  }
  __syncthreads();
  bf16_t* cat = (bf16_t*)(p.wsp() + OFF_H);
#pragma unroll
  for (int i = 0; i < 16; ++i) {
    int tl = (i & 3) + 8 * (i >> 2) + 4 * h;
    float tot = red[tl] + red[32 + tl] + red[64 + tl] + red[96 + tl];
    float rstd = rsqrtf(tot * (1.f / 256.f) + EPSF);
#pragma unroll
    for (int nt = 0; nt < 2; ++nt) {
      int ch = w * 64 + nt * 32 + r;
      gptr(cat)[(size_t)(c * 32 + tl) * DM + ch] = f2bf(acc[nt][i] * rstd * gptr(p.inp(I_GRPG))[l * 1024 + ch]);
    }
  }
  __syncthreads();
}

DI void hg_gate_vals(float z, float lb, float& lf, float& kv) {
  float e = __expf(-fabsf(z));
  float inv = frcp(1.f + e);
  float sg = (z >= 0.f) ? inv : e * inv;
  float sn = (z >= 0.f) ? e * inv : inv;
  lf = (lb == 0.f) ? (fminf(z, 0.f) - __logf(1.f + e)) : __logf(lb + (1.f - lb) * sg);
  kv = (1.f - lb) * sn;
}
DI float hg_lb(const Params& p, int l, int d, int ch) {
  if (l == 0) return 0.f;
  float x0 = p.inp(I_LBLOG)[(0 * 2 + d) * 256 + ch], x1 = p.inp(I_LBLOG)[(1 * 2 + d) * 256 + ch];
  return 1.f / (1.f + expf(x0 - x1));
}
DI void hg_build_vt(const float* proj, int c, int hd, int lane, bf16_t* Vt) {
#pragma unroll
  for (int j0 = 0; j0 < 32; j0 += 8) {
    float v[8];
#pragma unroll
    for (int q = 0; q < 8; ++q) v[q] = gptr(proj)[(size_t)(c * 32 + j0 + q) * PLD + PC_V + hd * 64 + lane];
    *(bf16x8*)(Vt + lane * 40 + j0) = pack8(v[0], v[1], v[2], v[3], v[4], v[5], v[6], v[7]);
  }
}

DI void ph_hg_local(const Params& p, int l, char* smem) {
  const int tid = otid(), lane = tid & 63, w = tid >> 6, r = lane & 31, h = lane >> 5;
  bf16_t* Vt = (bf16_t*)(smem + w * 11264);
  bf16_t* KhT = Vt + 64 * 40;
  const float* proj = (const float*)(p.wsp() + OFF_PROJ);
  float* hgs = (float*)(p.wsp() + OFF_HGS); float* hgg = (float*)(p.wsp() + OFF_HGG);
  for (int wi = obid() * 4 + w; wi < 2048; wi += gridDim.x * 4) {
    int hd = wi & 3, d = (wi >> 2) & 1, c = wi >> 3;
    hg_build_vt(proj, c, hd, lane, Vt);
    const float lb = hg_lb(p, l, d, hd * 64 + lane);
    float bcs[32], kvs[32];
    float run = 0.f;
#pragma unroll
    for (int s = 0; s < 32; ++s) {
      int j = d ? 31 - s : s;
      float z = gptr(proj)[(size_t)(c * 32 + j) * PLD + PC_ZF + d * 256 + hd * 64 + lane];
      float lf, kv; hg_gate_vals(z, lb, lf, kv);
      run += lf; bcs[s] = run; kvs[s] = kv;
    }
    const float blast = run;
#pragma unroll
    for (int j0 = 0; j0 < 32; j0 += 8) {
      float kh[8];
#pragma unroll
      for (int q = 0; q < 8; ++q) {
        int j = j0 + q;
        float b = d ? bcs[31 - j] : bcs[j];
        float kk = d ? kvs[31 - j] : kvs[j];
        kh[q] = kk * __expf(blast - b);
      }
      *(bf16x8*)(KhT + lane * 40 + j0) = pack8(kh[0], kh[1], kh[2], kh[3], kh[4], kh[5], kh[6], kh[7]);
    }
    hgg[(size_t)wi * 64 + lane] = __expf(blast);
    LDS_FENCE();
    f32x16 acc[2][2];
#pragma unroll
    for (int a = 0; a < 2; ++a)
#pragma unroll
      for (int b = 0; b < 2; ++b)
#pragma unroll
        for (int i = 0; i < 16; ++i) acc[a][b][i] = 0.f;
#pragma unroll
    for (int ks = 0; ks < 2; ++ks) {
      bf16x8 af[2], bf[2];
#pragma unroll
      for (int t = 0; t < 2; ++t) { af[t] = *(const bf16x8*)(Vt + (t * 32 + r) * 40 + ks * 16 + h * 8); bf[t] = *(const bf16x8*)(KhT + (t * 32 + r) * 40 + ks * 16 + h * 8); }
#pragma unroll
      for (int vt = 0; vt < 2; ++vt)
#pragma unroll
        for (int kt = 0; kt < 2; ++kt) acc[vt][kt] = __builtin_amdgcn_mfma_f32_32x32x16_bf16(af[vt], bf[kt], acc[vt][kt], 0, 0, 0);
    }
    float* dst = hgs + (size_t)wi * 4096;
#pragma unroll
    for (int vt = 0; vt < 2; ++vt)
#pragma unroll
      for (int kt = 0; kt < 2; ++kt)
#pragma unroll
        for (int i = 0; i < 16; ++i) gptr(dst)[(vt * 32 + (i & 3) + 8 * (i >> 2) + 4 * h) * 64 + kt * 32 + r] = acc[vt][kt][i];
  }
}

DI void hg_out_task(const Params& p, int l, int c, int hd, char* smem_w) {
  const int tid = otid(), lane = tid & 63, r = lane & 31, h = lane >> 5;
  bf16_t* Qt = (bf16_t*)smem_w;
  bf16_t* Kt = Qt + 32 * 72;
  bf16_t* Vt = Kt + 32 * 72;
  const float* proj = (const float*)(p.wsp() + OFF_PROJ);
  const float* hgs = (const float*)(p.wsp() + OFF_HGS);
  hg_build_vt(proj, c, hd, lane, Vt);
  f32x16 oT[2];
#pragma unroll
  for (int vt = 0; vt < 2; ++vt)
#pragma unroll
    for (int i = 0; i < 16; ++i) oT[vt][i] = 0.f;
#pragma unroll 1
  for (int d = 0; d < 2; ++d) {
    LDS_FENCE();
    const float lb = hg_lb(p, l, d, hd * 64 + lane);
    float run = 0.f;
    float zz[32], qq[32];
#pragma unroll
    for (int s = 0; s < 32; ++s) {
      int j = d ? 31 - s : s;
      zz[s] = gptr(proj)[(size_t)(c * 32 + j) * PLD + PC_ZF + d * 256 + hd * 64 + lane];
      qq[s] = gptr(proj)[(size_t)(c * 32 + j) * PLD + PC_Q + hd * 64 + lane];
    }
#pragma unroll
    for (int s = 0; s < 32; ++s) {
      int j = d ? 31 - s : s;
      float z = zz[s], q = qq[s];
      float lf, kv; hg_gate_vals(z, lb, lf, kv);
      run += lf;
      Qt[j * 72 + lane] = f2bf(q * __expf(run));
      Kt[j * 72 + lane] = f2bf(kv * __expf(-run));
    }
    LDS_FENCE();
    f32x16 sT;
#pragma unroll
    for (int i = 0; i < 16; ++i) sT[i] = 0.f;
    bf16x8 qf[4];
#pragma unroll
    for (int ks = 0; ks < 4; ++ks) {
      bf16x8 a = *(const bf16x8*)(Kt + r * 72 + ks * 16 + h * 8);
      qf[ks] = *(const bf16x8*)(Qt + r * 72 + ks * 16 + h * 8);
      sT = __builtin_amdgcn_mfma_f32_32x32x16_bf16(a, qf[ks], sT, 0, 0, 0);
    }
#pragma unroll
    for (int i = 0; i < 16; ++i) {
      int ii = (i & 3) + 8 * (i >> 2) + 4 * h;
      bool valid = d ? (ii >= r) : (ii <= r);
      sT[i] = valid ? sT[i] : 0.f;
    }
#pragma unroll
    for (int s2 = 0; s2 < 2; ++s2) {
      bf16x8 pb = pack8(sT[8 * s2], sT[8 * s2 + 1], sT[8 * s2 + 2], sT[8 * s2 + 3], sT[8 * s2 + 4], sT[8 * s2 + 5], sT[8 * s2 + 6], sT[8 * s2 + 7]);
#pragma unroll
      for (int vt = 0; vt < 2; ++vt) {
        s16x4 lo = *(const s16x4*)(Vt + (vt * 32 + r) * 40 + 16 * s2 + 4 * h);
        s16x4 hi2 = *(const s16x4*)(Vt + (vt * 32 + r) * 40 + 16 * s2 + 8 + 4 * h);
        bf16x8 av = __builtin_shufflevector(lo, hi2, 0, 1, 2, 3, 4, 5, 6, 7);
        oT[vt] = __builtin_amdgcn_mfma_f32_32x32x16_bf16(av, pb, oT[vt], 0, 0, 0);
      }
    }
    const float* st = hgs + (size_t)((c * 2 + d) * 4 + hd) * 4096;
#pragma unroll
    for (int ks = 0; ks < 4; ++ks) {
#pragma unroll
      for (int vt = 0; vt < 2; ++vt) {
        const GAS f32x4* sp4 = gptr((const f32x4*)(st + (vt * 32 + r) * 64 + ks * 16 + h * 8));
        f32x4 s0 = sp4[0], s1 = sp4[1];
        bf16x8 a = pack8(s0[0], s0[1], s0[2], s0[3], s1[0], s1[1], s1[2], s1[3]);
        oT[vt] = __builtin_amdgcn_mfma_f32_32x32x16_bf16(a, qf[ks], oT[vt], 0, 0, 0);
      }
    }
  }
  float ss = 0.f;
#pragma unroll
  for (int vt = 0; vt < 2; ++vt)
#pragma unroll
    for (int i = 0; i < 16; ++i) ss += oT[vt][i] * oT[vt][i];
  ss += __shfl_xor(ss, 32, 64);
  const float rstd = rsqrtf(ss * (1.f / 64.f) + EPSF);
  const int tok = c * 32 + r;
  bf16_t* cat = (bf16_t*)(p.wsp() + OFF_H);
#pragma unroll
  for (int vt = 0; vt < 2; ++vt)
#pragma unroll
    for (int g4 = 0; g4 < 4; ++g4) {
      int v0 = vt * 32 + 8 * g4 + 4 * h;
      f32x4 gt = *gptr((const f32x4*)(proj + (size_t)tok * PLD + PC_GATE + hd * 64 + v0));
      f32x4 gn = *gptr((const f32x4*)(p.inp(I_GRPG) + l * 1024 + 256 + hd * 64 + v0));
      s16x4 o;
      o[0] = (short)f2bf(oT[vt][4 * g4 + 0] * rstd * gn[0] * silu_f(gt[0]));
      o[1] = (short)f2bf(oT[vt][4 * g4 + 1] * rstd * gn[1] * silu_f(gt[1]));
      o[2] = (short)f2bf(oT[vt][4 * g4 + 2] * rstd * gn[2] * silu_f(gt[2]));
      o[3] = (short)f2bf(oT[vt][4 * g4 + 3] * rstd * gn[3] * silu_f(gt[3]));
      *gptr((s16x4*)(cat + (size_t)tok * DM + 256 + hd * 64 + v0)) = o;
    }
}

DI void ph_mix_out(const Params& p, int l, char* smem) {
  const int b = obid(); const int nb = gridDim.x;
  if (nb >= 2) {
    if ((b & 1) == 0) { for (int c = b >> 1; c < 256; c += (nb + 1) >> 1) s5_out_task(p, l, c, smem); }
    else {
      const int w = otid() >> 6;
      for (int c = b >> 1; c < 256; c += nb >> 1) hg_out_task(p, l, c, w, smem + w * 14336);
    }
  } else {
    for (int c = 0; c < 256; ++c) s5_out_task(p, l, c, smem);
    const int w = otid() >> 6;
    for (int c = 0; c < 256; ++c) hg_out_task(p, l, c, w, smem + w * 14336);
  }
}

DI void gmlp_task(const Params& p, int l, int C, int half, char* smem) {
  const int tid = otid(), lane = tid & 63, w = tid >> 6, r = lane & 31, h = lane >> 5;
  const int hd = w;
  float* rstd = (float*)smem;
  float* part = rstd + 128;
  bf16_t* GvT = (bf16_t*)(smem + 2560 + w * 9216);
  const float* proj = (const float*)(p.wsp() + OFF_PROJ);
  const bf16_t* wsb = (const bf16_t*)(p.wsp() + OFF_WSB) + (size_t)(l * 4 + hd) * 128 * 128;
#pragma unroll 4
  for (int i = 0; i < 8; ++i) {
    int tl = w * 32 + i * 4 + (lane >> 4);
    const float* src = proj + (size_t)(C * 128 + tl) * PLD + PC_GV + (lane & 15) * 16;
    float ss = 0.f;
#pragma unroll
    for (int q = 0; q < 4; ++q) {
      f32x4 v = *gptr((const f32x4*)(src + q * 4));
      float a = gelu_t(v[0]), b = gelu_t(v[1]), cc = gelu_t(v[2]), dd = gelu_t(v[3]);
      ss += a * a + b * b + cc * cc + dd * dd;
    }
#pragma unroll
    for (int o = 8; o > 0; o >>= 1) ss += __shfl_xor(ss, o, 64);
    if ((lane & 15) == 0) rstd[tl] = rsqrtf(ss * (1.f / 256.f) + EPSF);
  }
  __syncthreads();
  const float gmg = p.inp(I_GMNG)[l * 256 + hd * 64 + lane];
  bf16_t* cat = (bf16_t*)(p.wsp() + OFF_H);
  f32x16 acc[2][2];
#pragma unroll
  for (int a = 0; a < 2; ++a)
#pragma unroll
    for (int b = 0; b < 2; ++b)
#pragma unroll
      for (int i = 0; i < 16; ++i) acc[a][b][i] = 0.f;
#pragma unroll 1
  for (int pass = 0; pass < 2; ++pass) {
    LDS_FENCE();
#pragma unroll 4
    for (int j0 = 0; j0 < 64; j0 += 8) {
      float v[8];
#pragma unroll
      for (int q = 0; q < 8; ++q) {
        int j = pass * 64 + j0 + q;
        v[q] = gelu_t(gptr(proj)[(size_t)(C * 128 + j) * PLD + PC_GV + hd * 64 + lane]) * rstd[j] * gmg;
      }
      *(bf16x8*)(GvT + lane * 72 + j0) = pack8(v[0], v[1], v[2], v[3], v[4], v[5], v[6], v[7]);
    }
    LDS_FENCE();
#pragma unroll
    for (int ks = 0; ks < 4; ++ks) {
      bf16x8 af[2];
#pragma unroll
      for (int mt = 0; mt < 2; ++mt) af[mt] = *(const bf16x8*)(GvT + (mt * 32 + r) * 72 + ks * 16 + h * 8);
#pragma unroll
      for (int nt = 0; nt < 2; ++nt) {
        bf16x8 b = *gptr((const bf16x8*)(wsb + (size_t)((half * 2 + nt) * 32 + r) * 128 + pass * 64 + ks * 16 + h * 8));
#pragma unroll
        for (int mt = 0; mt < 2; ++mt) acc[mt][nt] = __builtin_amdgcn_mfma_f32_32x32x16_bf16(af[mt], b, acc[mt][nt], 0, 0, 0);
      }
    }
  }
#pragma unroll
  for (int nt = 0; nt < 2; ++nt) {
    const int ti = (half * 2 + nt) * 32 + r; const int tok = C * 128 + ti;
    const float bsv = p.inp(I_GMBS)[(l * 4 + hd) * 128 + ti];
    float ss = 0.f;
#pragma unroll
    for (int mt = 0; mt < 2; ++mt)
#pragma unroll
      for (int g4 = 0; g4 < 4; ++g4) {
        int d0 = mt * 32 + 8 * g4 + 4 * h;
        f32x4 gu = *gptr((const f32x4*)(proj + (size_t)tok * PLD + PC_GU + hd * 64 + d0));
        float v0 = gelu_t(gu[0]) * (acc[mt][nt][4 * g4 + 0] + bsv);
        float v1 = gelu_t(gu[1]) * (acc[mt][nt][4 * g4 + 1] + bsv);
        float v2 = gelu_t(gu[2]) * (acc[mt][nt][4 * g4 + 2] + bsv);
        float v3 = gelu_t(gu[3]) * (acc[mt][nt][4 * g4 + 3] + bsv);
        acc[mt][nt][4 * g4 + 0] = v0; acc[mt][nt][4 * g4 + 1] = v1; acc[mt][nt][4 * g4 + 2] = v2; acc[mt][nt][4 * g4 + 3] = v3;
        ss += v0 * v0 + v1 * v1 + v2 * v2 + v3 * v3;
      }
    ss += __shfl_xor(ss, 32, 64);
    if (h == 0) part[w * 64 + nt * 32 + r] = ss;
  }
  __syncthreads();
#pragma unroll
  for (int nt = 0; nt < 2; ++nt) {
    const int ti = (half * 2 + nt) * 32 + r; const int tok = C * 128 + ti;
    const int pi = nt * 32 + r;
    float tot = part[pi] + part[64 + pi] + part[128 + pi] + part[192 + pi];
    float rs = rsqrtf(tot * (1.f / 256.f) + EPSF);
#pragma unroll
    for (int mt = 0; mt < 2; ++mt)
#pragma unroll
      for (int g4 = 0; g4 < 4; ++g4) {
        int d0 = mt * 32 + 8 * g4 + 4 * h;
        f32x4 gn = *gptr((const f32x4*)(p.inp(I_GRPG) + l * 1024 + 768 + hd * 64 + d0));
        s16x4 o;
        o[0] = (short)f2bf(acc[mt][nt][4 * g4 + 0] * rs * gn[0]); o[1] = (short)f2bf(acc[mt][nt][4 * g4 + 1] * rs * gn[1]);
        o[2] = (short)f2bf(acc[mt][nt][4 * g4 + 2] * rs * gn[2]); o[3] = (short)f2bf(acc[mt][nt][4 * g4 + 3] * rs * gn[3]);
        *gptr((s16x4*)(cat + (size_t)tok * DM + 768 + hd * 64 + d0)) = o;
      }
  }
  __syncthreads();
}

DI void ph_c_norm(const Params& p, int l) {
  const int tid_ = otid(); const int lane = tid_ & 63, w = tid_ >> 6;
  bf16_t* cat = (bf16_t*)(p.wsp() + OFF_H);
  const float* g0 = (const float*)(p.wsp() + OFF_GCP0); const float* g1 = (const float*)(p.wsp() + OFF_GCP1);
  for (int tok = obid() * 4 + w; tok < NTOK; tok += gridDim.x * 4) {
    float4 v = ldg4(g0 + (size_t)tok * 256 + lane * 4);
    if (tok >= 4096) {
#pragma unroll
      for (int q = 0; q < 3; ++q) {
        float4 u = ldg4(g1 + ((size_t)q * 4096 + (tok - 4096)) * 256 + lane * 4);
        v.x += u.x; v.y += u.y; v.z += u.z; v.w += u.w;
      }
    }
    float ss = wave_sum(v.x * v.x + v.y * v.y + v.z * v.z + v.w * v.w);
    float rstd = rsqrtf(ss * (1.f / 256.f) + EPSF);
    float4 g = ldg4(p.inp(I_GRPG) + l * 1024 + 512 + lane * 4);
    ushort4 o; o.x = f2bf(v.x * rstd * g.x); o.y = f2bf(v.y * rstd * g.y); o.z = f2bf(v.z * rstd * g.z); o.w = f2bf(v.w * rstd * g.w);
    stg_us4(cat + (size_t)tok * DM + 512 + lane * 4, o);
  }
}

DI void ph_local(const Params& p, int l, char* smem) {
  for (int it = obid(); it < 448; it += gridDim.x) {
    if (it < 320) {
      int seq, mt, nt, ks, T, start, klen;
      if (it < 256) { ks = it & 3; nt = (it >> 2) & 1; mt = (it >> 3) & 15; seq = 16 + (it >> 7); klen = 1024; }
      else { int j = it - 256; ks = 0; nt = j & 1; mt = (j >> 1) & 1; seq = j >> 2; klen = 512; }
      seq_info(seq, start, T);
      const bf16_t* A = (const bf16_t*)(p.wsp() + (T == 256 ? OFF_DFTC : OFF_DFTL)) + (size_t)mt * 128 * 2 * T + ks * 1024;
      const bf16_t* Bt = (const bf16_t*)(p.wsp() + OFF_UVT) + (size_t)512 * start + (size_t)nt * 128 * 2 * T + ks * 1024;
      float* dst = (ks == 0) ? (float*)(p.wsp() + OFF_GCP0) + (size_t)(start + mt * 128) * 256 + nt * 128
                             : (float*)(p.wsp() + OFF_GCP1) + ((size_t)(ks - 1) * 4096 + (start - 4096) + mt * 128) * 256 + nt * 128;
      EpiStoreF epi{dst, 256};
      gemm_tile64_pf2(A, 2 * T, Bt, 2 * T, klen, smem, epi);
    } else {
      gmlp_task(p, l, (it - 320) >> 1, (it - 320) & 1, smem);
    }
  }
  ph_hg_local(p, l, smem);
  ph_s5_local(p, l, smem);
}

DI void ph_conv_gate(const Params& p, int l) {
  const int gtid = obid() * 256 + otid(), gsz = gridDim.x * 256;
  const bf16_t* z = (const bf16_t*)(p.wsp() + OFF_Z); bf16_t* act = (bf16_t*)(p.wsp() + OFF_ACT);
  const float* cw = p.inp(I_CONVW) + (size_t)l * 3 * DUP; const float* cb = p.inp(I_CONVB) + (size_t)l * DUP;
  for (int e = gtid; e < NTOK * (DFF / 8); e += gsz) {
    int tok = e / (DFF / 8), j0 = (e % (DFF / 8)) * 8;
    int seg = tok < 4096 ? 256 : 64; int tt = tok & (seg - 1);
    bool hp = tt > 0, hn = tt < seg - 1;
    float res[8];
    float za[2][8];
#pragma unroll
    for (int half = 0; half < 2; ++half) {
      int ch = half * DFF + j0;
      uint4 zc = *(const uint4*)(z + (size_t)tok * DUP + ch);
      uint4 zp = hp ? *(const uint4*)(z + (size_t)(tok - 1) * DUP + ch) : make_uint4(0, 0, 0, 0);
      uint4 zn = hn ? *(const uint4*)(z + (size_t)(tok + 1) * DUP + ch) : make_uint4(0, 0, 0, 0);
      const unsigned* pc = (const unsigned*)&zc; const unsigned* pp = (const unsigned*)&zp; const unsigned* pn = (const unsigned*)&zn;
#pragma unroll
      for (int q = 0; q < 8; ++q) {
        float vc = bf2f((bf16_t)((pc[q >> 1] >> ((q & 1) * 16)) & 0xffff));
        float vp = bf2f((bf16_t)((pp[q >> 1] >> ((q & 1) * 16)) & 0xffff));
        float vn = bf2f((bf16_t)((pn[q >> 1] >> ((q & 1) * 16)) & 0xffff));
        za[half][q] = cb[ch + q] + cw[ch + q] * vp + cw[DUP + ch + q] * vc + cw[2 * DUP + ch + q] * vn;
      }
    }
#pragma unroll
    for (int q = 0; q < 8; ++q) res[q] = gelu_t(za[0][q]) * za[1][q];
    uint4 o;
    o.x = (unsigned)f2bf(res[0]) | ((unsigned)f2bf(res[1]) << 16);
    o.y = (unsigned)f2bf(res[2]) | ((unsigned)f2bf(res[3]) << 16);
    o.z = (unsigned)f2bf(res[4]) | ((unsigned)f2bf(res[5]) << 16);
    o.w = (unsigned)f2bf(res[6]) | ((unsigned)f2bf(res[7]) << 16);
    *(uint4*)(act + (size_t)tok * DFF + j0) = o;
  }
}

#define EXP 0
#define GSYNC() xcd_barrier(xb)
#define XS(n) if (EXP == n) { GSYNC(); }
__global__ void __launch_bounds__(256, 2) mega_kernel(Params pk) {
  __shared__ __attribute__((aligned(16))) char smem[SMEM_BYTES];
  cg::grid_group grid = cg::this_grid();
  __shared__ uint4 xb_words;
  __shared__ Params sp;
  if (threadIdx.x == 0) { xb_words = make_uint4(0u, 0u, 0u, 0u); sp = pk; }
  __syncthreads();
  const Params& p = sp;
  XcdBarrier xb = xcd_barrier_post((unsigned*)(pk.ws + OFF_BAR), (volatile LAS unsigned*)&xb_words);
  if (p.wsp() == nullptr) grid.sync();
  ph_mu(p, smem);
  ph_prep(p, smem);
  GSYNC();
  ph_fold(p, smem);
  ph_mod_reduce(p);
  GSYNC();
  ph_fold_copy(p, 0);
  for (int l = 0; l < 2; ++l) {
    if (l > 0) ph_convert_weights(p, l, smem);
    ph_norm_mod(p, l, p.inp(I_N1G) + l * 1024, 0, 1024, l == 0);
    GSYNC();
    ph_gemm_in(p, smem);
    GSYNC();
    ph_local(p, l, smem);
    if (EXP == 11) ph_local(p, l, smem);
    GSYNC();
    ph_scans(p, l);
    ph_c_norm(p, l);
    GSYNC();
    ph_mix_out(p, l, smem);
    if (EXP == 12) ph_mix_out(p, l, smem);
    GSYNC();
    ph_gemm_out(p, l, smem);
    GSYNC();
    ph_norm_mod(p, l, p.inp(I_N2G) + l * 1024, 3072, 4096);
    GSYNC();
    ph_gemm_up(p, l, smem);
    GSYNC();
    ph_gemm_down(p, l, smem);
    GSYNC();
  }
  ph_final_norm(p);
}

extern "C" void kernel_launch(void* const* d_in, const int* in_sizes, int n_in, void* d_out, int out_size, void* d_ws, size_t ws_size,
                              hipStream_t stream) {
  static int grid_blocks = 0;
  if (!grid_blocks) {
    int dev = 0, cus = 0, per_cu = 0;
    hipGetDevice(&dev);
    hipDeviceGetAttribute(&cus, hipDeviceAttributeMultiprocessorCount, dev);
    hipOccupancyMaxActiveBlocksPerMultiprocessor(&per_cu, mega_kernel, 256, 0);
    if (per_cu > 2) per_cu = 2;
    if (per_cu < 1) per_cu = 1;
    grid_blocks = cus * per_cu;
  }
  if (ws_size < WS_NEEDED) fprintf(stderr, "workspace too small: %zu < %zu\n", ws_size, (size_t)WS_NEEDED);
  Params p{};
  for (int i = 0; i < 33; ++i) p.in[i] = (const float*)d_in[i];
  p.out = (float*)d_out;
  p.ws = (char*)d_ws;
  void* args[] = {&p};
  hipMemsetAsync((char*)d_ws + OFF_BAR, 0, XCD_BAR_WORDS_C * 4, stream);
  hipError_t e = hipLaunchCooperativeKernel((void*)mega_kernel, dim3(grid_blocks), dim3(256), args, 0, stream);
  if (e != hipSuccess) fprintf(stderr, "cooperative launch failed: %s (grid %d)\n", hipGetErrorString(e), grid_blocks);
}
```

```cpp
#include <hip/hip_runtime.h>
#include <hip/hip_cooperative_groups.h>
#include <cstdio>
namespace cg = cooperative_groups;

typedef unsigned short bf16_t;
using bf16x8 = __attribute__((ext_vector_type(8))) short;
using f32x16 = __attribute__((ext_vector_type(16))) float;
using u32x4 = __attribute__((ext_vector_type(4))) unsigned;
using s16x4 = __attribute__((ext_vector_type(4))) short;
using f32x4 = __attribute__((ext_vector_type(4))) float;
#define LDS_FENCE() asm volatile("" ::: "memory")

#define DI __device__ __forceinline__
#define GAS __attribute__((address_space(1)))
template <class T> DI const GAS T* gptr(const T* p) { return (const GAS T*)p; }
template <class T> DI GAS T* gptr(T* p) { return (GAS T*)p; }
DI float4 ldg4(const float* p) { f32x4 v = *gptr((const f32x4*)p); return make_float4(v[0], v[1], v[2], v[3]); }
DI void stg4(float* p, float4 v) { f32x4 t; t[0] = v.x; t[1] = v.y; t[2] = v.z; t[3] = v.w; *gptr((f32x4*)p) = t; }
DI void stg_us4(unsigned short* p, ushort4 v) { s16x4 t; t[0] = (short)v.x; t[1] = (short)v.y; t[2] = (short)v.z; t[3] = (short)v.w; *gptr((s16x4*)p) = t; }

constexpr int NTOK = 8192;
constexpr int DM = 1024;
constexpr int NWIN = 2560;
constexpr int PLD = 2048;
constexpr int DFF = 2816;
constexpr int DUP = 5632;
constexpr float EPSF = 1e-6f;

constexpr int PC_XA = 0, PC_Q = 256, PC_ZF = 512, PC_V = 1024, PC_GATE = 1280, PC_GU = 1536, PC_GV = 1792;

constexpr size_t SZ_WIN = (size_t)NWIN * 1024 * 2;
constexpr size_t SZ_WOUT = (size_t)1024 * 1024 * 2;
constexpr size_t SZ_WUP = (size_t)DUP * 1024 * 2;
constexpr size_t SZ_WDN = (size_t)1024 * DFF * 2;
constexpr size_t SZ_W256 = (size_t)256 * 256 * 2;
constexpr size_t OFF_WIN = 0;
constexpr size_t OFF_WOUT = OFF_WIN + SZ_WIN;
constexpr size_t OFF_WUP = OFF_WOUT + SZ_WOUT;
constexpr size_t OFF_WDN = OFF_WUP + SZ_WUP;
constexpr size_t OFF_WGLU = OFF_WDN + SZ_WDN;
constexpr size_t OFF_DFTL = OFF_WGLU + SZ_W256;
constexpr size_t OFF_DFTC = OFF_DFTL + (size_t)2048 * 4096 * 2;
constexpr int NKC = 16;
constexpr size_t OFF_ADAP = OFF_DFTC + (size_t)256 * 512 * 2;
constexpr size_t OFF_MOD = OFF_ADAP + (size_t)NKC * 2 * 3 * 6144 * 4;
constexpr size_t OFF_S5A = OFF_MOD + (size_t)2 * 3 * 6144 * 4;
constexpr size_t OFF_S5AL = OFF_S5A + 4096 * 2 * 4;
constexpr size_t OFF_S5BBR = OFF_S5AL + 4096 * 2 * 4;
constexpr size_t OFF_S5BBI = OFF_S5BBR + 4096 * 16 * 4;
constexpr size_t OFF_X = OFF_S5BBI + 4096 * 16 * 4;
constexpr size_t OFF_H = OFF_X + (size_t)NTOK * DM * 4;
constexpr size_t OFF_R1 = OFF_H + (size_t)NTOK * DM * 2;
constexpr size_t OFF_PROJ = OFF_R1;
constexpr size_t OFF_UVT = OFF_PROJ + (size_t)NTOK * PLD * 4;
constexpr size_t OFF_YLOC = OFF_UVT + (size_t)NTOK * 512 * 2;
constexpr size_t OFF_Z = OFF_R1;
constexpr size_t SZ_R1 = (size_t)NTOK * DUP * 2;
constexpr size_t OFF_R2 = OFF_R1 + SZ_R1;
constexpr size_t OFF_HGS = OFF_R2;
constexpr size_t OFF_GCP0 = OFF_HGS + (size_t)2048 * 4096 * 4;
constexpr size_t OFF_GCP1 = OFF_GCP0 + (size_t)NTOK * 256 * 4;
constexpr size_t OFF_HGG = OFF_GCP1 + (size_t)3 * 4096 * 256 * 4;
constexpr size_t OFF_S5E = OFF_HGG + (size_t)2048 * 64 * 4;
constexpr size_t OFF_S5H = OFF_S5E + (size_t)256 * 2 * 16 * 64 * 2 * 4;
constexpr size_t OFF_CMT = OFF_S5H + (size_t)256 * 2 * 16 * 64 * 2 * 4;
constexpr size_t OFF_WSB = OFF_CMT + (size_t)2 * 2 * 16 * 16 * 128 * 2;
constexpr size_t OFF_ACT = OFF_R2;
constexpr int XCD_BAR_WORDS_C = 3456;
constexpr size_t OFF_MU = OFF_WSB + (size_t)2 * 4 * 128 * 128 * 2;
constexpr size_t OFF_WFOLD = OFF_MU + (size_t)2 * 2 * 256 * 256 * 4;
constexpr size_t OFF_BAR = OFF_WFOLD + (size_t)2 * 512 * 1024 * 2;
constexpr size_t WS_NEEDED = OFF_BAR + XCD_BAR_WORDS_C * 4;

constexpr size_t OUT_S5RE = (size_t)NTOK * DM;
constexpr size_t OUT_S5IM = OUT_S5RE + 65536;
constexpr size_t OUT_HG = OUT_S5IM + 65536;

constexpr int SMEM_BYTES = 63488;

struct Params {
  const float* in[33];
  float* out;
  char* ws;
  DI char* wsp() const { return *(char* const volatile __attribute__((address_space(3)))*)(&ws); }
  DI const float* inp(int i) const { return *(const float* const __attribute__((address_space(3)))*)(&in[i]); }
  DI float* outp() const { return *(float* const __attribute__((address_space(3)))*)(&out); }
};

enum { I_XP = 0, I_XS, I_S5RE, I_S5IM, I_HGST, I_C, I_CCTX, I_WADA, I_BADA, I_N1G, I_N2G, I_WIN, I_LAMRE, I_LAMIM, I_LOGDT,
       I_BRE, I_BIM, I_CRE, I_CIM, I_S5D, I_WGLU, I_LBLOG, I_FNW, I_GMNG, I_GMWS, I_GMBS, I_GRPG, I_WOUT, I_WUP, I_CONVW,
       I_CONVB, I_WDN, I_FING };

DI bf16_t f2bf(float x) { unsigned u = __float_as_uint(x); u += 0x7fffu + ((u >> 16) & 1u); return (bf16_t)(u >> 16); }
DI float bf2f(bf16_t b) { return __uint_as_float(((unsigned)b) << 16); }
DI float frcp(float x) { return __builtin_amdgcn_rcpf(x); }
DI float gelu_t(float x) { float u2 = 1.5957691216057308f * (x + 0.044715f * x * x * x); return x * frcp(1.f + __expf(-u2)); }
DI float sigm(float x) { return frcp(1.f + __expf(-x)); }
DI float silu_f(float x) { return x * sigm(x); }
DI int otid() { int t = threadIdx.x; asm volatile("" : "+v"(t)); return t; }
DI int obid() { int b = blockIdx.x; asm volatile("" : "+s"(b)); return b; }
DI unsigned pack_bf2(float a, float b) { return (unsigned)f2bf(a) | ((unsigned)f2bf(b) << 16); }
DI bf16x8 pack8(float a0, float a1, float a2, float a3, float a4, float a5, float a6, float a7) {
  u32x4 v; v[0] = pack_bf2(a0, a1); v[1] = pack_bf2(a2, a3); v[2] = pack_bf2(a4, a5); v[3] = pack_bf2(a6, a7);
  return __builtin_bit_cast(bf16x8, v);
}
DI float wave_sum(float v) {
#pragma unroll
  for (int o = 32; o > 0; o >>= 1) v += __shfl_xor(v, o, 64);
  return v;
}
DI void seq_of_tok(int tok, int& start, int& T) {
  if (tok < 4096) { start = tok & ~255; T = 256; } else { start = 4096 + ((tok - 4096) & ~2047); T = 2048; }
}
DI int cv_of_tok(int tok) { return tok < 4096 ? 0 : 1 + ((tok - 4096) >> 11); }
DI void seq_info(int seq, int& start, int& T) {
  if (seq < 16) { start = seq * 256; T = 256; } else { start = 4096 + (seq - 16) * 2048; T = 2048; }
}


#define XB_TMO      128
#define XB_XCNT(j)  (256  + 64 * (j))
#define XB_XSUB(j)  (1280 + 64 * (j))
#define XB_XGEN(j)  (2304 + 64 * (j))
#define XB_TOP      3328
#define XB_TOPGEN   3392
#define XCD_BAR_WORDS 3456
#define XB_SPIN_CAP (1u << 18)
#define LAS __attribute__((address_space(3)))
DI unsigned xb_ld(unsigned* p) { return __hip_atomic_load((GAS unsigned*)p, __ATOMIC_RELAXED, __HIP_MEMORY_SCOPE_AGENT); }
DI unsigned xb_add(unsigned* p, unsigned v) { return __hip_atomic_fetch_add((GAS unsigned*)p, v, __ATOMIC_RELAXED, __HIP_MEMORY_SCOPE_AGENT); }
DI unsigned xb_xcc_id() { return (unsigned)__builtin_amdgcn_s_getreg((3 << 11) | 20) & 0xFu; }
#define XB_SPIN(cond, bar) do { unsigned _sp = 0; while (cond) { __builtin_amdgcn_s_sleep(1); \
    if ((++_sp & 255u) == 0u) { if (xb_ld(&(bar)[XB_TMO])) break; if (_sp > XB_SPIN_CAP) { atomicAdd(&(bar)[XB_TMO], 1u); break; } } } } while (0)
struct XcdBarrier { unsigned* bar; volatile LAS unsigned* st; };
DI XcdBarrier xcd_barrier_post(unsigned* bar, volatile LAS unsigned* st) {
  XcdBarrier b; b.bar = bar; b.st = st;
  if (threadIdx.x == 0) { unsigned x = xb_xcc_id(); st[2] = x; (void)xb_add(&bar[XB_XCNT(x)], 1u); }
  return b;
}
DI void xcd_barrier_complete(unsigned* bar, unsigned x, unsigned& nloc, unsigned& nx) {
  const unsigned G = gridDim.x * gridDim.y * gridDim.z;
  unsigned sum, cnt, mine, sp = 0u;
  for (;;) {
    sum = 0u; cnt = 0u; mine = 0u;
#pragma unroll
    for (unsigned j = 0; j < 16; ++j) { const unsigned c = xb_ld(&bar[XB_XCNT(j)]); sum += c; cnt += (c > 0u) ? 1u : 0u; mine = (j == x) ? c : mine; }
    if (sum == G) break;
    __builtin_amdgcn_s_sleep(1);
    if ((++sp & 255u) == 0u) { if (xb_ld(&bar[XB_TMO])) break; if (sp > XB_SPIN_CAP) { atomicAdd(&bar[XB_TMO], 1u); break; } }
  }
  nloc = mine > 0u ? mine : 1u; nx = cnt > 0u ? cnt : 1u;
}
DI void xcd_barrier(const XcdBarrier& b) {
  asm volatile("s_waitcnt vmcnt(0)" ::: "memory");
  __syncthreads();
  if (threadIdx.x == 0) {
    unsigned* bar = b.bar;
    asm volatile("" : "+s"(bar));
    __builtin_amdgcn_s_waitcnt(0);
    unsigned nloc = b.st[0], nx = b.st[1]; const unsigned bx = b.st[2];
    if (nloc == 0u) { xcd_barrier_complete(bar, bx, nloc, nx); b.st[0] = nloc; b.st[1] = nx; }
    const unsigned old = xb_add(&bar[XB_XSUB(bx)], 1u);
    const unsigned gen = old / nloc;
    if (old + 1u == (gen + 1u) * nloc) {
      __builtin_amdgcn_fence(__ATOMIC_RELEASE, "agent");
      asm volatile("s_waitcnt vmcnt(0)" ::: "memory");
      const unsigned og = xb_add(&bar[XB_TOP], 1u);
      const unsigned tg = og / nx;
      if (og + 1u == (tg + 1u) * nx) xb_add(&bar[XB_TOPGEN], 1u);
      else XB_SPIN(xb_ld(&bar[XB_TOPGEN]) == tg, bar);
      __builtin_amdgcn_fence(__ATOMIC_ACQUIRE, "agent");
      xb_add(&bar[XB_XGEN(bx)], 1u);
      asm volatile("s_waitcnt vmcnt(0)" ::: "memory");
    } else {
      XB_SPIN(xb_ld(&bar[XB_XGEN(bx)]) == gen, bar);
      __builtin_amdgcn_fence(__ATOMIC_ACQUIRE, "agent");
      asm volatile("s_waitcnt vmcnt(0)" ::: "memory");
    }
  }
  __syncthreads();
}

template <int BM, int BN, class Epi>
DI void gemm_tile(const bf16_t* __restrict__ A, int lda, const bf16_t* __restrict__ Bt, int ldb, int K, char* smem, const Epi& epi) {
  constexpr int LS = 40;
  constexpr int MI = BM / 64, NI = BN / 64;
  constexpr int A_CH = BM * 4 / 256, B_CH = BN * 4 / 256;
  bf16_t* sbase = (bf16_t*)smem;
  const int tid = otid(), lane = tid & 63, w = tid >> 6, wm = w >> 1, wn = w & 1, r = lane & 31, h = lane >> 5;
  f32x16 acc[MI][NI];
#pragma unroll
  for (int mi = 0; mi < MI; ++mi)
#pragma unroll
    for (int ni = 0; ni < NI; ++ni)
#pragma unroll
      for (int i = 0; i < 16; ++i) acc[mi][ni][i] = 0.f;
  u32x4 ra[A_CH], rb[B_CH];
  const int KT = K / 32;
#define GLOAD(kt)                                                                                   \
  {                                                                                                 \
    _Pragma("unroll") for (int i = 0; i < A_CH; ++i) {                                              \
      int c = tid + i * 256; int row = c >> 2, kc = c & 3;                                          \
      ra[i] = *(const u32x4*)(A + (size_t)row * lda + (kt) * 32 + kc * 8);                          \
    }                                                                                               \
    _Pragma("unroll") for (int i = 0; i < B_CH; ++i) {                                              \
      int c = tid + i * 256; int row = c >> 2, kc = c & 3;                                          \
      rb[i] = *(const u32x4*)(Bt + (size_t)row * ldb + (kt) * 32 + kc * 8);                         \
    }                                                                                               \
  }
#define SSTORE(s)                                                                                   \
  {                                                                                                 \
    bf16_t* sa = sbase + (s) * (BM + BN) * LS; bf16_t* sb = sa + BM * LS;                           \
    _Pragma("unroll") for (int i = 0; i < A_CH; ++i) {                                              \
      int c = tid + i * 256; int row = c >> 2, kc = c & 3;                                          \
      *(u32x4*)(sa + row * LS + kc * 8) = ra[i];                                                    \
    }                                                                                               \
    _Pragma("unroll") for (int i = 0; i < B_CH; ++i) {                                              \
      int c = tid + i * 256; int row = c >> 2, kc = c & 3;                                          \
      *(u32x4*)(sb + row * LS + kc * 8) = rb[i];                                                    \
    }                                                                                               \
  }
  GLOAD(0);
  SSTORE(0);
  __syncthreads();
  for (int kt = 0; kt < KT; ++kt) {
    if (kt + 1 < KT) GLOAD(kt + 1);
    const bf16_t* sa = sbase + (kt & 1) * (BM + BN) * LS;
    const bf16_t* sb = sa + BM * LS;
    const bf16_t* a_s = sa + (wm * (BM / 2) + r) * LS + h * 8;
    const bf16_t* b_s = sb + (wn * (BN / 2) + r) * LS + h * 8;
#pragma unroll
    for (int ks = 0; ks < 2; ++ks) {
      bf16x8 af[MI], bfr[NI];
#pragma unroll
      for (int mi = 0; mi < MI; ++mi) af[mi] = *(const bf16x8*)(a_s + mi * 32 * LS + ks * 16);
#pragma unroll
      for (int ni = 0; ni < NI; ++ni) bfr[ni] = *(const bf16x8*)(b_s + ni * 32 * LS + ks * 16);
#pragma unroll
      for (int mi = 0; mi < MI; ++mi)
#pragma unroll
        for (int ni = 0; ni < NI; ++ni) acc[mi][ni] = __builtin_amdgcn_mfma_f32_32x32x16_bf16(af[mi], bfr[ni], acc[mi][ni], 0, 0, 0);
    }
    if (kt + 1 < KT) SSTORE((kt + 1) & 1);
    __syncthreads();
  }
#undef GLOAD
#undef SSTORE
#pragma unroll
  for (int mi = 0; mi < MI; ++mi)
#pragma unroll
    for (int ni = 0; ni < NI; ++ni) {
#pragma unroll
      for (int i = 0; i < 16; ++i) {
        int rr = wm * (BM / 2) + mi * 32 + (i & 3) + 8 * (i >> 2) + 4 * h;
        int cc = wn * (BN / 2) + ni * 32 + r;
        epi(rr, cc, acc[mi][ni][i]);
        if ((i & 3) == 3) __builtin_amdgcn_sched_barrier(0);
      }
    }
}

template <int BM, int BN, class Epi, bool TILE_EPI = false>
DI void gemm_tile64(const bf16_t* __restrict__ A, int lda, const bf16_t* __restrict__ Bt, int ldb, int K, char* smem, const Epi& epi) {
  constexpr int LS = 72;
  constexpr int MI = BM / 64, NI = BN / 64;
  constexpr int A_CH = BM * 8 / 256, B_CH = BN * 8 / 256;
  bf16_t* sa = (bf16_t*)smem;
  bf16_t* sb = sa + BM * LS;
  const int tid = otid(), lane = tid & 63, w = tid >> 6, wm = w >> 1, wn = w & 1, r = lane & 31, h = lane >> 5;
  f32x16 acc[MI][NI];
#pragma unroll
  for (int mi = 0; mi < MI; ++mi)
#pragma unroll
    for (int ni = 0; ni < NI; ++ni)
#pragma unroll
      for (int i = 0; i < 16; ++i) acc[mi][ni][i] = 0.f;
  u32x4 ra[A_CH], rb[B_CH];
  const int KT = K / 64;
  const bf16_t* ag = A + (size_t)(tid >> 3) * lda + (tid & 7) * 8;
  const bf16_t* bg = Bt + (size_t)(tid >> 3) * ldb + (tid & 7) * 8;
  bf16_t* sa_w = sa + (tid >> 3) * LS + (tid & 7) * 8;
  bf16_t* sb_w = sb + (tid >> 3) * LS + (tid & 7) * 8;
#pragma unroll
  for (int i = 0; i < A_CH; ++i) ra[i] = *gptr((const u32x4*)(ag + (size_t)i * 32 * lda));
#pragma unroll
  for (int i = 0; i < B_CH; ++i) rb[i] = *gptr((const u32x4*)(bg + (size_t)i * 32 * ldb));
  const bf16_t* a_s = sa + (wm * (BM / 2) + r) * LS + h * 8;
  const bf16_t* b_s = sb + (wn * (BN / 2) + r) * LS + h * 8;
#pragma unroll 1
  for (int kt = 0; kt < KT; ++kt) {
    __syncthreads();
#pragma unroll
    for (int i = 0; i < A_CH; ++i) *(u32x4*)(sa_w + i * 32 * LS) = ra[i];
#pragma unroll
    for (int i = 0; i < B_CH; ++i) *(u32x4*)(sb_w + i * 32 * LS) = rb[i];
    __syncthreads();
    {
      bf16x8 af[2][MI], bfr[2][NI];
#define LDFRAG(buf, ks)                                                                               \
      { _Pragma("unroll") for (int mi = 0; mi < MI; ++mi) af[buf][mi] = *(const bf16x8*)(a_s + mi * 32 * LS + (ks) * 16);   \
        _Pragma("unroll") for (int ni = 0; ni < NI; ++ni) bfr[buf][ni] = *(const bf16x8*)(b_s + ni * 32 * LS + (ks) * 16); }
#define DOMFMA(buf)                                                                                   \
      { _Pragma("unroll") for (int mi = 0; mi < MI; ++mi)                                             \
          _Pragma("unroll") for (int ni = 0; ni < NI; ++ni)                                           \
            acc[mi][ni] = __builtin_amdgcn_mfma_f32_32x32x16_bf16(af[buf][mi], bfr[buf][ni], acc[mi][ni], 0, 0, 0); }
      LDFRAG(0, 0); LDFRAG(1, 1);
      __builtin_amdgcn_sched_barrier(0);
      if (kt + 1 < KT) {
#pragma unroll
        for (int i = 0; i < A_CH; ++i) ra[i] = *gptr((const u32x4*)(ag + (size_t)i * 32 * lda + (kt + 1) * 64));
#pragma unroll
        for (int i = 0; i < B_CH; ++i) rb[i] = *gptr((const u32x4*)(bg + (size_t)i * 32 * ldb + (kt + 1) * 64));
      }
      __builtin_amdgcn_sched_barrier(0);
      DOMFMA(0);
      __builtin_amdgcn_sched_barrier(0);
      LDFRAG(0, 2);
      __builtin_amdgcn_sched_barrier(0);
      DOMFMA(1);
      __builtin_amdgcn_sched_barrier(0);
      LDFRAG(1, 3);
      __builtin_amdgcn_sched_barrier(0);
      DOMFMA(0);
      __builtin_amdgcn_sched_barrier(0);
      DOMFMA(1);
      __builtin_amdgcn_sched_barrier(0);
#undef LDFRAG
#undef DOMFMA
    }
  }
  if constexpr (TILE_EPI) {
    epi.tile(acc, wm, wn, r, h, smem);
  } else {
#pragma unroll
    for (int mi = 0; mi < MI; ++mi)
#pragma unroll
      for (int ni = 0; ni < NI; ++ni) {
#pragma unroll
        for (int i = 0; i < 16; ++i) {
          int rr = wm * (BM / 2) + mi * 32 + (i & 3) + 8 * (i >> 2) + 4 * h;
          int cc = wn * (BN / 2) + ni * 32 + r;
          epi(rr, cc, acc[mi][ni][i]);
          if ((i & 3) == 3) __builtin_amdgcn_sched_barrier(0);
        }
      }
  }
  __syncthreads();
}

template <class Epi>
DI void gemm_tile64_pf2(const bf16_t* __restrict__ A, int lda, const bf16_t* __restrict__ Bt, int ldb, int K, char* smem, const Epi& epi) {
  constexpr int BM = 128, BN = 128, LS = 72, MI = 2, NI = 2, CH = 4;
  bf16_t* sa = (bf16_t*)smem;
  bf16_t* sb = sa + BM * LS;
  const int tid = otid(), lane = tid & 63, w = tid >> 6, wm = w >> 1, wn = w & 1, r = lane & 31, h = lane >> 5;
  f32x16 acc[MI][NI];
#pragma unroll
  for (int mi = 0; mi < MI; ++mi)
#pragma unroll
    for (int ni = 0; ni < NI; ++ni)
#pragma unroll
      for (int i = 0; i < 16; ++i) acc[mi][ni][i] = 0.f;
  u32x4 ra0[CH], rb0[CH], ra1[CH], rb1[CH];
  const int KT = K / 64;
  const bf16_t* ag = A + (size_t)(tid >> 3) * lda + (tid & 7) * 8;
  const bf16_t* bg = Bt + (size_t)(tid >> 3) * ldb + (tid & 7) * 8;
  bf16_t* sa_w = sa + (tid >> 3) * LS + (tid & 7) * 8;
  bf16_t* sb_w = sb + (tid >> 3) * LS + (tid & 7) * 8;
#pragma unroll
  for (int i = 0; i < CH; ++i) { ra0[i] = *gptr((const u32x4*)(ag + (size_t)i * 32 * lda)); rb0[i] = *gptr((const u32x4*)(bg + (size_t)i * 32 * ldb)); }
#pragma unroll
  for (int i = 0; i < CH; ++i) { ra1[i] = *gptr((const u32x4*)(ag + (size_t)i * 32 * lda + 64)); rb1[i] = *gptr((const u32x4*)(bg + (size_t)i * 32 * ldb + 64)); }
  const bf16_t* a_s = sa + (wm * (BM / 2) + r) * LS + h * 8;
  const bf16_t* b_s = sb + (wn * (BN / 2) + r) * LS + h * 8;
#define PF2_COMPUTE(PREF)                                                                                \
  {                                                                                                    \
    bf16x8 af[4][MI], bfr[4][NI];                                                                      \
    _Pragma("unroll") for (int ks = 0; ks < 4; ++ks) {                                                 \
      _Pragma("unroll") for (int mi = 0; mi < MI; ++mi) af[ks][mi] = *(const bf16x8*)(a_s + mi * 32 * LS + ks * 16);   \
      _Pragma("unroll") for (int ni = 0; ni < NI; ++ni) bfr[ks][ni] = *(const bf16x8*)(b_s + ni * 32 * LS + ks * 16);  \
    }                                                                                                  \
    __builtin_amdgcn_sched_barrier(0);     \
    PREF;                                                                                              \
    __builtin_amdgcn_sched_barrier(0);                                                                 \
    _Pragma("unroll") for (int ks = 0; ks < 4; ++ks)                                                   \
      _Pragma("unroll") for (int mi = 0; mi < MI; ++mi)                                                \
        _Pragma("unroll") for (int ni = 0; ni < NI; ++ni)                                              \
          acc[mi][ni] = __builtin_amdgcn_mfma_f32_32x32x16_bf16(af[ks][mi], bfr[ks][ni], acc[mi][ni], 0, 0, 0);  \
    __builtin_amdgcn_sched_barrier(0);                                                                 \
  }
#pragma unroll 1
  for (int kt = 0; kt < KT; kt += 2) {
    __syncthreads();
#pragma unroll
    for (int i = 0; i < CH; ++i) { *(u32x4*)(sa_w + i * 32 * LS) = ra0[i]; *(u32x4*)(sb_w + i * 32 * LS) = rb0[i]; }
    __syncthreads();
    auto pref0 = [&]() {
      if (kt + 2 < KT) {
#pragma unroll
        for (int i = 0; i < CH; ++i) { ra0[i] = *gptr((const u32x4*)(ag + (size_t)i * 32 * lda + (kt + 2) * 64)); rb0[i] = *gptr((const u32x4*)(bg + (size_t)i * 32 * ldb + (kt + 2) * 64)); }
      }
    };
    PF2_COMPUTE(pref0());
    __syncthreads();
#pragma unroll
    for (int i = 0; i < CH; ++i) { *(u32x4*)(sa_w + i * 32 * LS) = ra1[i]; *(u32x4*)(sb_w + i * 32 * LS) = rb1[i]; }
    __syncthreads();
    auto pref1 = [&]() {
      if (kt + 3 < KT) {
#pragma unroll
        for (int i = 0; i < CH; ++i) { ra1[i] = *gptr((const u32x4*)(ag + (size_t)i * 32 * lda + (kt + 3) * 64)); rb1[i] = *gptr((const u32x4*)(bg + (size_t)i * 32 * ldb + (kt + 3) * 64)); }
      }
    };
    PF2_COMPUTE(pref1());
  }
#undef PF2_COMPUTE
#pragma unroll
  for (int mi = 0; mi < MI; ++mi)
#pragma unroll
    for (int ni = 0; ni < NI; ++ni) {
#pragma unroll
      for (int i = 0; i < 16; ++i) {
        int rr = wm * (BM / 2) + mi * 32 + (i & 3) + 8 * (i >> 2) + 4 * h;
        int cc = wn * (BN / 2) + ni * 32 + r;
        epi(rr, cc, acc[mi][ni][i]);
        if ((i & 3) == 3) __builtin_amdgcn_sched_barrier(0);
      }
    }
  __syncthreads();
}

DI bool xcd_tile(int k, int MT, int NT, int& mt, int& nt) {
  const int b = obid(), G = gridDim.x;
  if ((G & 7) == 0) {
    int xcd = b & 7, local = b >> 3, per = (MT >> 3) * NT, idx = local + k * (G >> 3);
    if (idx >= per) return false;
    mt = (idx / NT) * 8 + xcd; nt = idx % NT; return true;
  }
  int idx = b + k * G; if (idx >= MT * NT) return false;
  mt = idx / NT; nt = idx % NT; return true;
}

struct EpiG1 {
  float* proj; bf16_t* uvt; int m0, n0;
  DI void operator()(int r, int c, float v) const {
    int tok = m0 + r, n = n0 + c;
    if (n < 1536) gptr(proj)[(size_t)tok * PLD + n] = v;
    else if (n >= 2048) gptr(proj)[(size_t)tok * PLD + n - 512] = v;
    else {
      int cc = n - 1536; int part = cc >> 8, ch = cc & 255; int start, T; seq_of_tok(tok, start, T);
      gptr(uvt)[(size_t)512 * start + (size_t)ch * 2 * T + part * T + (tok - start)] = f2bf(v);
    }
  }
};
struct EpiStoreBf { bf16_t* dst; int ld; DI void operator()(int r, int c, float v) const { dst[(size_t)r * ld + c] = f2bf(v); } };
struct EpiStoreF { float* dst; int ld; DI void operator()(int r, int c, float v) const { gptr(dst)[(size_t)r * ld + c] = v; } };
struct EpiResid {
  float* x; const float* gate; int m0, n0;
  const float* xp; const float* xs;
  DI void operator()(int r, int c, float v) const {
    int tok = m0 + r, col = n0 + c; size_t i = (size_t)tok * DM + col;
    float xin = xp ? (tok < 4096 ? gptr(xp)[i] : gptr(xs)[i - (size_t)4096 * DM]) : gptr(x)[i];
    gptr(x)[i] = xin + gptr(gate)[cv_of_tok(tok) * 6144 + col] * v;
  }
};

struct EpiConvGate {
  bf16_t* act; const float* cw; const float* cb; int m0; int nt; bool ctx;
  DI void tile(f32x16 (&acc)[4][2], int wm, int wn, int r, int h, char* smem) const {
    const int j = nt * 64 + wn * 32 + r;
    float w0[2], w1[2], w2[2], bs[2];
#pragma unroll
    for (int ni = 0; ni < 2; ++ni) {
      int ch = ni * DFF + j;
      w0[ni] = gptr(cw)[ch]; w1[ni] = gptr(cw)[DUP + ch]; w2[ni] = gptr(cw)[2 * DUP + ch]; bs[ni] = gptr(cb)[ch];
    }
    float* edge = (float*)smem;
    __syncthreads();
#pragma unroll
    for (int ni = 0; ni < 2; ++ni) {
      if (h == 0) edge[((((wm * 2 + wn) * 2 + ni) * 2) + 0) * 32 + r] = acc[0][ni][0];
      else        edge[((((wm * 2 + wn) * 2 + ni) * 2) + 1) * 32 + r] = acc[3][ni][15];
    }
    __syncthreads();
    float up_edge[2], dn_edge[2];
#pragma unroll
    for (int ni = 0; ni < 2; ++ni) {
      float ue = edge[((((0 * 2 + wn) * 2 + ni) * 2) + 1) * 32 + r];
      float de = edge[((((1 * 2 + wn) * 2 + ni) * 2) + 0) * 32 + r];
      up_edge[ni] = (ctx && wm == 1) ? ue : 0.f;
      dn_edge[ni] = (ctx && wm == 0) ? de : 0.f;
    }
    float Bp[2][4], Tp[2][4];
#pragma unroll
    for (int ni = 0; ni < 2; ++ni)
#pragma unroll
      for (int mi = 0; mi < 4; ++mi) {
        Bp[ni][mi] = __shfl_xor(acc[mi][ni][15], 32, 64);
        Tp[ni][mi] = __shfl_xor(acc[mi][ni][0], 32, 64);
      }
#pragma unroll
    for (int mi = 0; mi < 4; ++mi) {
      float zc[2][16];
#pragma unroll
      for (int ni = 0; ni < 2; ++ni) {
        float prev_in = (mi == 0) ? up_edge[ni] : ((mi == 2 && !ctx) ? 0.f : Bp[ni][mi > 0 ? mi - 1 : 0]);
        float next_in = (mi == 3) ? dn_edge[ni] : ((mi == 1 && !ctx) ? 0.f : Tp[ni][mi < 3 ? mi + 1 : 3]);
        float rp[4], rn[4];
#pragma unroll
        for (int g = 0; g < 4; ++g) {
          float sp_ = (h == 0) ? acc[mi][ni][4 * g + 3] : acc[mi][ni][g > 0 ? 4 * g - 1 : 0];
          float sn_ = (h == 1) ? acc[mi][ni][4 * g] : acc[mi][ni][g < 3 ? 4 * g + 4 : 15];
          rp[g] = __shfl_xor(sp_, 32, 64);
          rn[g] = __shfl_xor(sn_, 32, 64);
        }
#pragma unroll
        for (int e = 0; e < 16; ++e) {
          const int g = e >> 2;
          float pv, nx;
          if ((e & 3) != 0) pv = acc[mi][ni][e - 1];
          else pv = (h == 1) ? rp[g] : (g > 0 ? rp[g] : prev_in);
          if ((e & 3) != 3) nx = acc[mi][ni][e + 1];
          else nx = (h == 0) ? rn[g] : (g < 3 ? rn[g] : next_in);
          zc[ni][e] = bs[ni] + w0[ni] * pv + w1[ni] * acc[mi][ni][e] + w2[ni] * nx;
        }
      }
#pragma unroll
      for (int e = 0; e < 16; ++e) {
        int row = m0 + wm * 128 + mi * 32 + (e & 3) + 8 * (e >> 2) + 4 * h;
        gptr(act)[(size_t)row * DFF + j] = f2bf(gelu_t(zc[0][e]) * zc[1][e]);
        if ((e & 3) == 3) __builtin_amdgcn_sched_barrier(0);
      }
    }
  }
};

DI void ph_convert_weights(const Params& p, int l, char* smem, bool skip_fold = false) {
  float(*tile)[65] = (float(*)[65])smem;
  float(*t1)[65] = (float(*)[65])(smem + 64 * 65 * 4);
  float(*t2)[65] = (float(*)[65])(smem + 2 * 64 * 65 * 4);
  float* tw = (float*)(smem + 3 * 64 * 65 * 4);
  const int tid = otid();
  constexpr int N_IT = 640 + 256 + 1408 + 704 + 16;
  for (int it = obid(); it < N_IT; it += gridDim.x) {
    const float* src; bf16_t* dst; int K, Nsrc, n0, k0, sc0, fold = -1; bool wup_perm = false;
    int j = it;
    if (j < 640) {
      int nt = j / 16, kt = j % 16; src = p.inp(I_WIN) + (size_t)l * 1024 * 2304; K = 1024; Nsrc = 2304; n0 = nt * 64; k0 = kt * 64;
      dst = (bf16_t*)(p.wsp() + OFF_WIN);
      if (n0 < 1536) sc0 = n0;
      else if (n0 < 2048) { int cc = n0 - 1536; fold = cc >> 8; sc0 = cc & 255; }
      else sc0 = n0 - 256;
    } else if ((j -= 640) < 256) {
      int nt = j / 16, kt = j % 16; src = p.inp(I_WOUT) + (size_t)l * 1024 * 1024; K = 1024; Nsrc = 1024; n0 = nt * 64; k0 = kt * 64; sc0 = n0;
      dst = (bf16_t*)(p.wsp() + OFF_WOUT);
    } else if ((j -= 256) < 1408) {
      int nt = j / 16, kt = j % 16; src = p.inp(I_WUP) + (size_t)l * 1024 * DUP; K = 1024; Nsrc = DUP; n0 = nt * 64; k0 = kt * 64; sc0 = n0;
      dst = (bf16_t*)(p.wsp() + OFF_WUP); wup_perm = true;
    } else if ((j -= 1408) < 704) {
      int nt = j / 44, kt = j % 44; src = p.inp(I_WDN) + (size_t)l * DFF * 1024; K = DFF; Nsrc = 1024; n0 = nt * 64; k0 = kt * 64; sc0 = n0;
      dst = (bf16_t*)(p.wsp() + OFF_WDN);
    } else {
      j -= 704; int nt = j / 4, kt = j % 4; src = p.inp(I_WGLU) + (size_t)l * 65536; K = 256; Nsrc = 256; n0 = nt * 64; k0 = kt * 64; sc0 = n0;
      dst = (bf16_t*)(p.wsp() + OFF_WGLU);
    }
    if (fold < 0) {
#pragma unroll
      for (int i = 0; i < 16; ++i) {
        int kk = (tid >> 6) + 4 * i, nn = tid & 63;
        int sc = sc0 + nn;
        if (wup_perm) sc = ((nn & 32) ? DFF : 0) + (n0 >> 7) * 64 + ((n0 >> 6) & 1) * 32 + (nn & 31);
        tile[kk][nn] = gptr(src)[(size_t)(k0 + kk) * Nsrc + sc];
      }
      __syncthreads();
#pragma unroll
      for (int i = 0; i < 16; ++i) {
        int kk = tid & 63, nn = (tid >> 6) + 4 * i;
        gptr(dst)[(size_t)(n0 + nn) * K + k0 + kk] = f2bf(tile[kk][nn]);
      }
      __syncthreads();
    } else if (!skip_fold) {
      const bf16_t* wf = (const bf16_t*)(p.wsp() + OFF_WFOLD) + (size_t)l * 512 * 1024;
#pragma unroll
      for (int i = 0; i < 16; ++i) {
        int kk = tid & 63, nn = (tid >> 6) + 4 * i;
        gptr(dst)[(size_t)(n0 + nn) * K + k0 + kk] = gptr(wf)[(size_t)(n0 - 1536 + nn) * 1024 + k0 + kk];
      }
      __syncthreads();
    }
  }
}

DI void ph_mu(const Params& p, char* smem) {
  float(*t1)[65] = (float(*)[65])smem;
  float* tw = (float*)(smem + 64 * 65 * 4);
  const int tid = otid();
  float* mu = (float*)(p.wsp() + OFF_MU);
  for (int it = obid(); it < 64; it += gridDim.x) {
    int ct = it & 3, hd = (it >> 2) & 3, part = (it >> 4) & 1, l = it >> 5;
    const float* fnw = p.inp(I_FNW) + (size_t)l * 65536;
    __syncthreads();
    if (tid < 64) tw[tid] = (part == 0) ? cospif((float)tid / 32.f) : sinpif((float)tid / 32.f);
#pragma unroll
    for (int i = 0; i < 16; ++i) { int rr = (tid >> 6) + 4 * i, cc = tid & 63; t1[rr][cc] = gptr(fnw)[(size_t)(hd * 64 + rr) * 256 + ct * 64 + cc]; }
    __syncthreads();
#pragma unroll 1
    for (int i = 0; i < 16; ++i) {
      int jj = (tid >> 6) + 4 * i, cc = tid & 63;
      float sacc = 0.f;
#pragma unroll 8
      for (int kk = 0; kk < 64; ++kk) sacc += tw[(jj * kk) & 63] * t1[kk][cc];
      gptr(mu)[((size_t)(l * 2 + part) * 256 + hd * 64 + jj) * 256 + ct * 64 + cc] = 0.125f * sacc;
    }
  }
  __syncthreads();
}
DI void ph_fold(const Params& p, char* smem) {
  float(*t0)[65] = (float(*)[65])smem;
  float(*t2)[65] = (float(*)[65])(smem + 64 * 65 * 4);
  const int tid = otid();
  const float* mu = (const float*)(p.wsp() + OFF_MU);
  bf16_t* wf = (bf16_t*)(p.wsp() + OFF_WFOLD);
  for (int it = obid(); it < 256; it += gridDim.x) {
    int ct = it & 3, kt = (it >> 2) & 15, part = (it >> 6) & 1, l = it >> 7;
    const float* src = p.inp(I_WIN) + (size_t)l * 1024 * 2304;
    float acc[16];
#pragma unroll
    for (int i = 0; i < 16; ++i) acc[i] = 0.f;
#pragma unroll 1
    for (int hd = 0; hd < 4; ++hd) {
      __syncthreads();
#pragma unroll
      for (int i = 0; i < 16; ++i) {
        int rr = (tid >> 6) + 4 * i, cc = tid & 63;
        t0[rr][cc] = gptr(src)[(size_t)(kt * 64 + rr) * 2304 + 1536 + hd * 64 + cc];
        t2[rr][cc] = gptr(mu)[((size_t)(l * 2 + part) * 256 + hd * 64 + rr) * 256 + ct * 64 + cc];
      }
      __syncthreads();
      const int kk = tid & 63;
#pragma unroll 2
      for (int jj = 0; jj < 64; ++jj) {
        float a = t0[kk][jj];
#pragma unroll
        for (int i = 0; i < 16; ++i) acc[i] += a * t2[jj][(tid >> 6) + 4 * i];
      }
    }
#pragma unroll
    for (int i = 0; i < 16; ++i) {
      int kk = tid & 63, nn = (tid >> 6) + 4 * i;
      gptr(wf)[((size_t)l * 512 + part * 256 + ct * 64 + nn) * 1024 + kt * 64 + kk] = f2bf(acc[i]);
    }
  }
  __syncthreads();
}

DI void ph_fold_copy(const Params& p, int l) {
  const int gtid = obid() * 256 + otid(), gsz = gridDim.x * 256;
  const u32x4* src = (const u32x4*)(p.wsp() + OFF_WFOLD + (size_t)l * 512 * 1024 * 2);
  u32x4* dst = (u32x4*)(p.wsp() + OFF_WIN + (size_t)1536 * 1024 * 2);
  for (int e = gtid; e < 512 * 1024 / 8; e += gsz) dst[e] = src[e];
}

DI void ph_prep(const Params& p, char* smem) {
  const int tid = otid();
  ph_convert_weights(p, 0, smem, true);
  {
    float* sl = (float*)smem;
    float* red = sl + 192;
    float* adap = (float*)(p.wsp() + OFF_ADAP);
    for (int it = obid(); it < 2 * 24 * NKC; it += gridDim.x) {
      int kc = it % NKC, nc = (it / NKC) % 24, l = it / (NKC * 24);
      if (tid < 192) {
        int cv = tid >> 6, kk = tid & 63; int k = kc * 64 + kk;
        float cval = (cv == 0) ? p.inp(I_CCTX)[k] : p.inp(I_C)[(cv - 1) * 1024 + k];
        sl[tid] = silu_f(cval);
      }
      __syncthreads();
      int rg = tid >> 6, lane = tid & 63;
      float a0[4] = {0, 0, 0, 0}, a1[4] = {0, 0, 0, 0}, a2[4] = {0, 0, 0, 0};
      const float* wsrc = p.inp(I_WADA) + (size_t)l * 1024 * 6144 + nc * 256 + lane * 4;
#pragma unroll 4
      for (int i = 0; i < 16; ++i) {
        int kk = rg * 16 + i;
        float4 wv = ldg4(wsrc + (size_t)(kc * 64 + kk) * 6144);
        float s0 = sl[kk], s1 = sl[64 + kk], s2 = sl[128 + kk];
        a0[0] += s0 * wv.x; a0[1] += s0 * wv.y; a0[2] += s0 * wv.z; a0[3] += s0 * wv.w;
        a1[0] += s1 * wv.x; a1[1] += s1 * wv.y; a1[2] += s1 * wv.z; a1[3] += s1 * wv.w;
        a2[0] += s2 * wv.x; a2[1] += s2 * wv.y; a2[2] += s2 * wv.z; a2[3] += s2 * wv.w;
      }
#pragma unroll
      for (int q = 0; q < 4; ++q) {
        red[(rg * 3 + 0) * 256 + lane * 4 + q] = a0[q];
        red[(rg * 3 + 1) * 256 + lane * 4 + q] = a1[q];
        red[(rg * 3 + 2) * 256 + lane * 4 + q] = a2[q];
      }
      __syncthreads();
#pragma unroll
      for (int cv = 0; cv < 3; ++cv) {
        float s = red[(0 * 3 + cv) * 256 + tid] + red[(1 * 3 + cv) * 256 + tid] + red[(2 * 3 + cv) * 256 + tid] + red[(3 * 3 + cv) * 256 + tid];
        adap[((size_t)(kc * 2 + l) * 3 + cv) * 6144 + nc * 256 + tid] = s;
      }
      __syncthreads();
    }
  }
  const int gtid = obid() * 256 + tid, gsz = gridDim.x * 256;
  {
    float* s5a = (float*)(p.wsp() + OFF_S5A); float* s5al = (float*)(p.wsp() + OFF_S5AL);
    float* bbr = (float*)(p.wsp() + OFF_S5BBR); float* bbi = (float*)(p.wsp() + OFF_S5BBI);
    for (int e = gtid; e < 4096 * 16; e += gsz) {
      int idx = e >> 4, pp = e & 15;
      float lr = fminf(p.inp(I_LAMRE)[idx], -1e-4f), li = p.inp(I_LAMIM)[idx];
      float dt = expf(p.inp(I_LOGDT)[idx >> 6]);
      float mag = expf(lr * dt), ang = li * dt;
      float are = mag * cosf(ang), aim = mag * sinf(ang);
      float den = lr * lr + li * li, xr = are - 1.f;
      float zre = (xr * lr + aim * li) / den, zim = (aim * lr - xr * li) / den;
      float br = p.inp(I_BRE)[e], bi = p.inp(I_BIM)[e];
      bbr[e] = zre * br - zim * bi;
      bbi[e] = zre * bi + zim * br;
      if (pp == 0) {
        s5a[idx * 2] = are; s5a[idx * 2 + 1] = aim;
        float pr = are, pi = aim;
#pragma unroll
        for (int q = 0; q < 5; ++q) { float nr = pr * pr - pi * pi, ni = 2.f * pr * pi; pr = nr; pi = ni; }
        s5al[idx * 2] = pr; s5al[idx * 2 + 1] = pi;
      }
    }
  }
  {
    bf16_t* cmt = (bf16_t*)(p.wsp() + OFF_CMT);
    for (int e = gtid; e < 2 * 2 * 16 * 16 * 128; e += gsz) {
      int k = e & 127, row = e >> 7; int n = k >> 1;
      float v = (k & 1) ? -p.inp(I_CIM)[(size_t)row * 64 + n] : p.inp(I_CRE)[(size_t)row * 64 + n];
      cmt[e] = f2bf(v);
    }
    bf16_t* wsb = (bf16_t*)(p.wsp() + OFF_WSB);
    for (int e = gtid; e < 2 * 4 * 128 * 128; e += gsz) wsb[e] = f2bf(p.inp(I_GMWS)[e]);
  }
  {
    float* ctab = (float*)smem; float* stab = ctab + 2048;
    __syncthreads();
    for (int m = tid; m < 2048; m += 256) { float a = (float)m / 1024.f; ctab[m] = cospif(a) * 0.02209708691207961f; stab[m] = -sinpif(a) * 0.02209708691207961f; }
    __syncthreads();
    bf16_t* dl = (bf16_t*)(p.wsp() + OFF_DFTL);
    for (int e = gtid; e < 2048 * 256; e += gsz) {
      int t = e >> 8, s0 = (e & 255) * 8;
      float c[8], sn[8];
#pragma unroll
      for (int q = 0; q < 8; ++q) { int m = (t * (s0 + q)) & 2047; c[q] = ctab[m]; sn[q] = stab[m]; }
      *(bf16x8*)(dl + (size_t)t * 4096 + s0) = pack8(c[0], c[1], c[2], c[3], c[4], c[5], c[6], c[7]);
      *(bf16x8*)(dl + (size_t)t * 4096 + 2048 + s0) = pack8(sn[0], sn[1], sn[2], sn[3], sn[4], sn[5], sn[6], sn[7]);
    }
    bf16_t* dc = (bf16_t*)(p.wsp() + OFF_DFTC);
    const float rs = 0.0625f / 0.02209708691207961f;
    for (int e = gtid; e < 256 * 256; e += gsz) {
      int t = e >> 8, s2 = e & 255; int m = ((t * s2) & 255) * 8;
      dc[t * 512 + s2] = f2bf(ctab[m] * rs);
      dc[t * 512 + 256 + s2] = f2bf(stab[m] * rs);
    }
    __syncthreads();
  }
}

DI void ph_mod_reduce(const Params& p) {
  const int gtid = obid() * 256 + otid(), gsz = gridDim.x * 256;
  const float* adap = (const float*)(p.wsp() + OFF_ADAP); float* mod = (float*)(p.wsp() + OFF_MOD);
  for (int e = gtid; e < 2 * 3 * 6144; e += gsz) {
    int n = e % 6144, l = e / (3 * 6144);
    float s = p.inp(I_BADA)[l * 6144 + n];
    for (int kc = 0; kc < NKC; ++kc) s += gptr(adap)[(size_t)kc * 2 * 3 * 6144 + e];
    mod[e] = s;
  }
}

DI void ph_norm_mod(const Params& p, int l, const float* gnorm, int sh_off, int sc_off, bool from_input = false) {
  const int tid_ = otid(); const int lane = tid_ & 63, w = tid_ >> 6;
  const float* x = (const float*)(p.wsp() + OFF_X); bf16_t* hb = (bf16_t*)(p.wsp() + OFF_H);
  const float* mod = (const float*)(p.wsp() + OFF_MOD) + (size_t)l * 3 * 6144;
  for (int tok = obid() * 4 + w; tok < NTOK; tok += gridDim.x * 4) {
    const float* xr = from_input ? (tok < 4096 ? p.inp(I_XP) + (size_t)tok * DM : p.inp(I_XS) + (size_t)(tok - 4096) * DM) : x + (size_t)tok * DM;
    float4 v[4]; float ss = 0.f;
#pragma unroll
    for (int i = 0; i < 4; ++i) { v[i] = ldg4(xr + i * 256 + lane * 4); ss += v[i].x * v[i].x + v[i].y * v[i].y + v[i].z * v[i].z + v[i].w * v[i].w; }
    ss = wave_sum(ss);
    float rstd = rsqrtf(ss * (1.f / 1024.f) + EPSF);
    const float* mm = mod + cv_of_tok(tok) * 6144;
#pragma unroll
    for (int i = 0; i < 4; ++i) {
      int col = i * 256 + lane * 4;
      float4 g = ldg4(gnorm + col); float4 sc = ldg4(mm + sc_off + col); float4 sh = ldg4(mm + sh_off + col);
      ushort4 o;
      o.x = f2bf(v[i].x * rstd * g.x * (1.f + sc.x) + sh.x);
      o.y = f2bf(v[i].y * rstd * g.y * (1.f + sc.y) + sh.y);
      o.z = f2bf(v[i].z * rstd * g.z * (1.f + sc.z) + sh.z);
      o.w = f2bf(v[i].w * rstd * g.w * (1.f + sc.w) + sh.w);
      stg_us4(hb + (size_t)tok * DM + col, o);
    }
  }
}

DI void ph_final_norm(const Params& p) {
  const int tid_ = otid(); const int lane = tid_ & 63, w = tid_ >> 6;
  const float* x = (const float*)(p.wsp() + OFF_X);
  const float* g = p.inp(I_FING);
  for (int tok = obid() * 4 + w; tok < NTOK; tok += gridDim.x * 4) {
    const float* xr = x + (size_t)tok * DM;
    float4 v[4]; float ss = 0.f;
#pragma unroll
    for (int i = 0; i < 4; ++i) { v[i] = ldg4(xr + i * 256 + lane * 4); ss += v[i].x * v[i].x + v[i].y * v[i].y + v[i].z * v[i].z + v[i].w * v[i].w; }
    ss = wave_sum(ss);
    float rstd = rsqrtf(ss * (1.f / 1024.f) + EPSF);
#pragma unroll
    for (int i = 0; i < 4; ++i) {
      int col = i * 256 + lane * 4; float4 gg = ldg4(g + col);
      float4 o; o.x = v[i].x * rstd * gg.x; o.y = v[i].y * rstd * gg.y; o.z = v[i].z * rstd * gg.z; o.w = v[i].w * rstd * gg.w;
      stg4(p.outp() + (size_t)tok * DM + col, o);
    }
  }
}

DI void ph_gemm_in(const Params& p, char* smem) {
  const bf16_t* A = (const bf16_t*)(p.wsp() + OFF_H); const bf16_t* Bt = (const bf16_t*)(p.wsp() + OFF_WIN);
  int mt, nt;
  for (int k = 0; xcd_tile(k, 64, 20, mt, nt); ++k) {
    EpiG1 epi{(float*)(p.wsp() + OFF_PROJ), (bf16_t*)(p.wsp() + OFF_UVT), mt * 128, nt * 128};
    gemm_tile64_pf2(A + (size_t)mt * 128 * 1024, 1024, Bt + (size_t)nt * 128 * 1024, 1024, 1024, smem, epi);
  }
}
DI void ph_gemm_out(const Params& p, int l, char* smem) {
  int mt, nt;
  for (int k = 0; xcd_tile(k, 64, 8, mt, nt); ++k) {
    EpiResid epi{(float*)(p.wsp() + OFF_X), (const float*)(p.wsp() + OFF_MOD) + (size_t)l * 3 * 6144 + 2048, mt * 128, nt * 128, l == 0 ? p.inp(I_XP) : nullptr, l == 0 ? p.inp(I_XS) : nullptr};
    gemm_tile64_pf2((const bf16_t*)(p.wsp() + OFF_H) + (size_t)mt * 128 * 1024, 1024, (const bf16_t*)(p.wsp() + OFF_WOUT) + (size_t)nt * 128 * 1024, 1024, 1024, smem, epi);
  }
}
DI void ph_gemm_up(const Params& p, int l, char* smem) {
  int mt, nt;
  for (int k = 0; xcd_tile(k, 32, 44, mt, nt); ++k) {
    EpiConvGate epi{(bf16_t*)(p.wsp() + OFF_ACT), p.inp(I_CONVW) + (size_t)l * 3 * DUP, p.inp(I_CONVB) + (size_t)l * DUP, mt * 256, nt, mt < 16};
    gemm_tile64<256, 128, EpiConvGate, true>((const bf16_t*)(p.wsp() + OFF_H) + (size_t)mt * 256 * 1024, 1024, (const bf16_t*)(p.wsp() + OFF_WUP) + (size_t)nt * 128 * 1024, 1024, 1024, smem, epi);
  }
}
DI void ph_gemm_down(const Params& p, int l, char* smem) {
  int mt, nt;
  for (int k = 0; xcd_tile(k, 64, 8, mt, nt); ++k) {
    EpiResid epi{(float*)(p.wsp() + OFF_X), (const float*)(p.wsp() + OFF_MOD) + (size_t)l * 3 * 6144 + 5120, mt * 128, nt * 128, nullptr, nullptr};
    gemm_tile64_pf2((const bf16_t*)(p.wsp() + OFF_ACT) + (size_t)mt * 128 * DFF, DFF, (const bf16_t*)(p.wsp() + OFF_WDN) + (size_t)nt * 128 * DFF, DFF, DFF, smem, epi);
  }
}

DI void ph_scans(const Params& p, int l) {
  const int gtid = obid() * 256 + otid(), gsz = gridDim.x * 256;
  {
    float* hgs = (float*)(p.wsp() + OFF_HGS); const float* hgg = (const float*)(p.wsp() + OFF_HGG);
    for (int e = gtid; e < 18 * 2 * 4 * 4096; e += gsz) {
      int k = e & 63, v = (e >> 6) & 63, hd = (e >> 12) & 3, d = (e >> 14) & 1, seq = e >> 15;
      int start, T; seq_info(seq, start, T);
      int nc = T >> 5, cb = start >> 5;
      float S = 0.f;
      if (seq >= 16) S = p.inp(I_HGST)[((((size_t)(seq - 16) * 2 + l) * 2 + d) * 4 + hd) * 4096 + k * 64 + v];
      for (int s0 = 0; s0 < nc; s0 += 8) {
        float tv[8], gv[8];
#pragma unroll
        for (int u = 0; u < 8; ++u) {
          int s = s0 + u; int cc = d ? nc - 1 - s : s; size_t idx = (size_t)((cb + cc) * 2 + d) * 4 + hd;
          tv[u] = gptr(hgs)[idx * 4096 + v * 64 + k]; gv[u] = gptr(hgg)[idx * 64 + k];
        }
#pragma unroll
        for (int u = 0; u < 8; ++u) {
          int s = s0 + u; int cc = d ? nc - 1 - s : s; size_t idx = (size_t)((cb + cc) * 2 + d) * 4 + hd;
          gptr(hgs)[idx * 4096 + v * 64 + k] = S;
          S = gv[u] * S + tv[u];
        }
      }
      if (seq < 16) p.outp()[OUT_HG + ((((size_t)seq * 2 + l) * 2 + d) * 4 + hd) * 4096 + k * 64 + v] = S;
    }
  }
  {
    const float* s5e = (const float*)(p.wsp() + OFF_S5E); float* s5h = (float*)(p.wsp() + OFF_S5H);
    const float* s5al = (const float*)(p.wsp() + OFF_S5AL);
    for (int e = gtid; e < 18 * 2 * 16 * 64; e += gsz) {
      int n = e & 63, g = (e >> 6) & 15, d = (e >> 10) & 1, seq = e >> 11;
      int start, T; seq_info(seq, start, T);
      int nc = T >> 5, cb = start >> 5;
      int pidx = ((l * 2 + d) * 16 + g) * 64 + n;
      float ar = s5al[pidx * 2], ai = s5al[pidx * 2 + 1];
      float hr = 0.f, hi = 0.f;
      if (seq >= 16) {
        size_t si = ((((size_t)(seq - 16) * 2 + l) * 2 + d) * 16 + g) * 64 + n;
        hr = p.inp(I_S5RE)[si]; hi = p.inp(I_S5IM)[si];
      }
      for (int s0 = 0; s0 < nc; s0 += 8) {
        float er[8], ei[8];
#pragma unroll
        for (int u = 0; u < 8; ++u) {
          int s = s0 + u; int cc = d ? nc - 1 - s : s; size_t idx = ((size_t)(((cb + cc) * 2 + d) * 16 + g) * 64 + n) * 2;
          er[u] = gptr(s5e)[idx]; ei[u] = gptr(s5e)[idx + 1];
        }
#pragma unroll
        for (int u = 0; u < 8; ++u) {
          int s = s0 + u; int cc = d ? nc - 1 - s : s; size_t idx = ((size_t)(((cb + cc) * 2 + d) * 16 + g) * 64 + n) * 2;
          gptr(s5h)[idx] = hr; gptr(s5h)[idx + 1] = hi;
          float nr = ar * hr - ai * hi + er[u], ni = ar * hi + ai * hr + ei[u];
          hr = nr; hi = ni;
        }
      }
      if (seq < 16) {
        size_t oi = ((((size_t)seq * 2 + l) * 2 + d) * 16 + g) * 64 + n;
        p.outp()[OUT_S5RE + oi] = hr; p.outp()[OUT_S5IM + oi] = hi;
      }
    }
  }
}

constexpr int HS5 = 136;
DI void s5_stage_u(const float* up, int lane, float* ub) {
  const float* src = up + (size_t)(lane >> 1) * PLD + (lane & 1) * 8;
  f32x4 a = *gptr((const f32x4*)src), b = *gptr((const f32x4*)(src + 4));
  *(f32x4*)(ub + lane * 8) = a; *(f32x4*)(ub + lane * 8 + 4) = b;
}
template <bool WRITE_H>
DI void s5_scan(const float* ub, float are, float aim, const float (&br)[16], const float (&bi)[16], int d, int lane, float& hr, float& hi, bf16_t* HB) {
#pragma unroll 4
  for (int s = 0; s < 32; ++s) {
    const int j = d ? 31 - s : s;
    const float4* u4 = (const float4*)(ub + j * 16);
    float4 u0 = u4[0], u1 = u4[1], u2 = u4[2], u3 = u4[3];
    float ur0 = br[0] * u0.x, ur1 = br[4] * u1.x, ur2 = br[8] * u2.x, ur3 = br[12] * u3.x;
    float ui0 = bi[0] * u0.x, ui1 = bi[4] * u1.x, ui2 = bi[8] * u2.x, ui3 = bi[12] * u3.x;
    ur0 += br[1] * u0.y; ur1 += br[5] * u1.y; ur2 += br[9] * u2.y; ur3 += br[13] * u3.y;
    ui0 += bi[1] * u0.y; ui1 += bi[5] * u1.y; ui2 += bi[9] * u2.y; ui3 += bi[13] * u3.y;
    ur0 += br[2] * u0.z; ur1 += br[6] * u1.z; ur2 += br[10] * u2.z; ur3 += br[14] * u3.z;
    ui0 += bi[2] * u0.z; ui1 += bi[6] * u1.z; ui2 += bi[10] * u2.z; ui3 += bi[14] * u3.z;
    ur0 += br[3] * u0.w; ur1 += br[7] * u1.w; ur2 += br[11] * u2.w; ur3 += br[15] * u3.w;
    ui0 += bi[3] * u0.w; ui1 += bi[7] * u1.w; ui2 += bi[11] * u2.w; ui3 += bi[15] * u3.w;
    float ur = (ur0 + ur1) + (ur2 + ur3), ui = (ui0 + ui1) + (ui2 + ui3);
    float nr = are * hr - aim * hi + ur, ni = are * hi + aim * hr + ui;
    hr = nr; hi = ni;
    if (WRITE_H) *(unsigned*)(HB + j * HS5 + lane * 2) = pack_bf2(hr, hi);
  }
}

DI void ph_s5_local(const Params& p, int l, char* smem) {
  const int tid = otid(), lane = tid & 63, w = tid >> 6;
  float* ub = (float*)(smem + w * 11264);
  bf16_t* HB = (bf16_t*)(smem + w * 11264 + 2048);
  const float* proj = (const float*)(p.wsp() + OFF_PROJ);
  const float* s5a = (const float*)(p.wsp() + OFF_S5A); const float* bbr = (const float*)(p.wsp() + OFF_S5BBR); const float* bbi = (const float*)(p.wsp() + OFF_S5BBI);
  float* s5e = (float*)(p.wsp() + OFF_S5E);
  float* yloc = (float*)(p.wsp() + OFF_YLOC);
  const bf16_t* cmt = (const bf16_t*)(p.wsp() + OFF_CMT);
  const int row16 = lane & 15, quad = lane >> 4;
  for (int wi = obid() * 4 + w; wi < 8192; wi += gridDim.x * 4) {
    int g = wi & 15, d = (wi >> 4) & 1, c = wi >> 5;
    int pidx = ((l * 2 + d) * 16 + g) * 64 + lane;
    float hr = 0.f, hi = 0.f;
    const float are = gptr(s5a)[pidx * 2], aim = gptr(s5a)[pidx * 2 + 1];
    float br[16], bi[16];
#pragma unroll
    for (int q = 0; q < 4; ++q) {
      f32x4 t = *gptr((const f32x4*)(bbr + (size_t)pidx * 16 + q * 4)); br[q * 4] = t[0]; br[q * 4 + 1] = t[1]; br[q * 4 + 2] = t[2]; br[q * 4 + 3] = t[3];
      f32x4 u = *gptr((const f32x4*)(bbi + (size_t)pidx * 16 + q * 4)); bi[q * 4] = u[0]; bi[q * 4 + 1] = u[1]; bi[q * 4 + 2] = u[2]; bi[q * 4 + 3] = u[3];
    }
    const bf16_t* cb = cmt + ((size_t)(((l * 2 + d) * 16 + g) * 16 + row16)) * 128 + quad * 8;
    bf16x8 bbv[4];
#pragma unroll
    for (int ks = 0; ks < 4; ++ks) bbv[ks] = *gptr((const bf16x8*)(cb + ks * 32));
    LDS_FENCE();
    s5_stage_u(proj + (size_t)(c * 32) * PLD + PC_XA + g * 16, lane, ub);
    LDS_FENCE();
    s5_scan<true>(ub, are, aim, br, bi, d, lane, hr, hi, HB);
    size_t eo = ((size_t)((c * 2 + d) * 16 + g) * 64 + lane) * 2;
    gptr(s5e)[eo] = hr; gptr(s5e)[eo + 1] = hi;
    LDS_FENCE();
    f32x4 yacc[2];
#pragma unroll
    for (int mt = 0; mt < 2; ++mt) { yacc[mt][0] = 0.f; yacc[mt][1] = 0.f; yacc[mt][2] = 0.f; yacc[mt][3] = 0.f; }
#pragma unroll
    for (int ks = 0; ks < 4; ++ks) {
#pragma unroll
      for (int mt = 0; mt < 2; ++mt) {
        bf16x8 a = *(const bf16x8*)(HB + (mt * 16 + row16) * HS5 + ks * 32 + quad * 8);
        yacc[mt] = __builtin_amdgcn_mfma_f32_16x16x32_bf16(a, bbv[ks], yacc[mt], 0, 0, 0);
      }
    }
#pragma unroll
    for (int mt = 0; mt < 2; ++mt)
#pragma unroll
      for (int i = 0; i < 4; ++i)
        gptr(yloc)[((size_t)d * NTOK + c * 32 + mt * 16 + quad * 4 + i) * 256 + g * 16 + row16] = yacc[mt][i];
  }
}

DI void s5_out_task(const Params& p, int l, int c, char* smem) {
  const int tid = otid(), lane = tid & 63, w = tid >> 6;
  bf16_t* HB = (bf16_t*)(smem + w * 8704);
  bf16_t* Y5 = (bf16_t*)(smem + 4 * 8704);
  float* red = (float*)(smem + 4 * 8704 + 32 * 264 * 2);
  const float* proj = (const float*)(p.wsp() + OFF_PROJ);
  const float* s5a = (const float*)(p.wsp() + OFF_S5A);
  const float* s5h = (const float*)(p.wsp() + OFF_S5H);
  const bf16_t* cmt = (const bf16_t*)(p.wsp() + OFF_CMT);
  const float* yloc = (const float*)(p.wsp() + OFF_YLOC);
  const int row16 = lane & 15, quad = lane >> 4;
  float are[8], aim[8], hr0[8], hi0[8];
#pragma unroll
  for (int q = 0; q < 8; ++q) {
    const int g = w * 4 + (q >> 1), d = q & 1;
    const int pidx = ((l * 2 + d) * 16 + g) * 64 + lane;
    const size_t ho = ((size_t)((c * 2 + d) * 16 + g) * 64 + lane) * 2;
    are[q] = gptr(s5a)[pidx * 2]; aim[q] = gptr(s5a)[pidx * 2 + 1];
    hr0[q] = gptr(s5h)[ho]; hi0[q] = gptr(s5h)[ho + 1];
  }
#pragma unroll
  for (int gq = 0; gq < 4; ++gq) {
    const int g = w * 4 + gq;
    float yl[8], xav[8];
#pragma unroll
    for (int mt = 0; mt < 2; ++mt)
#pragma unroll
      for (int i = 0; i < 4; ++i) {
        const int tl = mt * 16 + quad * 4 + i;
        const size_t yo = (size_t)(c * 32 + tl) * 256 + g * 16 + row16;
        yl[mt * 4 + i] = gptr(yloc)[yo] + gptr(yloc)[(size_t)NTOK * 256 + yo];
        xav[mt * 4 + i] = gptr(proj)[(size_t)(c * 32 + tl) * PLD + PC_XA + g * 16 + row16];
      }
    const float dsk = gptr(p.inp(I_S5D))[l * 256 + g * 16 + row16];
    f32x4 yacc[2];
#pragma unroll
    for (int mt = 0; mt < 2; ++mt) { yacc[mt][0] = 0.f; yacc[mt][1] = 0.f; yacc[mt][2] = 0.f; yacc[mt][3] = 0.f; }
#pragma unroll
    for (int d = 0; d < 2; ++d) {
      const bf16_t* cb = cmt + ((size_t)(((l * 2 + d) * 16 + g) * 16 + row16)) * 128 + quad * 8;
      bf16x8 bb[4];
#pragma unroll
      for (int ks = 0; ks < 4; ++ks) bb[ks] = *gptr((const bf16x8*)(cb + ks * 32));
      const float ar = are[gq * 2 + d], ai = aim[gq * 2 + d];
      float pr = hr0[gq * 2 + d], pi = hi0[gq * 2 + d];
      LDS_FENCE();
#pragma unroll 8
      for (int sft = 0; sft < 32; ++sft) {
        const int j = d ? 31 - sft : sft;
        float nr = ar * pr - ai * pi, ni = ar * pi + ai * pr;
        pr = nr; pi = ni;
        *(unsigned*)(HB + j * HS5 + lane * 2) = pack_bf2(pr, pi);
      }
      LDS_FENCE();
#pragma unroll
      for (int ks = 0; ks < 4; ++ks) {
#pragma unroll
        for (int mt = 0; mt < 2; ++mt) {
          bf16x8 a = *(const bf16x8*)(HB + (mt * 16 + row16) * HS5 + ks * 32 + quad * 8);
          yacc[mt] = __builtin_amdgcn_mfma_f32_16x16x32_bf16(a, bb[ks], yacc[mt], 0, 0, 0);
        }
      }
    }
    LDS_FENCE();
#pragma unroll
    for (int mt = 0; mt < 2; ++mt)
#pragma unroll
      for (int i = 0; i < 4; ++i) {
        int tl = mt * 16 + quad * 4 + i;
        float y = gelu_t(yacc[mt][i] + yl[mt * 4 + i] + dsk * xav[mt * 4 + i]);
        Y5[tl * 264 + g * 16 + row16] = f2bf(y);
      }
  }
  __syncthreads();
  const int r = lane & 31, h = lane >> 5;
  f32x16 acc[2];
#pragma unroll
  for (int nt = 0; nt < 2; ++nt)
#pragma unroll
    for (int i = 0; i < 16; ++i) acc[nt][i] = 0.f;
  const bf16_t* wg = (const bf16_t*)(p.wsp() + OFF_WGLU);
#pragma unroll 8
  for (int ks = 0; ks < 16; ++ks) {
    bf16x8 a = *(const bf16x8*)(Y5 + r * 264 + ks * 16 + h * 8);
#pragma unroll
    for (int nt = 0; nt < 2; ++nt) {
      bf16x8 b = *gptr((const bf16x8*)(wg + (size_t)(w * 64 + nt * 32 + r) * 256 + ks * 16 + h * 8));
      acc[nt] = __builtin_amdgcn_mfma_f32_32x32x16_bf16(a, b, acc[nt], 0, 0, 0);
    }
  }
#pragma unroll
  for (int i = 0; i < 16; ++i) {
    int tl = (i & 3) + 8 * (i >> 2) + 4 * h;
    float s = 0.f;
#pragma unroll
    for (int nt = 0; nt < 2; ++nt) { float v = bf2f(Y5[tl * 264 + w * 64 + nt * 32 + r]) * sigm(acc[nt][i]); acc[nt][i] = v; s += v * v; }
#pragma unroll
    for (int o = 16; o > 0; o >>= 1) s += __shfl_xor(s, o, 64);
    if (r == 0) red[w * 32 + tl] = s;
  }
  __syncthreads();
  bf16_t* cat = (bf16_t*)(p.wsp() + OFF_H);
#pragma unroll
  for (int i = 0; i < 16; ++i) {
    int tl = (i & 3) + 8 * (i >> 2) + 4 * h;
    float tot = red[tl] + red[32 + tl] + red[64 + tl] + red[96 + tl];
    float rstd = rsqrtf(tot * (1.f / 256.f) + EPSF);
#pragma unroll
    for (int nt = 0; nt < 2; ++nt) {
      int ch = w * 64 + nt * 32 + r;
      gptr(cat)[(size_t)(c * 32 + tl) * DM + ch] = f2bf(acc[nt][i] * rstd * gptr(p.inp(I_GRPG))[l * 1024 + ch]);
    }
  }
  __syncthreads();
}

DI void hg_gate_vals(float z, float lb, float& lf, float& kv) {
  float e = __expf(-fabsf(z));
  float inv = frcp(1.f + e);
  float sg = (z >= 0.f) ? inv : e * inv;
  float sn = (z >= 0.f) ? e * inv : inv;
  lf = (lb == 0.f) ? (fminf(z, 0.f) - __logf(1.f + e)) : __logf(lb + (1.f - lb) * sg);
  kv = (1.f - lb) * sn;
}
DI float hg_lb(const Params& p, int l, int d, int ch) {
  if (l == 0) return 0.f;
  float x0 = p.inp(I_LBLOG)[(0 * 2 + d) * 256 + ch], x1 = p.inp(I_LBLOG)[(1 * 2 + d) * 256 + ch];
  return 1.f / (1.f + expf(x0 - x1));
}
DI void hg_build_vt(const float* proj, int c, int hd, int lane, bf16_t* Vt) {
#pragma unroll
  for (int j0 = 0; j0 < 32; j0 += 8) {
    float v[8];
#pragma unroll
    for (int q = 0; q < 8; ++q) v[q] = gptr(proj)[(size_t)(c * 32 + j0 + q) * PLD + PC_V + hd * 64 + lane];
    *(bf16x8*)(Vt + lane * 40 + j0) = pack8(v[0], v[1], v[2], v[3], v[4], v[5], v[6], v[7]);
  }
}

DI void ph_hg_local(const Params& p, int l, char* smem) {
  const int tid = otid(), lane = tid & 63, w = tid >> 6, r = lane & 31, h = lane >> 5;
  bf16_t* Vt = (bf16_t*)(smem + w * 11264);
  bf16_t* KhT = Vt + 64 * 40;
  const float* proj = (const float*)(p.wsp() + OFF_PROJ);
  float* hgs = (float*)(p.wsp() + OFF_HGS); float* hgg = (float*)(p.wsp() + OFF_HGG);
  for (int wi = obid() * 4 + w; wi < 2048; wi += gridDim.x * 4) {
    int hd = wi & 3, d = (wi >> 2) & 1, c = wi >> 3;
    hg_build_vt(proj, c, hd, lane, Vt);
    const float lb = hg_lb(p, l, d, hd * 64 + lane);
    float bcs[32], kvs[32];
    float run = 0.f;
#pragma unroll
    for (int s = 0; s < 32; ++s) {
      int j = d ? 31 - s : s;
      float z = gptr(proj)[(size_t)(c * 32 + j) * PLD + PC_ZF + d * 256 + hd * 64 + lane];
      float lf, kv; hg_gate_vals(z, lb, lf, kv);
      run += lf; bcs[s] = run; kvs[s] = kv;
    }
    const float blast = run;
#pragma unroll
    for (int j0 = 0; j0 < 32; j0 += 8) {
      float kh[8];
#pragma unroll
      for (int q = 0; q < 8; ++q) {
        int j = j0 + q;
        float b = d ? bcs[31 - j] : bcs[j];
        float kk = d ? kvs[31 - j] : kvs[j];
        kh[q] = kk * __expf(blast - b);
      }
      *(bf16x8*)(KhT + lane * 40 + j0) = pack8(kh[0], kh[1], kh[2], kh[3], kh[4], kh[5], kh[6], kh[7]);
    }
    hgg[(size_t)wi * 64 + lane] = __expf(blast);
    LDS_FENCE();
    f32x16 acc[2][2];
#pragma unroll
    for (int a = 0; a < 2; ++a)
#pragma unroll
      for (int b = 0; b < 2; ++b)
#pragma unroll
        for (int i = 0; i < 16; ++i) acc[a][b][i] = 0.f;
#pragma unroll
    for (int ks = 0; ks < 2; ++ks) {
      bf16x8 af[2], bf[2];
#pragma unroll
      for (int t = 0; t < 2; ++t) { af[t] = *(const bf16x8*)(Vt + (t * 32 + r) * 40 + ks * 16 + h * 8); bf[t] = *(const bf16x8*)(KhT + (t * 32 + r) * 40 + ks * 16 + h * 8); }
#pragma unroll
      for (int vt = 0; vt < 2; ++vt)
#pragma unroll
        for (int kt = 0; kt < 2; ++kt) acc[vt][kt] = __builtin_amdgcn_mfma_f32_32x32x16_bf16(af[vt], bf[kt], acc[vt][kt], 0, 0, 0);
    }
    float* dst = hgs + (size_t)wi * 4096;
#pragma unroll
    for (int vt = 0; vt < 2; ++vt)
#pragma unroll
      for (int kt = 0; kt < 2; ++kt)
#pragma unroll
        for (int i = 0; i < 16; ++i) gptr(dst)[(vt * 32 + (i & 3) + 8 * (i >> 2) + 4 * h) * 64 + kt * 32 + r] = acc[vt][kt][i];
  }
}

DI void hg_out_task(const Params& p, int l, int c, int hd, char* smem_w) {
  const int tid = otid(), lane = tid & 63, r = lane & 31, h = lane >> 5;
  bf16_t* Qt = (bf16_t*)smem_w;
  bf16_t* Kt = Qt + 32 * 72;
  bf16_t* Vt = Kt + 32 * 72;
  const float* proj = (const float*)(p.wsp() + OFF_PROJ);
  const float* hgs = (const float*)(p.wsp() + OFF_HGS);
  hg_build_vt(proj, c, hd, lane, Vt);
  f32x16 oT[2];
#pragma unroll
  for (int vt = 0; vt < 2; ++vt)
#pragma unroll
    for (int i = 0; i < 16; ++i) oT[vt][i] = 0.f;
#pragma unroll 1
  for (int d = 0; d < 2; ++d) {
    LDS_FENCE();
    const float lb = hg_lb(p, l, d, hd * 64 + lane);
    float run = 0.f;
    float zz[32], qq[32];
#pragma unroll
    for (int s = 0; s < 32; ++s) {
      int j = d ? 31 - s : s;
      zz[s] = gptr(proj)[(size_t)(c * 32 + j) * PLD + PC_ZF + d * 256 + hd * 64 + lane];
      qq[s] = gptr(proj)[(size_t)(c * 32 + j) * PLD + PC_Q + hd * 64 + lane];
    }
#pragma unroll
    for (int s = 0; s < 32; ++s) {
      int j = d ? 31 - s : s;
      float z = zz[s], q = qq[s];
      float lf, kv; hg_gate_vals(z, lb, lf, kv);
      run += lf;
      Qt[j * 72 + lane] = f2bf(q * __expf(run));
      Kt[j * 72 + lane] = f2bf(kv * __expf(-run));
    }
    LDS_FENCE();
    f32x16 sT;
#pragma unroll
    for (int i = 0; i < 16; ++i) sT[i] = 0.f;
    bf16x8 qf[4];
#pragma unroll
    for (int ks = 0; ks < 4; ++ks) {
      bf16x8 a = *(const bf16x8*)(Kt + r * 72 + ks * 16 + h * 8);
      qf[ks] = *(const bf16x8*)(Qt + r * 72 + ks * 16 + h * 8);
      sT = __builtin_amdgcn_mfma_f32_32x32x16_bf16(a, qf[ks], sT, 0, 0, 0);
    }
#pragma unroll
    for (int i = 0; i < 16; ++i) {
      int ii = (i & 3) + 8 * (i >> 2) + 4 * h;
      bool valid = d ? (ii >= r) : (ii <= r);
      sT[i] = valid ? sT[i] : 0.f;
    }
#pragma unroll
    for (int s2 = 0; s2 < 2; ++s2) {
      bf16x8 pb = pack8(sT[8 * s2], sT[8 * s2 + 1], sT[8 * s2 + 2], sT[8 * s2 + 3], sT[8 * s2 + 4], sT[8 * s2 + 5], sT[8 * s2 + 6], sT[8 * s2 + 7]);
#pragma unroll
      for (int vt = 0; vt < 2; ++vt) {
        s16x4 lo = *(const s16x4*)(Vt + (vt * 32 + r) * 40 + 16 * s2 + 4 * h);
        s16x4 hi2 = *(const s16x4*)(Vt + (vt * 32 + r) * 40 + 16 * s2 + 8 + 4 * h);
        bf16x8 av = __builtin_shufflevector(lo, hi2, 0, 1, 2, 3, 4, 5, 6, 7);
        oT[vt] = __builtin_amdgcn_mfma_f32_32x32x16_bf16(av, pb, oT[vt], 0, 0, 0);
      }
    }
    const float* st = hgs + (size_t)((c * 2 + d) * 4 + hd) * 4096;
#pragma unroll
    for (int ks = 0; ks < 4; ++ks) {
#pragma unroll
      for (int vt = 0; vt < 2; ++vt) {
        const GAS f32x4* sp4 = gptr((const f32x4*)(st + (vt * 32 + r) * 64 + ks * 16 + h * 8));
        f32x4 s0 = sp4[0], s1 = sp4[1];
        bf16x8 a = pack8(s0[0], s0[1], s0[2], s0[3], s1[0], s1[1], s1[2], s1[3]);
        oT[vt] = __builtin_amdgcn_mfma_f32_32x32x16_bf16(a, qf[ks], oT[vt], 0, 0, 0);
      }
    }
  }
  float ss = 0.f;
#pragma unroll
  for (int vt = 0; vt < 2; ++vt)
#pragma unroll
    for (int i = 0; i < 16; ++i) ss += oT[vt][i] * oT[vt][i];
  ss += __shfl_xor(ss, 32, 64);
  const float rstd = rsqrtf(ss * (1.f / 64.f) + EPSF);
  const int tok = c * 32 + r;
  bf16_t* cat = (bf16_t*)(p.wsp() + OFF_H);
#pragma unroll
  for (int vt = 0; vt < 2; ++vt)
#pragma unroll
    for (int g4 = 0; g4 < 4; ++g4) {
      int v0 = vt * 32 + 8 * g4 + 4 * h;
      f32x4 gt = *gptr((const f32x4*)(proj + (size_t)tok * PLD + PC_GATE + hd * 64 + v0));
      f32x4 gn = *gptr((const f32x4*)(p.inp(I_GRPG) + l * 1024 + 256 + hd * 64 + v0));
      s16x4 o;
      o[0] = (short)f2bf(oT[vt][4 * g4 + 0] * rstd * gn[0] * silu_f(gt[0]));
      o[1] = (short)f2bf(oT[vt][4 * g4 + 1] * rstd * gn[1] * silu_f(gt[1]));
      o[2] = (short)f2bf(oT[vt][4 * g4 + 2] * rstd * gn[2] * silu_f(gt[2]));
      o[3] = (short)f2bf(oT[vt][4 * g4 + 3] * rstd * gn[3] * silu_f(gt[3]));
      *gptr((s16x4*)(cat + (size_t)tok * DM + 256 + hd * 64 + v0)) = o;
    }
}

DI void ph_mix_out(const Params& p, int l, char* smem) {
  const int b = obid(); const int nb = gridDim.x;
  if (nb >= 2) {
    if ((b & 1) == 0) { for (int c = b >> 1; c < 256; c += (nb + 1) >> 1) s5_out_task(p, l, c, smem); }
    else {
      const int w = otid() >> 6;
      for (int c = b >> 1; c < 256; c += nb >> 1) hg_out_task(p, l, c, w, smem + w * 14336);
    }
  } else {
    for (int c = 0; c < 256; ++c) s5_out_task(p, l, c, smem);
    const int w = otid() >> 6;
    for (int c = 0; c < 256; ++c) hg_out_task(p, l, c, w, smem + w * 14336);
  }
}

DI void gmlp_task(const Params& p, int l, int C, int half, char* smem) {
  const int tid = otid(), lane = tid & 63, w = tid >> 6, r = lane & 31, h = lane >> 5;
  const int hd = w;
  float* rstd = (float*)smem;
  float* part = rstd + 128;
  bf16_t* GvT = (bf16_t*)(smem + 2560 + w * 9216);
  const float* proj = (const float*)(p.wsp() + OFF_PROJ);
  const bf16_t* wsb = (const bf16_t*)(p.wsp() + OFF_WSB) + (size_t)(l * 4 + hd) * 128 * 128;
#pragma unroll 4
  for (int i = 0; i < 8; ++i) {
    int tl = w * 32 + i * 4 + (lane >> 4);
    const float* src = proj + (size_t)(C * 128 + tl) * PLD + PC_GV + (lane & 15) * 16;
    float ss = 0.f;
#pragma unroll
    for (int q = 0; q < 4; ++q) {
      f32x4 v = *gptr((const f32x4*)(src + q * 4));
      float a = gelu_t(v[0]), b = gelu_t(v[1]), cc = gelu_t(v[2]), dd = gelu_t(v[3]);
      ss += a * a + b * b + cc * cc + dd * dd;
    }
#pragma unroll
    for (int o = 8; o > 0; o >>= 1) ss += __shfl_xor(ss, o, 64);
    if ((lane & 15) == 0) rstd[tl] = rsqrtf(ss * (1.f / 256.f) + EPSF);
  }
  __syncthreads();
  const float gmg = p.inp(I_GMNG)[l * 256 + hd * 64 + lane];
  bf16_t* cat = (bf16_t*)(p.wsp() + OFF_H);
  f32x16 acc[2][2];
#pragma unroll
  for (int a = 0; a < 2; ++a)
#pragma unroll
    for (int b = 0; b < 2; ++b)
#pragma unroll
      for (int i = 0; i < 16; ++i) acc[a][b][i] = 0.f;
#pragma unroll 1
  for (int pass = 0; pass < 2; ++pass) {
    LDS_FENCE();
#pragma unroll 4
    for (int j0 = 0; j0 < 64; j0 += 8) {
      float v[8];
#pragma unroll
      for (int q = 0; q < 8; ++q) {
        int j = pass * 64 + j0 + q;
        v[q] = gelu_t(gptr(proj)[(size_t)(C * 128 + j) * PLD + PC_GV + hd * 64 + lane]) * rstd[j] * gmg;
      }
      *(bf16x8*)(GvT + lane * 72 + j0) = pack8(v[0], v[1], v[2], v[3], v[4], v[5], v[6], v[7]);
    }
    LDS_FENCE();
#pragma unroll
    for (int ks = 0; ks < 4; ++ks) {
      bf16x8 af[2];
#pragma unroll
      for (int mt = 0; mt < 2; ++mt) af[mt] = *(const bf16x8*)(GvT + (mt * 32 + r) * 72 + ks * 16 + h * 8);
#pragma unroll
      for (int nt = 0; nt < 2; ++nt) {
        bf16x8 b = *gptr((const bf16x8*)(wsb + (size_t)((half * 2 + nt) * 32 + r) * 128 + pass * 64 + ks * 16 + h * 8));
#pragma unroll
        for (int mt = 0; mt < 2; ++mt) acc[mt][nt] = __builtin_amdgcn_mfma_f32_32x32x16_bf16(af[mt], b, acc[mt][nt], 0, 0, 0);
      }
    }
  }
#pragma unroll
  for (int nt = 0; nt < 2; ++nt) {
    const int ti = (half * 2 + nt) * 32 + r; const int tok = C * 128 + ti;
    const float bsv = p.inp(I_GMBS)[(l * 4 + hd) * 128 + ti];
    float ss = 0.f;
#pragma unroll
    for (int mt = 0; mt < 2; ++mt)
#pragma unroll
      for (int g4 = 0; g4 < 4; ++g4) {
        int d0 = mt * 32 + 8 * g4 + 4 * h;
        f32x4 gu = *gptr((const f32x4*)(proj + (size_t)tok * PLD + PC_GU + hd * 64 + d0));
        float v0 = gelu_t(gu[0]) * (acc[mt][nt][4 * g4 + 0] + bsv);
        float v1 = gelu_t(gu[1]) * (acc[mt][nt][4 * g4 + 1] + bsv);
        float v2 = gelu_t(gu[2]) * (acc[mt][nt][4 * g4 + 2] + bsv);
        float v3 = gelu_t(gu[3]) * (acc[mt][nt][4 * g4 + 3] + bsv);
        acc[mt][nt][4 * g4 + 0] = v0; acc[mt][nt][4 * g4 + 1] = v1; acc[mt][nt][4 * g4 + 2] = v2; acc[mt][nt][4 * g4 + 3] = v3;
        ss += v0 * v0 + v1 * v1 + v2 * v2 + v3 * v3;
      }
    ss += __shfl_xor(ss, 32, 64);
    if (h == 0) part[w * 64 + nt * 32 + r] = ss;
  }
  __syncthreads();
#pragma unroll
  for (int nt = 0; nt < 2; ++nt) {
    const int ti = (half * 2 + nt) * 32 + r; const int tok = C * 128 + ti;
    const int pi = nt * 32 + r;
    float tot = part[pi] + part[64 + pi] + part[128 + pi] + part[192 + pi];
    float rs = rsqrtf(tot * (1.f / 256.f) + EPSF);
#pragma unroll
    for (int mt = 0; mt < 2; ++mt)
#pragma unroll
      for (int g4 = 0; g4 < 4; ++g4) {
        int d0 = mt * 32 + 8 * g4 + 4 * h;
        f32x4 gn = *gptr((const f32x4*)(p.inp(I_GRPG) + l * 1024 + 768 + hd * 64 + d0));
        s16x4 o;
        o[0] = (short)f2bf(acc[mt][nt][4 * g4 + 0] * rs * gn[0]); o[1] = (short)f2bf(acc[mt][nt][4 * g4 + 1] * rs * gn[1]);
        o[2] = (short)f2bf(acc[mt][nt][4 * g4 + 2] * rs * gn[2]); o[3] = (short)f2bf(acc[mt][nt][4 * g4 + 3] * rs * gn[3]);
        *gptr((s16x4*)(cat + (size_t)tok * DM + 768 + hd * 64 + d0)) = o;
      }
  }
  __syncthreads();
}

DI void ph_c_norm(const Params& p, int l) {
  const int tid_ = otid(); const int lane = tid_ & 63, w = tid_ >> 6;
  bf16_t* cat = (bf16_t*)(p.wsp() + OFF_H);
  const float* g0 = (const float*)(p.wsp() + OFF_GCP0); const float* g1 = (const float*)(p.wsp() + OFF_GCP1);
  for (int tok = obid() * 4 + w; tok < NTOK; tok += gridDim.x * 4) {
    float4 v = ldg4(g0 + (size_t)tok * 256 + lane * 4);
    if (tok >= 4096) {
#pragma unroll
      for (int q = 0; q < 3; ++q) {
        float4 u = ldg4(g1 + ((size_t)q * 4096 + (tok - 4096)) * 256 + lane * 4);
        v.x += u.x; v.y += u.y; v.z += u.z; v.w += u.w;
      }
    }
    float ss = wave_sum(v.x * v.x + v.y * v.y + v.z * v.z + v.w * v.w);
    float rstd = rsqrtf(ss * (1.f / 256.f) + EPSF);
    float4 g = ldg4(p.inp(I_GRPG) + l * 1024 + 512 + lane * 4);
    ushort4 o; o.x = f2bf(v.x * rstd * g.x); o.y = f2bf(v.y * rstd * g.y); o.z = f2bf(v.z * rstd * g.z); o.w = f2bf(v.w * rstd * g.w);
    stg_us4(cat + (size_t)tok * DM + 512 + lane * 4, o);
  }
}

DI void ph_local(const Params& p, int l, char* smem) {
  for (int it = obid(); it < 448; it += gridDim.x) {
    if (it < 320) {
      int seq, mt, nt, ks, T, start, klen;
      if (it < 256) { ks = it & 3; nt = (it >> 2) & 1; mt = (it >> 3) & 15; seq = 16 + (it >> 7); klen = 1024; }
      else { int j = it - 256; ks = 0; nt = j & 1; mt = (j >> 1) & 1; seq = j >> 2; klen = 512; }
      seq_info(seq, start, T);
      const bf16_t* A = (const bf16_t*)(p.wsp() + (T == 256 ? OFF_DFTC : OFF_DFTL)) + (size_t)mt * 128 * 2 * T + ks * 1024;
      const bf16_t* Bt = (const bf16_t*)(p.wsp() + OFF_UVT) + (size_t)512 * start + (size_t)nt * 128 * 2 * T + ks * 1024;
      float* dst = (ks == 0) ? (float*)(p.wsp() + OFF_GCP0) + (size_t)(start + mt * 128) * 256 + nt * 128
                             : (float*)(p.wsp() + OFF_GCP1) + ((size_t)(ks - 1) * 4096 + (start - 4096) + mt * 128) * 256 + nt * 128;
      EpiStoreF epi{dst, 256};
      gemm_tile64_pf2(A, 2 * T, Bt, 2 * T, klen, smem, epi);
    } else {
      gmlp_task(p, l, (it - 320) >> 1, (it - 320) & 1, smem);
    }
  }
  ph_hg_local(p, l, smem);
  ph_s5_local(p, l, smem);
}

DI void ph_conv_gate(const Params& p, int l) {
  const int gtid = obid() * 256 + otid(), gsz = gridDim.x * 256;
  const bf16_t* z = (const bf16_t*)(p.wsp() + OFF_Z); bf16_t* act = (bf16_t*)(p.wsp() + OFF_ACT);
  const float* cw = p.inp(I_CONVW) + (size_t)l * 3 * DUP; const float* cb = p.inp(I_CONVB) + (size_t)l * DUP;
  for (int e = gtid; e < NTOK * (DFF / 8); e += gsz) {
    int tok = e / (DFF / 8), j0 = (e % (DFF / 8)) * 8;
    int seg = tok < 4096 ? 256 : 64; int tt = tok & (seg - 1);
    bool hp = tt > 0, hn = tt < seg - 1;
    float res[8];
    float za[2][8];
#pragma unroll
    for (int half = 0; half < 2; ++half) {
      int ch = half * DFF + j0;
      uint4 zc = *(const uint4*)(z + (size_t)tok * DUP + ch);
      uint4 zp = hp ? *(const uint4*)(z + (size_t)(tok - 1) * DUP + ch) : make_uint4(0, 0, 0, 0);
      uint4 zn = hn ? *(const uint4*)(z + (size_t)(tok + 1) * DUP + ch) : make_uint4(0, 0, 0, 0);
      const unsigned* pc = (const unsigned*)&zc; const unsigned* pp = (const unsigned*)&zp; const unsigned* pn = (const unsigned*)&zn;
#pragma unroll
      for (int q = 0; q < 8; ++q) {
        float vc = bf2f((bf16_t)((pc[q >> 1] >> ((q & 1) * 16)) & 0xffff));
        float vp = bf2f((bf16_t)((pp[q >> 1] >> ((q & 1) * 16)) & 0xffff));
        float vn = bf2f((bf16_t)((pn[q >> 1] >> ((q & 1) * 16)) & 0xffff));
        za[half][q] = cb[ch + q] + cw[ch + q] * vp + cw[DUP + ch + q] * vc + cw[2 * DUP + ch + q] * vn;
      }
    }
#pragma unroll
    for (int q = 0; q < 8; ++q) res[q] = gelu_t(za[0][q]) * za[1][q];
    uint4 o;
    o.x = (unsigned)f2bf(res[0]) | ((unsigned)f2bf(res[1]) << 16);
    o.y = (unsigned)f2bf(res[2]) | ((unsigned)f2bf(res[3]) << 16);
    o.z = (unsigned)f2bf(res[4]) | ((unsigned)f2bf(res[5]) << 16);
    o.w = (unsigned)f2bf(res[6]) | ((unsigned)f2bf(res[7]) << 16);
    *(uint4*)(act + (size_t)tok * DFF + j0) = o;
  }
}

#define EXP 0
#define GSYNC() xcd_barrier(xb)
#define XS(n) if (EXP == n) { GSYNC(); }
__global__ void __launch_bounds__(256, 2) mega_kernel(Params pk) {
  __shared__ __attribute__((aligned(16))) char smem[SMEM_BYTES];
  cg::grid_group grid = cg::this_grid();
  __shared__ uint4 xb_words;
  __shared__ Params sp;
  if (threadIdx.x == 0) { xb_words = make_uint4(0u, 0u, 0u, 0u); sp = pk; }
  __syncthreads();
  const Params& p = sp;
  XcdBarrier xb = xcd_barrier_post((unsigned*)(pk.ws + OFF_BAR), (volatile LAS unsigned*)&xb_words);
  if (p.wsp() == nullptr) grid.sync();
  ph_mu(p, smem);
  ph_prep(p, smem);
  GSYNC();
  ph_fold(p, smem);
  ph_mod_reduce(p);
  GSYNC();
  ph_fold_copy(p, 0);
  for (int l = 0; l < 2; ++l) {
    if (l > 0) ph_convert_weights(p, l, smem);
    ph_norm_mod(p, l, p.inp(I_N1G) + l * 1024, 0, 1024, l == 0);
    GSYNC();
    ph_gemm_in(p, smem);
    GSYNC();
    ph_local(p, l, smem);
    if (EXP == 11) ph_local(p, l, smem);
    GSYNC();
    ph_scans(p, l);
    ph_c_norm(p, l);
    GSYNC();
    ph_mix_out(p, l, smem);
    if (EXP == 12) ph_mix_out(p, l, smem);
    GSYNC();
    ph_gemm_out(p, l, smem);
    GSYNC();
    ph_norm_mod(p, l, p.inp(I_N2G) + l * 1024, 3072, 4096);
    GSYNC();
    ph_gemm_up(p, l, smem);
    GSYNC();
    ph_gemm_down(p, l, smem);
    GSYNC();
  }
  ph_final_norm(p);
}

extern "C" void kernel_launch(void* const* d_in, const int* in_sizes, int n_in, void* d_out, int out_size, void* d_ws, size_t ws_size,
                              hipStream_t stream) {
  static int grid_blocks = 0;
  if (!grid_blocks) {
    int dev = 0, cus = 0, per_cu = 0;
    hipGetDevice(&dev);
    hipDeviceGetAttribute(&cus, hipDeviceAttributeMultiprocessorCount, dev);
    hipOccupancyMaxActiveBlocksPerMultiprocessor(&per_cu, mega_kernel, 256, 0);
    if (per_cu > 2) per_cu = 2;
    if (per_cu < 1) per_cu = 1;
    grid_blocks = cus * per_cu;
  }
  if (ws_size < WS_NEEDED) fprintf(stderr, "workspace too small: %zu < %zu\n", ws_size, (size_t)WS_NEEDED);
  Params p{};
  for (int i = 0; i < 33; ++i) p.in[i] = (const float*)d_in[i];
  p.out = (float*)d_out;
  p.ws = (char*)d_ws;
  void* args[] = {&p};
  hipMemsetAsync((char*)d_ws + OFF_BAR, 0, XCD_BAR_WORDS_C * 4, stream);
  hipError_t e = hipLaunchCooperativeKernel((void*)mega_kernel, dim3(grid_blocks), dim3(256), args, 0, stream);
  if (e != hipSuccess) fprintf(stderr, "cooperative launch failed: %s (grid %d)\n", hipGetErrorString(e), grid_blocks);
}
```
